# Optimizing an MI355X kernel written in HIP

```python
import jax
import jax.numpy as jnp
from jax import lax
import numpy as np


D_MODEL = 2048
BATCH = 16
SEQ = 2048
DEPTH = 2

GRID_W = 64
CTX_LEN = 256
HEAD_DIM = 128
Q_BLOCK = 128
ROPE_THETA = 10000.0
EPS = 1e-6

GQA_HEADS = 8
GQA_KV_HEADS = 2
GQA_GROUP = GQA_HEADS // GQA_KV_HEADS
GQA_Q_W = GQA_HEADS * HEAD_DIM
GQA_KV_W = GQA_KV_HEADS * HEAD_DIM
GQA_IN_W = GQA_Q_W + 2 * GQA_KV_W
HGRN_HEADS = 8
HGRN_DK = 128
HGRN_DV = 128
HGRN_KW = HGRN_HEADS * HGRN_DK
HGRN_VW = HGRN_HEADS * HGRN_DV
HGRN_IN_W = 3 * HGRN_KW + 2 * HGRN_VW
HGRN_CHUNK = 32
NA_HEADS = 8
NA_WIN_R_MAX = 8
NA_WIN_C = 16
NA_W = NA_HEADS * HEAD_DIM
NA_IN_W = 3 * NA_W
MLA_HEADS = 8
MLA_Q_RANK = 512
MLA_KV_RANK = 512
MLA_NOPE = 128
MLA_ROPE = 64
MLA_V = 128
MLA_IN_W = MLA_Q_RANK + MLA_KV_RANK + MLA_ROPE
PEER_HEADS = 8
PEER_N_KEYS = 128
PEER_N_EXPERTS = PEER_N_KEYS * PEER_N_KEYS
PEER_TOPK = 16
PEER_QDIM = 256
PEER_TOKEN_BLOCK = 128

N_EVEN = (DEPTH + 1) // 2
N_ODD = DEPTH // 2
EVEN_IN_W = GQA_IN_W + HGRN_IN_W
EVEN_OUT_W = GQA_Q_W + HGRN_VW
ODD_IN_W = NA_IN_W + MLA_IN_W
ODD_OUT_W = NA_W + MLA_HEADS * MLA_V

kernel_name = 'hybrid_flow_gqa_hgrn2_natten_mla_peer'


def rms_norm(x, w):
    xf = x.astype(jnp.float32)
    y = xf * lax.rsqrt(jnp.mean(xf * xf, axis=-1, keepdims=True) + EPS)
    return (y * w.astype(jnp.float32)).astype(x.dtype)


def modulate(h, shift, scale):
    return h * (1.0 + scale) + shift


def split_heads(z, h):
    b, l, _ = z.shape
    return z.reshape(b, l, h, -1).transpose(0, 2, 1, 3)


def merge_heads(z):
    b, h, l, d = z.shape
    return z.transpose(0, 2, 1, 3).reshape(b, l, h * d)


def rope_1d(x, pos):
    half = x.shape[-1] // 2
    inv = ROPE_THETA ** (-jnp.arange(half, dtype=jnp.float32) / half)
    ang = pos.astype(jnp.float32)[:, None] * inv[None, :]
    cos, sin = jnp.cos(ang), jnp.sin(ang)
    xf = x.astype(jnp.float32)
    x1, x2 = xf[..., :half], xf[..., half:]
    return jnp.concatenate([x1 * cos - x2 * sin, x1 * sin + x2 * cos], axis=-1).astype(x.dtype)


def axial_rope(x):
    n = x.shape[-2]
    t = jnp.arange(n)
    h = x.shape[-1] // 2
    return jnp.concatenate([rope_1d(x[..., :h], t // GRID_W), rope_1d(x[..., h:], t % GRID_W)], axis=-1)


def softmax_attend(q, k, v, scale):
    s = jnp.einsum('bhgqd,bhkd->bhgqk', q, k).astype(jnp.float32) * scale
    p = jax.nn.softmax(s, axis=-1).astype(v.dtype)
    return jnp.einsum('bhgqk,bhkd->bhgqd', p, v)


def blocked_attend(q, k, v, scale):
    b, hk, g, n, dk = q.shape
    qb = q.reshape(b, hk, g, n // Q_BLOCK, Q_BLOCK, dk).transpose(3, 0, 1, 2, 4, 5)
    o = lax.map(lambda qi: softmax_attend(qi, k, v, scale), qb)
    return o.transpose(1, 2, 3, 0, 4, 5).reshape(b, hk, g, n, v.shape[-1])


def gqa_mixer(z_x, z_c, q_norm_w, k_norm_w, need_ctx):
    def prep(z, rotate):
        q, k, v = jnp.split(z, [GQA_Q_W, GQA_Q_W + GQA_KV_W], axis=-1)
        q = rms_norm(split_heads(q, GQA_HEADS), q_norm_w)
        k = rms_norm(split_heads(k, GQA_KV_HEADS), k_norm_w)
        if rotate:
            q, k = axial_rope(q), axial_rope(k)
        b, _, l, d = q.shape
        return q.reshape(b, GQA_KV_HEADS, GQA_GROUP, l, d), k, split_heads(v, GQA_KV_HEADS)

    def out(o):
        b, hk, g, l, d = o.shape
        return merge_heads(o.reshape(b, hk * g, l, d))

    scale = HEAD_DIM ** -0.5
    qc, kc, vc = prep(z_c, False)
    qx, kx, vx = prep(z_x, True)
    y_x = out(blocked_attend(qx, jnp.concatenate([kc, kx], axis=2), jnp.concatenate([vc, vx], axis=2), scale))
    y_c = out(softmax_attend(qc, kc, vc, scale)) if need_ctx else None
    return y_x, y_c


def hgrn_forget(f_pre, lb):
    lb = lb.reshape(HGRN_HEADS, 1, HGRN_DK)
    s = jax.nn.sigmoid(f_pre.astype(jnp.float32))
    f = lb + (1.0 - lb) * s
    return (1.0 - lb) * (1.0 - s), jnp.log(f)


def hgrn_chunk_scan(q, k, g, v, s0):
    b, h, l, _ = q.shape
    nc = l // HGRN_CHUNK

    def to_chunks(z):
        return z.reshape(b, h, nc, HGRN_CHUNK, z.shape[-1]).transpose(2, 0, 1, 3, 4)

    incl = jnp.tril(jnp.ones((HGRN_CHUNK, HGRN_CHUNK), dtype=bool))[:, :, None]

    def step(s, inp):
        qc, kc, gc, vc = inp
        cum = jnp.cumsum(gc, axis=2)
        rel = cum[:, :, :, None, :] - cum[:, :, None, :, :]
        decay = jnp.exp(jnp.where(incl, rel, -jnp.inf))
        a = jnp.einsum('bhtd,bhsd,bhtsd->bhts', qc, kc, decay)
        o = jnp.einsum('bhts,bhsv->bhtv', a, vc) + jnp.einsum('bhtd,bhdv->bhtv', qc * jnp.exp(cum), s)
        last = cum[:, :, -1:, :]
        s_new = jnp.exp(last[:, :, 0, :])[..., None] * s + jnp.einsum('bhsd,bhsv->bhdv', kc * jnp.exp(last - cum), vc)
        return s_new, o

    s_fin, o = lax.scan(step, s0, (to_chunks(q), to_chunks(k), to_chunks(g), to_chunks(v)))
    return o.transpose(1, 2, 0, 3, 4).reshape(b, h, l, -1), s_fin


def hgrn_mixer(z_x, z_c, lb_fw, lb_bw, o_norm_w, need_ctx):
    splits = [HGRN_KW, 2 * HGRN_KW, 3 * HGRN_KW, 3 * HGRN_KW + HGRN_VW]

    def prep(z):
        q, f_fw, f_bw, i, g = jnp.split(z, splits, axis=-1)
        q = split_heads(q, HGRN_HEADS).astype(jnp.float32)
        i = split_heads(i, HGRN_HEADS).astype(jnp.float32)
        fw = hgrn_forget(split_heads(f_fw, HGRN_HEADS), lb_fw)
        bw = hgrn_forget(split_heads(f_bw, HGRN_HEADS), lb_bw)
        return q, i, fw, bw, g

    flip = lambda t: jnp.flip(t, axis=2)
    qc, ic, (kfc, gfc), (kbc, gbc), gate_c = prep(z_c)
    qx, ix, (kfx, gfx), (kbx, gbx), gate_x = prep(z_x)
    s0 = jnp.zeros((z_x.shape[0], HGRN_HEADS, HGRN_DK, HGRN_DV), jnp.float32)
    o_fc, s_fc = hgrn_chunk_scan(qc, kfc, gfc, ic, s0)
    o_bc, s_bc = hgrn_chunk_scan(flip(qc), flip(kbc), flip(gbc), flip(ic), s0)
    o_fx, _ = hgrn_chunk_scan(qx, kfx, gfx, ix, s_fc)
    o_bx, _ = hgrn_chunk_scan(flip(qx), flip(kbx), flip(gbx), flip(ix), s_bc)
    w = o_norm_w.reshape(HGRN_HEADS, 1, HGRN_DV)

    def readout(o, gate):
        return merge_heads(rms_norm(o, w)).astype(gate.dtype) * jax.nn.silu(gate)

    y_x = readout(o_fx + flip(o_bx), gate_x)
    y_c = readout(o_fc + flip(o_bc), gate_c) if need_ctx else None
    return y_x, y_c


def na_mixer(z_x, z_c, rpb, need_ctx):
    b, n, _ = z_x.shape
    rows = n // GRID_W
    win_r = min(NA_WIN_R_MAX, rows)
    scale = HEAD_DIM ** -0.5
    qx, kx, vx = [split_heads(t, NA_HEADS) for t in jnp.split(z_x, 3, axis=-1)]
    qc, kc, vc = [split_heads(t, NA_HEADS) for t in jnp.split(z_c, 3, axis=-1)]
    n_ctx = kc.shape[2]
    cols = jnp.arange(GRID_W)
    col_start = jnp.clip(cols - NA_WIN_C // 2, 0, GRID_W - NA_WIN_C)
    in_win = (cols[None, :] >= col_start[:, None]) & (cols[None, :] < col_start[:, None] + NA_WIN_C)
    win_mask = jnp.tile(in_win[:, None, :], (1, win_r, 1)).reshape(GRID_W, win_r * GRID_W)
    dc_idx = jnp.clip(cols[None, :] - cols[:, None] + NA_WIN_C - 1, 0, 2 * NA_WIN_C - 2)
    kg = kx.reshape(b, NA_HEADS, rows, GRID_W, HEAD_DIM)
    vg = vx.reshape(b, NA_HEADS, rows, GRID_W, HEAD_DIM)

    def row_block(args):
        r, q_row = args
        r0 = jnp.clip(r - win_r // 2, 0, rows - win_r)
        k_band = lax.dynamic_slice_in_dim(kg, r0, win_r, axis=2).reshape(b, NA_HEADS, win_r * GRID_W, HEAD_DIM)
        v_band = lax.dynamic_slice_in_dim(vg, r0, win_r, axis=2).reshape(b, NA_HEADS, win_r * GRID_W, HEAD_DIM)
        dr_idx = r0 + jnp.arange(win_r) - r + NA_WIN_R_MAX - 1
        bias = rpb[:, dr_idx][:, :, dc_idx]
        bias = bias.transpose(0, 2, 1, 3).reshape(NA_HEADS, GRID_W, win_r * GRID_W)
        s_loc = jnp.einsum('bhqd,bhkd->bhqk', q_row, k_band).astype(jnp.float32) * scale + bias
        s_loc = jnp.where(win_mask, s_loc, -jnp.inf)
        s_ctx = jnp.einsum('bhqd,bhkd->bhqk', q_row, kc).astype(jnp.float32) * scale
        p = jax.nn.softmax(jnp.concatenate([s_ctx, s_loc], axis=-1), axis=-1).astype(vx.dtype)
        return jnp.einsum('bhqk,bhkd->bhqd', p[..., :n_ctx], vc) + jnp.einsum('bhqk,bhkd->bhqd', p[..., n_ctx:], v_band)

    q_rows = qx.reshape(b, NA_HEADS, rows, GRID_W, HEAD_DIM).transpose(2, 0, 1, 3, 4)
    o = lax.map(row_block, (jnp.arange(rows), q_rows))
    y_x = merge_heads(o.transpose(1, 2, 0, 3, 4).reshape(b, NA_HEADS, n, HEAD_DIM))
    y_c = merge_heads(softmax_attend(qc[:, :, None], kc, vc, scale)[:, :, 0]) if need_ctx else None
    return y_x, y_c


def mla_mixer(z_x, z_c, q_norm_w, w_q_up, kv_norm_w, w_kv_up, need_ctx):
    def prep(z, rotate):
        cq, ckv, k_rope = jnp.split(z, [MLA_Q_RANK, MLA_Q_RANK + MLA_KV_RANK], axis=-1)
        q = split_heads(rms_norm(cq, q_norm_w) @ w_q_up, MLA_HEADS)
        kv = split_heads(rms_norm(ckv, kv_norm_w) @ w_kv_up, MLA_HEADS)
        q_nope, q_rope = q[..., :MLA_NOPE], q[..., MLA_NOPE:]
        k_nope, v = kv[..., :MLA_NOPE], kv[..., MLA_NOPE:]
        k_rope = k_rope[:, None]
        if rotate:
            q_rope, k_rope = axial_rope(q_rope), axial_rope(k_rope)
        k = jnp.concatenate([k_nope, jnp.broadcast_to(k_rope, k_nope.shape[:-1] + (MLA_ROPE,))], axis=-1)
        return jnp.concatenate([q_nope, q_rope], axis=-1)[:, :, None], k, v

    scale = (MLA_NOPE + MLA_ROPE) ** -0.5
    qc, kc, vc = prep(z_c, False)
    qx, kx, vx = prep(z_x, True)
    y_x = merge_heads(blocked_attend(qx, jnp.concatenate([kc, kx], axis=2), jnp.concatenate([vc, vx], axis=2), scale)[:, :, 0])
    y_c = merge_heads(softmax_attend(qc, kc, vc, scale)[:, :, 0]) if need_ctx else None
    return y_x, y_c


def peer_ffn(x, wq, keys, u, v):
    t, d = x.shape
    xb = x.reshape(t // PEER_TOKEN_BLOCK, PEER_TOKEN_BLOCK, d)

    def block(xt):
        q = (xt @ wq).reshape(-1, PEER_HEADS, 2, PEER_QDIM // 2)
        s = jnp.einsum('thpd,hpkd->thpk', q, keys).astype(jnp.float32)
        sv, si = lax.top_k(s, PEER_TOPK)
        cand = (sv[:, :, 0, :, None] + sv[:, :, 1, None, :]).reshape(-1, PEER_HEADS, PEER_TOPK * PEER_TOPK)
        cidx = (si[:, :, 0, :, None] * PEER_N_KEYS + si[:, :, 1, None, :]).reshape(-1, PEER_HEADS, PEER_TOPK * PEER_TOPK)
        top_s, pos = lax.top_k(cand, PEER_TOPK)
        eidx = jnp.take_along_axis(cidx, pos, axis=-1).reshape(-1, PEER_HEADS * PEER_TOPK)
        gate = jax.nn.softmax(top_s, axis=-1).reshape(-1, PEER_HEADS * PEER_TOPK).astype(xt.dtype)
        h = jax.nn.gelu(jnp.einsum('td,ted->te', xt, u[eidx]))
        return jnp.einsum('te,ted->td', gate * h, v[eidx])

    return lax.map(block, xb).reshape(t, d)


def setup_inputs(seed: int = 0) -> dict:
    key = jax.random.key(seed)
    ks = iter(jax.random.split(key, 32))
    D = D_MODEL

    def nrm(shape, s):
        return jax.random.normal(next(ks), shape, jnp.float32) * s

    def gain(shape):
        return 1.0 + nrm(shape, 0.02)

    return {
        'x': nrm((BATCH, SEQ, D), 1.0),
        'c': nrm((BATCH, D), 1.0),
        'ctx': nrm((BATCH, CTX_LEN, D), 1.0),
        'c_ctx': nrm((D,), 1.0),
        'w_mod': nrm((DEPTH, D, 6 * D), 0.5 * D ** -0.5),
        'b_mod': nrm((DEPTH, 6 * D), 0.01),
        'norm1_w': gain((DEPTH, D)),
        'norm2_w': gain((DEPTH, D)),
        'ev_w_in': nrm((N_EVEN, D, EVEN_IN_W), D ** -0.5),
        'ev_w_out': nrm((N_EVEN, EVEN_OUT_W, D), EVEN_OUT_W ** -0.5),
        'gqa_q_norm': gain((N_EVEN, HEAD_DIM)),
        'gqa_k_norm': gain((N_EVEN, HEAD_DIM)),
        'hgrn_lb': nrm((2, DEPTH + 1, HGRN_KW), 0.1),
        'hgrn_o_norm': gain((N_EVEN, HGRN_VW)),
        'od_w_in': nrm((N_ODD, D, ODD_IN_W), D ** -0.5),
        'od_w_out': nrm((N_ODD, ODD_OUT_W, D), ODD_OUT_W ** -0.5),
        'na_rpb': nrm((N_ODD, NA_HEADS, 2 * NA_WIN_R_MAX - 1, 2 * NA_WIN_C - 1), 0.1),
        'mla_q_norm': gain((N_ODD, MLA_Q_RANK)),
        'mla_w_q_up': nrm((N_ODD, MLA_Q_RANK, MLA_HEADS * (MLA_NOPE + MLA_ROPE)), MLA_Q_RANK ** -0.5),
        'mla_kv_norm': gain((N_ODD, MLA_KV_RANK)),
        'mla_w_kv_up': nrm((N_ODD, MLA_KV_RANK, MLA_HEADS * (MLA_NOPE + MLA_V)), MLA_KV_RANK ** -0.5),
        'peer_wq': nrm((DEPTH, D, PEER_HEADS * PEER_QDIM), D ** -0.5),
        'peer_keys': nrm((DEPTH, PEER_HEADS, 2, PEER_N_KEYS, PEER_QDIM // 2), (PEER_QDIM // 2) ** -0.5),
        'peer_u': nrm((DEPTH, PEER_N_EXPERTS, D), D ** -0.5),
        'peer_v': nrm((DEPTH, PEER_N_EXPERTS, D), 1.0),
        'final_norm_w': gain((D,)),
    }


def reference(x, c, ctx, c_ctx, w_mod, b_mod, norm1_w, norm2_w, ev_w_in, ev_w_out, gqa_q_norm, gqa_k_norm,
              hgrn_lb, hgrn_o_norm, od_w_in, od_w_out, na_rpb, mla_q_norm, mla_w_q_up, mla_kv_norm, mla_w_kv_up,
              peer_wq, peer_keys, peer_u, peer_v, final_norm_w):
    b, n, d = x.shape
    sc = jax.nn.silu(c)[:, None, :]
    sctx = jax.nn.silu(c_ctx)[None, None, :]
    lb_table = jnp.cumsum(jax.nn.softmax(hgrn_lb.astype(jnp.float32), axis=1), axis=1)
    h_x, h_c = x, ctx
    for l in range(DEPTH):
        need_ctx = l < DEPTH - 1
        j = l // 2
        mx = jnp.split(sc @ w_mod[l] + b_mod[l], 6, axis=-1)
        mc = jnp.split(sctx @ w_mod[l] + b_mod[l], 6, axis=-1)
        a_x = modulate(rms_norm(h_x, norm1_w[l]), mx[0], mx[1])
        a_c = modulate(rms_norm(h_c, norm1_w[l]), mc[0], mc[1])
        if l % 2 == 0:
            z_x, z_c = a_x @ ev_w_in[j], a_c @ ev_w_in[j]
            ya_x, ya_c = gqa_mixer(z_x[..., :GQA_IN_W], z_c[..., :GQA_IN_W], gqa_q_norm[j], gqa_k_norm[j], need_ctx)
            yb_x, yb_c = hgrn_mixer(z_x[..., GQA_IN_W:], z_c[..., GQA_IN_W:], lb_table[0, l], lb_table[1, l],
                                    hgrn_o_norm[j], need_ctx)
            w_out = ev_w_out[j]
        else:
            z_x, z_c = a_x @ od_w_in[j], a_c @ od_w_in[j]
            ya_x, ya_c = na_mixer(z_x[..., :NA_IN_W], z_c[..., :NA_IN_W], na_rpb[j], need_ctx)
            yb_x, yb_c = mla_mixer(z_x[..., NA_IN_W:], z_c[..., NA_IN_W:], mla_q_norm[j], mla_w_q_up[j],
                                   mla_kv_norm[j], mla_w_kv_up[j], need_ctx)
            w_out = od_w_out[j]
        h_x = h_x + mx[2] * (jnp.concatenate([ya_x, yb_x], axis=-1) @ w_out)
        f_x = modulate(rms_norm(h_x, norm2_w[l]), mx[3], mx[4])
        h_x = h_x + mx[5] * peer_ffn(f_x.reshape(-1, d), peer_wq[l], peer_keys[l], peer_u[l], peer_v[l]).reshape(b, n, d)
        if need_ctx:
            h_c = h_c + mc[2] * (jnp.concatenate([ya_c, yb_c], axis=-1) @ w_out)
            f_c = modulate(rms_norm(h_c, norm2_w[l]), mc[3], mc[4])
            h_c = h_c + mc[5] * peer_ffn(f_c.reshape(-1, d), peer_wq[l], peer_keys[l], peer_u[l], peer_v[l]).reshape(h_c.shape)
    return rms_norm(h_x, final_norm_w)
```

```cpp
#include <hip/hip_runtime.h>
#include <cstdio>
#include <cstdint>

#define DBG_SANITIZE 0
#ifndef DBG_REPMASK
#define DBG_REPMASK 0u
#endif
#ifndef MK_N_LAUNCHES
#define MK_N_LAUNCHES 1
#endif

#define DI __device__ __forceinline__
#define LAS __attribute__((address_space(3)))
typedef unsigned short bf16_t;
typedef short bf16x8 __attribute__((ext_vector_type(8)));
typedef short s16x4 __attribute__((ext_vector_type(4)));
typedef float f32x4 __attribute__((ext_vector_type(4)));
typedef float f32x16 __attribute__((ext_vector_type(16)));
typedef unsigned u32x4 __attribute__((ext_vector_type(4)));
typedef unsigned u32x2 __attribute__((ext_vector_type(2)));

constexpr int DM = 2048, NBATCH = 16, SEQ = 2048, CTXL = 256;
constexpr int MXR = NBATCH * SEQ;
constexpr int MCR = NBATCH * CTXL;
constexpr int MT = MXR + MCR;
constexpr int EV_IN = 6656, OD_IN = 4160, OD_INP = 4352;
constexpr float EPS = 1e-6f;
constexpr int NPHASE = 22;

constexpr size_t MiB = 1u << 20;
constexpr size_t WS_CTL = 0, CTL_ZERO_BYTES = 1 * MiB;
constexpr size_t WS_MODX = 1 * MiB;
constexpr size_t WS_MODC = WS_MODX + (size_t)2 * 16 * 12288 * 4;
constexpr size_t WS_WIN0 = 4 * MiB;
constexpr size_t WS_WOUT0 = 30 * MiB;
constexpr size_t WS_WIN1 = 38 * MiB;
constexpr size_t WS_WOUT1 = 55 * MiB;
constexpr size_t WS_WQUP = 63 * MiB;
constexpr size_t WS_WKVUP = 65 * MiB;
constexpr size_t WS_WPQ = 67 * MiB;
constexpr size_t WS_KEYS = 83 * MiB;
constexpr size_t WS_U = 84 * MiB, WS_V = 148 * MiB;
constexpr size_t WS_SU = 3 * MiB, WS_SV = 3 * MiB + 65536;
constexpr size_t WS_QUP = 84 * MiB;
constexpr size_t WS_ACT = 212 * MiB;
constexpr size_t WS_H = 356 * MiB;
constexpr size_t WS_OF = 356 * MiB, WS_OB = 428 * MiB;
constexpr size_t WS_A8 = 500 * MiB;
constexpr size_t WS_Q8 = 500 * MiB, WS_K8 = 540 * MiB;
constexpr size_t WS_K8N = 500 * MiB, WS_K8R = 540 * MiB;
constexpr size_t WS_K8NA = 572 * MiB;
constexpr size_t WS_V8G = 552 * MiB, WS_V8NA = 608 * MiB, WS_V8M = 950 * MiB;
constexpr float QK8_SC = 16.f;
constexpr size_t WS_Z = 644 * MiB;
constexpr size_t WS_PQ = 644 * MiB;
constexpr size_t WS_EIDX = 788 * MiB, WS_GATE = 806 * MiB;
constexpr size_t WS_HP = 824 * MiB;
constexpr size_t WS_KVUP = 950 * MiB;
constexpr size_t WS_END = 1112 * MiB;
constexpr int CW_BAR = 4096;
constexpr int CW_QUEUE2 = 8192 + 64;
constexpr int CW_QUEUE = 8192;

constexpr int LDS_BYTES = 147456;
constexpr int LDS_MISC = 131072 + 1024;

typedef __bf16 bf16v2 __attribute__((ext_vector_type(2)));
typedef float f32x2 __attribute__((ext_vector_type(2)));
DI unsigned pk2(float lo, float hi) { const f32x2 v = {lo, hi}; return __builtin_bit_cast(unsigned, __builtin_convertvector(v, bf16v2)); }
DI float bflo(unsigned u) { return __uint_as_float(u << 16); }
DI float bfhi(unsigned u) { return __uint_as_float(u & 0xffff0000u); }
DI int pk4_fp8(float a, float b, float c, float d) { int p = __builtin_amdgcn_cvt_pk_fp8_f32(fminf(fmaxf(a, -448.f), 448.f), fminf(fmaxf(b, -448.f), 448.f), 0, false);
    return __builtin_amdgcn_cvt_pk_fp8_f32(fminf(fmaxf(c, -448.f), 448.f), fminf(fmaxf(d, -448.f), 448.f), p, true); }
DI float wave_sum(float v) {
#pragma unroll
    for (int o = 1; o < 64; o <<= 1) v += __shfl_xor(v, o);
    return v;
}
DI float silu_f(float x) { return x / (1.f + __expf(-x)); }
DI float gelu_tanh(float x) { const float u = 0.7978845608028654f * (x + 0.044715f * x * x * x); const float e = __expf(2.f * u); const float t = 1.f - 2.f / (e + 1.f); return 0.5f * x * (1.f + t); }

#define XB_TMO      128
#define XB_XCNT(j)  (256  + 64 * (j))
#define XB_XSUB(j)  (1280 + 64 * (j))
#define XB_XGEN(j)  (2304 + 64 * (j))
#define XB_TOP      3328
#define XB_TOPGEN   3392
#define XCD_BAR_WORDS 3456
#define XB_SPIN_CAP (1u << 20)
DI unsigned xb_ld(unsigned* p)              { return __hip_atomic_load(p, __ATOMIC_RELAXED, __HIP_MEMORY_SCOPE_AGENT); }
DI unsigned xb_add(unsigned* p, unsigned v) { return __hip_atomic_fetch_add(p, v, __ATOMIC_RELAXED, __HIP_MEMORY_SCOPE_AGENT); }
DI unsigned xb_xcc_id() { return (unsigned)__builtin_amdgcn_s_getreg((3 << 11) | 20) & 0xFu; }
#define XB_SPIN(cond, bar) do { unsigned _sp = 0; while (cond) { __builtin_amdgcn_s_sleep(1); \
    if ((++_sp & 255u) == 0u) { if (xb_ld(&(bar)[XB_TMO])) break; if (_sp > XB_SPIN_CAP) { atomicAdd(&(bar)[XB_TMO], 1u); break; } } } } while (0)
struct XcdBarrier { unsigned* bar; unsigned x; volatile LAS unsigned* st; };
DI XcdBarrier xcd_barrier_post(unsigned* bar, volatile LAS unsigned* st) {
    XcdBarrier b; b.bar = bar; b.x = xb_xcc_id(); b.st = st;
    if (threadIdx.x == 0) (void)xb_add(&bar[XB_XCNT(b.x)], 1u);
    return b;
}
DI void xcd_barrier_complete(unsigned* bar, unsigned x, unsigned& nloc, unsigned& nx) {
    const unsigned G = gridDim.x * gridDim.y * gridDim.z;
    unsigned sum, cnt, mine, sp = 0u;
    for (;;) {
        sum = 0u; cnt = 0u; mine = 0u;
#pragma unroll
        for (unsigned j = 0; j < 16; ++j) { const unsigned c = xb_ld(&bar[XB_XCNT(j)]); sum += c; cnt += (c > 0u) ? 1u : 0u; mine = (j == x) ? c : mine; }
        if (sum == G) break;
        __builtin_amdgcn_s_sleep(1);
        if ((++sp & 255u) == 0u) { if (xb_ld(&bar[XB_TMO])) break; if (sp > XB_SPIN_CAP) { atomicAdd(&bar[XB_TMO], 1u); break; } }
    }
    nloc = mine > 0u ? mine : 1u; nx = cnt > 0u ? cnt : 1u;
}
DI void xcd_barrier(const XcdBarrier& b) {
    asm volatile("s_waitcnt vmcnt(0)" ::: "memory");
    __syncthreads();
    if (threadIdx.x == 0) {
        unsigned* bar = b.bar;
        __builtin_amdgcn_s_waitcnt(0);
        unsigned nloc = b.st[0], nx = b.st[1];
        if (nloc == 0u) { xcd_barrier_complete(bar, b.x, nloc, nx); b.st[0] = nloc; b.st[1] = nx; }
        const unsigned old = xb_add(&bar[XB_XSUB(b.x)], 1u);
        const unsigned gen = old / nloc;
        if (old + 1u == (gen + 1u) * nloc) {
            __builtin_amdgcn_fence(__ATOMIC_RELEASE, "agent");
            asm volatile("s_waitcnt vmcnt(0)" ::: "memory");
            const unsigned og = xb_add(&bar[XB_TOP], 1u);
            const unsigned tg = og / nx;
            if (og + 1u == (tg + 1u) * nx) xb_add(&bar[XB_TOPGEN], 1u);
            else XB_SPIN(xb_ld(&bar[XB_TOPGEN]) == tg, bar);
            __builtin_amdgcn_fence(__ATOMIC_ACQUIRE, "agent");
            xb_add(&bar[XB_XGEN(b.x)], 1u);
            asm volatile("s_waitcnt vmcnt(0)" ::: "memory");
        } else {
            XB_SPIN(xb_ld(&bar[XB_XGEN(b.x)]) == gen, bar);
            __builtin_amdgcn_fence(__ATOMIC_ACQUIRE, "agent");
            asm volatile("s_waitcnt vmcnt(0)" ::: "memory");
        }
    }
    __syncthreads();
}

namespace pg8 {
constexpr int BM = 256, BK = 64, HALF = 128, HTB = HALF * BK * 2, STAGE_BYTES = 8 * HTB, NXCD = 8, WGM = 8;
__host__ __device__ __forceinline__ int lds_byte(int r, int c) { const int st = (r >> 4) * 2 + (c >> 5), rr = r & 15, cc = c & 31, ob = rr * 64 + cc * 2; return st * 1024 + (ob ^ (((ob >> 9) & 1) << 5)); }
__host__ __device__ __forceinline__ void stage_rc(int b, int& R, int& C) { const int st = b / 1024, sb = b % 1024, swz = sb ^ (((sb >> 9) & 1) << 5); R = (st >> 1) * 16 + swz / 64; C = (st & 1) * 32 + (swz % 64) / 2; }
__host__ __device__ __forceinline__ int perm32(int rho) { const int n = rho >> 4, i = rho & 15; return 8 * (i >> 2) + 4 * n + (i & 3); }
struct Unit { int pm, pn; };
struct Gemm { const bf16_t* A; const bf16_t* Bt; int M, N, K, lda, ldb; };
struct StaticOrder {
    int nM, nN, nwg, G, c;
    __device__ void init(int M, int N, int G_, int c_) { nM = M / BM; nN = N / BM; nwg = nM * nN; G = G_; c = c_; }
    __device__ bool next(int i, Unit& u) const {
        const long L = (long)i * G + c; if (L >= nwg) return false;
        int wgid = (int)L; { const int q = nwg / NXCD, r = nwg % NXCD, xcd = wgid % NXCD, off = wgid / NXCD; wgid = (xcd < r ? xcd * (q + 1) : r * (q + 1) + (xcd - r) * q) + off; }
        const int nig = WGM * nN, gid = wgid / nig, fm = gid * WGM, gsz = (nM - fm) < WGM ? (nM - fm) : WGM;
        u.pm = fm + ((wgid % nig) % gsz); u.pn = (wgid % nig) / gsz; return true;
    }
};
struct EpiBf16 {
    static constexpr bool PERM = true;
    bf16_t* O; int ldc; float osc = 1.f;
    DI void operator()(const f32x4 (&acc)[2][2][4][2], const Unit& u, int wr, int wc, int fr, int fq) const {
        const int row0 = u.pm * BM + wr * 64 + fr, col0 = u.pn * BM + wc * 32 + 8 * fq;
#pragma unroll
        for (int ai = 0; ai < 2; ++ai)
#pragma unroll
            for (int m = 0; m < 4; ++m) { bf16_t* rowp = O + (size_t)(row0 + ai * HALF + m * 16) * ldc + col0;
#pragma unroll
                for (int bj = 0; bj < 2; ++bj) { const f32x4 v0 = acc[ai][bj][m][0] * osc, v1 = acc[ai][bj][m][1] * osc;
                    u32x4 w; w.x = pk2(v0[0], v0[1]); w.y = pk2(v0[2], v0[3]); w.z = pk2(v1[0], v1[1]); w.w = pk2(v1[2], v1[3]);
                    *(u32x4*)(rowp + bj * HALF) = w; } }
    }
};
struct EpiKV8 {
    static constexpr bool PERM = true;
    unsigned char* V8; float osc; unsigned char* K8; float ksc;
    DI void operator()(const f32x4 (&acc)[2][2][4][2], const Unit& u, int wr, int wc, int fr, int fq) const {
        const int row0 = u.pm * BM + wr * 64 + fr, cin = wc * 32 + 8 * fq;
#pragma unroll
        for (int ai = 0; ai < 2; ++ai)
#pragma unroll
            for (int m = 0; m < 4; ++m) { const size_t row = (size_t)(row0 + ai * HALF + m * 16);
                { const f32x4 v0 = acc[ai][0][m][0] * ksc, v1 = acc[ai][0][m][1] * ksc;
                  u32x2 w; w.x = (unsigned)pk4_fp8(v0[0], v0[1], v0[2], v0[3]); w.y = (unsigned)pk4_fp8(v1[0], v1[1], v1[2], v1[3]);
                  *(u32x2*)(K8 + row * 1024 + u.pn * 128 + cin) = w; }
                { const f32x4 v0 = acc[ai][1][m][0] * osc, v1 = acc[ai][1][m][1] * osc;
                  u32x2 w; w.x = (unsigned)pk4_fp8(v0[0], v0[1], v0[2], v0[3]); w.y = (unsigned)pk4_fp8(v1[0], v1[1], v1[2], v1[3]);
                  *(u32x2*)(V8 + row * 1024 + u.pn * 128 + cin) = w; } }
    }
};
struct EpiZ1 {
    static constexpr bool PERM = true;
    bf16_t* O; int ldc; float osc; unsigned char* K8; float ksc; unsigned char* V8;
    DI void operator()(const f32x4 (&acc)[2][2][4][2], const Unit& u, int wr, int wc, int fr, int fq) const {
        const int row0 = u.pm * BM + wr * 64 + fr, cin = wc * 32 + 8 * fq;
        if (u.pn >= 4 && u.pn < 12) {
            const bool isk = u.pn < 8; const float fs = isk ? ksc : osc; unsigned char* dst8 = isk ? (K8 + (u.pn - 4) * BM) : (V8 + (u.pn - 8) * BM);
#pragma unroll
            for (int ai = 0; ai < 2; ++ai)
#pragma unroll
                for (int m = 0; m < 4; ++m) { unsigned char* rowp = dst8 + (size_t)(row0 + ai * HALF + m * 16) * 1024 + cin;
#pragma unroll
                    for (int bj = 0; bj < 2; ++bj) { const f32x4 v0 = acc[ai][bj][m][0] * fs, v1 = acc[ai][bj][m][1] * fs;
                        u32x2 w; w.x = (unsigned)pk4_fp8(v0[0], v0[1], v0[2], v0[3]); w.y = (unsigned)pk4_fp8(v1[0], v1[1], v1[2], v1[3]);
                        *(u32x2*)(rowp + bj * HALF) = w; } }
        } else {
#pragma unroll
            for (int ai = 0; ai < 2; ++ai)
#pragma unroll
                for (int m = 0; m < 4; ++m) { bf16_t* rowp = O + (size_t)(row0 + ai * HALF + m * 16) * ldc + u.pn * BM + cin;
#pragma unroll
                    for (int bj = 0; bj < 2; ++bj) { const f32x4 v0 = acc[ai][bj][m][0] * osc, v1 = acc[ai][bj][m][1] * osc;
                        u32x4 w; w.x = pk2(v0[0], v0[1]); w.y = pk2(v0[2], v0[3]); w.z = pk2(v1[0], v1[1]); w.w = pk2(v1[2], v1[3]);
                        *(u32x4*)(rowp + bj * HALF) = w; } }
        }
    }
};
template <bool RBF16>
struct EpiResid {
    static constexpr bool PERM = true;
    bf16_t* H; const void* Rx; const void* Rc; const float* gx; const float* gc; int gstride; float osc = 1.f;
    DI void operator()(const f32x4 (&acc)[2][2][4][2], const Unit& u, int wr, int wc, int fr, int fq) const {
        const int rowt = u.pm * BM;
        const char* R; const float* g;
        constexpr int RB = RBF16 ? 2 : 4;
        if (rowt < MXR) { R = (const char*)Rx + (size_t)rowt * DM * RB; g = gx + (size_t)(rowt >> 11) * gstride; } else { R = (const char*)Rc + (size_t)(rowt - MXR) * DM * RB; g = gc; }
        bf16_t* Ho = H + (size_t)rowt * DM;
        const int rl0 = wr * 64 + fr, col0 = u.pn * BM + wc * 32 + 8 * fq;
        f32x4 gv[2][2];
#pragma unroll
        for (int bj = 0; bj < 2; ++bj)
#pragma unroll
            for (int n = 0; n < 2; ++n) gv[bj][n] = *(const f32x4*)(g + col0 + bj * HALF + 4 * n) * osc;
#pragma unroll
        for (int ai = 0; ai < 2; ++ai)
#pragma unroll
            for (int m = 0; m < 4; ++m) { const size_t ro = (size_t)(rl0 + ai * HALF + m * 16) * DM + col0;
#pragma unroll
                for (int bj = 0; bj < 2; ++bj) { f32x4 r0, r1;
                    if (RBF16) { const u32x4 rr = *(const u32x4*)(R + (ro + bj * HALF) * 2); r0 = (f32x4){bflo(rr.x), bfhi(rr.x), bflo(rr.y), bfhi(rr.y)}; r1 = (f32x4){bflo(rr.z), bfhi(rr.z), bflo(rr.w), bfhi(rr.w)}; }
                    else { r0 = *(const f32x4*)(R + (ro + bj * HALF) * 4); r1 = *(const f32x4*)(R + (ro + bj * HALF + 4) * 4); }
                    const f32x4 v0 = r0 + gv[bj][0] * acc[ai][bj][m][0], v1 = r1 + gv[bj][1] * acc[ai][bj][m][1];
                    u32x4 w; w.x = pk2(v0[0], v0[1]); w.y = pk2(v0[2], v0[3]); w.z = pk2(v1[0], v1[1]); w.w = pk2(v1[2], v1[3]);
                    *(u32x4*)(Ho + ro + bj * HALF) = w; } }
    }
};

template <class Epi, bool FP8 = false>
DI void gemm_phase(LAS unsigned char* lds, const Gemm g, const StaticOrder& S, const Epi& E) {
    const int tid = threadIdx.x, wid = __builtin_amdgcn_readfirstlane(tid >> 6), lane = tid & 63, wr = wid >> 2, wc = wid & 3, fr = lane & 15, fq = lane >> 4;
    const int K = g.K, nt = K / BK;
    unsigned voffA[2], voffB[2];
#pragma unroll
    for (int i = 0; i < 2; ++i) { int R, C; stage_rc(tid * 16 + i * 8192, R, C); const int Rb = Epi::PERM ? ((R & ~31) + perm32(R & 31)) : R;
        voffA[i] = (unsigned)(R * g.lda + C) * 2u; voffB[i] = (unsigned)(Rb * g.ldb + C) * 2u; }
    const size_t kstep = (size_t)(BK * 2);
    const size_t hA = (size_t)HALF * g.lda * 2, hB = (size_t)HALF * g.ldb * 2;
    const size_t tA = 2 * hA, tB = 2 * hB;
    const unsigned ldsw = (unsigned)wid * 1024u;
    const int aoff = lds_byte(wr * 64 + fr, fq * 8), boff = lds_byte(wc * 32 + fr, fq * 8);
#define PG8_SA(b, h) (((b) * 2 + (h)) * HTB)
#define PG8_SB(b, h) ((4 + (b) * 2 + (h)) * HTB)
#define PG8_STAGE(bufoff, gbase, voff) do { _Pragma("unroll") for (int _i = 0; _i < 2; ++_i) \
        __builtin_amdgcn_global_load_lds((const unsigned*)((const char*)(gbase) + (voff)[_i]), (LAS unsigned*)(lds + (bufoff) + ldsw + _i * 8192), 16, 0, 0); } while (0)
#define PG8_LD8(p) __builtin_shufflevector(*(const LAS u32x4*)(p), *(const LAS u32x4*)((p) + 1024), 0, 1, 2, 3, 4, 5, 6, 7)
#define PG8_LDA(dst, b, h) do { if constexpr (FP8) { _Pragma("unroll") for (int m = 0; m < 4; ++m) dst##8[m] = PG8_LD8(lds + PG8_SA(b, h) + aoff + m * 2048); } \
        else { _Pragma("unroll") for (int m = 0; m < 4; ++m) _Pragma("unroll") for (int k = 0; k < 2; ++k) dst[m][k] = *(const LAS bf16x8*)(lds + PG8_SA(b, h) + aoff + m * 2048 + k * 1024); } } while (0)
#define PG8_LDB(dst, b, h) do { if constexpr (FP8) { _Pragma("unroll") for (int n = 0; n < 2; ++n) dst##8[n] = PG8_LD8(lds + PG8_SB(b, h) + boff + n * 2048); } \
        else { _Pragma("unroll") for (int n = 0; n < 2; ++n) _Pragma("unroll") for (int k = 0; k < 2; ++k) dst[n][k] = *(const LAS bf16x8*)(lds + PG8_SB(b, h) + boff + n * 2048 + k * 1024); } } while (0)
#define PG8_MMA(ai, bj, At, Bt) do { __builtin_amdgcn_s_setprio(1); \
        if constexpr (FP8) { _Pragma("unroll") for (int m = 0; m < 4; ++m) _Pragma("unroll") for (int n = 0; n < 2; ++n) \
            asm volatile("v_mfma_scale_f32_16x16x128_f8f6f4 %0, %1, %2, %0, %3, %3 op_sel_hi:[0,0,0]" : "+v"(acc[ai][bj][m][n]) : "v"(Bt##8[n]), "v"(At##8[m]), "v"(one_scale)); } \
        else { _Pragma("unroll") for (int m = 0; m < 4; ++m) _Pragma("unroll") for (int n = 0; n < 2; ++n) _Pragma("unroll") for (int k = 0; k < 2; ++k) \
            acc[ai][bj][m][n] = __builtin_amdgcn_mfma_f32_16x16x32_bf16(Bt[n][k], At[m][k], acc[ai][bj][m][n], 0, 0, 0); } \
        __builtin_amdgcn_s_setprio(0); } while (0)
#define PG8_WAIT_V(n) asm volatile("s_waitcnt vmcnt(" #n ")" ::: "memory")
#define PG8_WAIT_L(n) asm volatile("s_waitcnt lgkmcnt(" #n ")" ::: "memory")
#define PG8_BAR __builtin_amdgcn_s_barrier()
#define PG8_SCHED __builtin_amdgcn_sched_barrier(0)
    Unit cur, nxt; int ui = 0;
    if (!S.next(0, cur)) return;
    f32x4 acc[2][2][4][2];
#pragma unroll
    for (int a = 0; a < 2; ++a)
#pragma unroll
        for (int b = 0; b < 2; ++b)
#pragma unroll
            for (int m = 0; m < 4; ++m)
#pragma unroll
                for (int n = 0; n < 2; ++n) acc[a][b][m][n] = (f32x4){0.f, 0.f, 0.f, 0.f};
    bf16x8 At[4][2], B0[2][2], B1[2][2];
    typedef unsigned u32x8 __attribute__((ext_vector_type(8))); typedef int i32x8 __attribute__((ext_vector_type(8)));
    u32x8 At8[4], B08[2], B18[2];
    const unsigned one_scale = 0x7f7f7f7fu;
    const char* cA = (const char*)g.A + (size_t)cur.pm * tA; const char* cB = (const char*)g.Bt + (size_t)cur.pn * tB;
    PG8_STAGE(PG8_SB(0, 0), cB, voffB); PG8_STAGE(PG8_SA(0, 0), cA, voffA); PG8_STAGE(PG8_SB(0, 1), cB + hB, voffB); PG8_STAGE(PG8_SA(0, 1), cA + hA, voffA);
    if (wr == 1) PG8_BAR;
    PG8_WAIT_V(4); PG8_BAR;
    PG8_STAGE(PG8_SB(1, 0), cB + kstep, voffB); PG8_STAGE(PG8_SA(1, 0), cA + kstep, voffA); PG8_STAGE(PG8_SB(1, 1), cB + hB + kstep, voffB);
    PG8_WAIT_V(6); PG8_BAR;
    for (;;) {
        const bool has_next = S.next(ui + 1, nxt);
        const char* nA = has_next ? (const char*)g.A + (size_t)nxt.pm * tA : cA; const char* nB = has_next ? (const char*)g.Bt + (size_t)nxt.pn * tB : cB;
        for (int t = 0; t < nt; t += 2) {
            const bool last = (t == nt - 2);
            const char* a1 = cA + (size_t)(t + 1) * kstep;
            const char* a2 = last ? nA : cA + (size_t)(t + 2) * kstep; const char* b2 = last ? nB : cB + (size_t)(t + 2) * kstep;
            const char* a3 = a2 + kstep; const char* b3 = b2 + kstep;
            PG8_LDB(B0, 0, 0); PG8_SCHED; PG8_LDA(At, 0, 0); PG8_STAGE(PG8_SA(1, 1), a1 + hA, voffA);
            PG8_WAIT_L(8); PG8_BAR; PG8_WAIT_L(0); PG8_MMA(0, 0, At, B0); PG8_BAR; PG8_SCHED;
            PG8_LDB(B1, 0, 1); PG8_STAGE(PG8_SB(0, 0), b2, voffB);
            PG8_BAR; PG8_WAIT_L(0); PG8_MMA(0, 1, At, B1); PG8_BAR;
            PG8_LDA(At, 0, 1); PG8_STAGE(PG8_SA(0, 0), a2, voffA);
            PG8_BAR; PG8_WAIT_L(0); PG8_MMA(1, 0, At, B0); PG8_BAR; PG8_SCHED;
            PG8_STAGE(PG8_SB(0, 1), b2 + hB, voffB);
            PG8_WAIT_V(6); PG8_BAR; PG8_MMA(1, 1, At, B1); PG8_BAR;
            PG8_LDB(B0, 1, 0); PG8_SCHED; PG8_LDA(At, 1, 0); PG8_STAGE(PG8_SA(0, 1), a2 + hA, voffA);
            PG8_WAIT_L(8); PG8_BAR; PG8_WAIT_L(0); PG8_MMA(0, 0, At, B0); PG8_BAR; PG8_SCHED;
            PG8_LDB(B1, 1, 1); PG8_STAGE(PG8_SB(1, 0), b3, voffB);
            PG8_BAR; PG8_WAIT_L(0); PG8_MMA(0, 1, At, B1); PG8_BAR;
            PG8_LDA(At, 1, 1); PG8_STAGE(PG8_SA(1, 0), a3, voffA);
            PG8_BAR; PG8_WAIT_L(0); PG8_MMA(1, 0, At, B0); PG8_BAR; PG8_SCHED;
            PG8_STAGE(PG8_SB(1, 1), b3 + hB, voffB);
            PG8_WAIT_V(6); PG8_BAR; PG8_MMA(1, 1, At, B1); PG8_BAR;
        }
        E(acc, cur, wr, wc, fr, fq);
        if (!has_next) break;
#pragma unroll
        for (int a = 0; a < 2; ++a)
#pragma unroll
            for (int b = 0; b < 2; ++b)
#pragma unroll
                for (int m = 0; m < 4; ++m)
#pragma unroll
                    for (int n = 0; n < 2; ++n) acc[a][b][m][n] = (f32x4){0.f, 0.f, 0.f, 0.f};
        cur = nxt; cA = nA; cB = nB; ++ui;
    }
    PG8_WAIT_V(0);
    if (wr == 0) PG8_BAR;
    PG8_BAR;
#undef PG8_SA
#undef PG8_SB
#undef PG8_STAGE
#undef PG8_LDA
#undef PG8_LDB
#undef PG8_MMA
#undef PG8_LD8
#undef PG8_WAIT_V
#undef PG8_WAIT_L
#undef PG8_BAR
#undef PG8_SCHED
}
}

enum { I_X = 0, I_C, I_CTX, I_CCTX, I_WMOD, I_BMOD, I_N1W, I_N2W, I_EVIN, I_EVOUT, I_GQN, I_GKN, I_HLB, I_HON, I_ODIN, I_ODOUT, I_RPB,
       I_MQN, I_MQUP, I_MKVN, I_MKVUP, I_PWQ, I_PKEYS, I_PU, I_PV, I_FNW, N_IN };
struct Args { const float* in[N_IN]; float* out; unsigned char* ws; int ph_lo, ph_hi; };
struct Frame {
    LAS unsigned char* lds;
    int tid, lane, wave, gw, ngw, G, wg;
};

constexpr float FP8_WSC = 2048.f, FP8_WSC2 = 1024.f, FP8_ASC = 16.f;
DI void transpose_item_fp8(const float* W, int K, int N, unsigned char* WT, LAS float* scr, int item, int lane, float wsc = FP8_WSC) {
    const int nblk = N / 32, kb = item / nblk, nb = item % nblk, k0 = 64 * kb, n0 = 32 * nb;
#pragma unroll 8
    for (int i = 0; i < 32; ++i) { const int kk = 2 * i + (lane >> 5); scr[kk * 33 + (lane & 31)] = W[(size_t)(k0 + kk) * N + n0 + (lane & 31)] * wsc; }
    asm volatile("s_waitcnt lgkmcnt(0)" ::: "memory");
    const int c = lane & 7;
#pragma unroll
    for (int j = 0; j < 4; ++j) { const int n = (lane >> 3) + 8 * j; const LAS float* sp = scr + (8 * c) * 33 + n;
        u32x2 o; o.x = (unsigned)pk4_fp8(sp[0 * 33], sp[1 * 33], sp[2 * 33], sp[3 * 33]); o.y = (unsigned)pk4_fp8(sp[4 * 33], sp[5 * 33], sp[6 * 33], sp[7 * 33]);
        *(u32x2*)(WT + (size_t)(n0 + n) * K + k0 + 8 * c) = o; }
    asm volatile("s_waitcnt lgkmcnt(0)" ::: "memory");
}
DI void transpose_item(const float* W, int K, int N, bf16_t* WT, LAS float* scr, int item, int lane) {
    const int nblk = N / 32, kb = item / nblk, nb = item % nblk, k0 = 64 * kb, n0 = 32 * nb;
#pragma unroll 8
    for (int i = 0; i < 32; ++i) { const int kk = 2 * i + (lane >> 5); scr[kk * 33 + (lane & 31)] = W[(size_t)(k0 + kk) * N + n0 + (lane & 31)]; }
    asm volatile("s_waitcnt lgkmcnt(0)" ::: "memory");
    const int c = lane & 7;
#pragma unroll
    for (int j = 0; j < 4; ++j) { const int n = (lane >> 3) + 8 * j; const LAS float* s = scr + (8 * c) * 33 + n;
        u32x4 o; o.x = pk2(s[0 * 33], s[1 * 33]); o.y = pk2(s[2 * 33], s[3 * 33]); o.z = pk2(s[4 * 33], s[5 * 33]); o.w = pk2(s[6 * 33], s[7 * 33]);
        *(u32x4*)(WT + (size_t)(n0 + n) * K + k0 + 8 * c) = o; }
    asm volatile("s_waitcnt lgkmcnt(0)" ::: "memory");
}
DI void cvt_bf16_stream(const Frame& F, const float* src, bf16_t* dst, size_t n) {
    const size_t nth = (size_t)F.G * 512, t0 = (size_t)F.wg * 512 + F.tid;
    for (size_t i = t0; i < n / 8; i += nth) {
        const f32x4 a = *(const f32x4*)(src + i * 8), b = *(const f32x4*)(src + i * 8 + 4);
        u32x4 o; o.x = pk2(a[0], a[1]); o.y = pk2(a[2], a[3]); o.z = pk2(b[0], b[1]); o.w = pk2(b[2], b[3]);
        *(u32x4*)(dst + i * 8) = o;
    }
}
typedef float f32x16v __attribute__((ext_vector_type(16)));
typedef float f32x32v __attribute__((ext_vector_type(32)));
typedef __bf16 bf16x32v __attribute__((ext_vector_type(32)));
typedef unsigned u32x6 __attribute__((ext_vector_type(6)));
constexpr int ROWB = 1536, SLB = 192;
DI void cvt_fp6_rows(const Frame& F, const float* src, unsigned char* dst, float* inv_scale, int nrows) {
    LAS float* stage = (LAS float*)(F.lds + F.wave * 8192);
    for (int row = F.gw; row < nrows; row += F.ngw) {
        const float* sp = src + (size_t)row * DM;
        f32x4 v[8]; float mx = 0.f;
#pragma unroll
        for (int j = 0; j < 8; ++j) { v[j] = *(const f32x4*)(sp + 4 * (F.lane + 64 * j));
            mx = fmaxf(mx, fmaxf(fmaxf(fabsf(v[j][0]), fabsf(v[j][1])), fmaxf(fabsf(v[j][2]), fabsf(v[j][3])))); }
#pragma unroll
        for (int o = 1; o < 64; o <<= 1) mx = fmaxf(mx, __shfl_xor(mx, o));
        mx = fmaxf(mx, 1e-30f);
        const float sc = exp2f(floorf(log2f(7.0f / mx)));
#pragma unroll
        for (int j = 0; j < 8; ++j) *(LAS f32x4*)(stage + 4 * (F.lane + 64 * j)) = v[j] * sc;
        asm volatile("s_waitcnt lgkmcnt(0)" ::: "memory");
        f32x16v a, b;
#pragma unroll
        for (int j = 0; j < 8; ++j) { const f32x4 t0 = *(const LAS f32x4*)(stage + 32 * F.lane + 4 * j);
            a[2 * j] = t0[0]; b[2 * j] = t0[1]; a[2 * j + 1] = t0[2]; b[2 * j + 1] = t0[3]; }
        const u32x6 p = __builtin_amdgcn_cvt_scalef32_2xpk16_fp6_f32(a, b, 1.0f);
        unsigned char* dp = dst + ((size_t)(F.lane >> 3) * 16384 + row) * SLB + 24 * (F.lane & 7);
        *(u32x2*)dp = (u32x2){p[0], p[1]}; *(u32x2*)(dp + 8) = (u32x2){p[2], p[3]}; *(u32x2*)(dp + 16) = (u32x2){p[4], p[5]};
        if (F.lane == 0) inv_scale[row] = 1.f / sc;
        asm volatile("s_waitcnt lgkmcnt(0)" ::: "memory");
    }
}
DI void mod_gemv(const Frame& F, const Args& a) {
    const float* c = a.in[I_C]; const float* cctx = a.in[I_CCTX]; const float* wmod = a.in[I_WMOD]; const float* bmod = a.in[I_BMOD];
    float* modx = (float*)(a.ws + WS_MODX); float* modc = (float*)(a.ws + WS_MODC);
    LAS float* red = (LAS float*)F.lds;
    const int r = F.lane & 31, hh = F.lane >> 5;
    for (int blk = F.wg; blk < 768; blk += F.G) {
        const int l = blk / 384, j0 = (blk % 384) * 32;
        const float* W = wmod + (size_t)l * DM * 12288 + j0;
        f32x16 acc; for (int i = 0; i < 16; ++i) acc[i] = 0.f;
        const int kbeg = F.wave * 256;
        for (int ks = 0; ks < 16; ++ks) {
            const int k0 = kbeg + ks * 16 + 8 * hh;
            float av[8];
            if (r < 17) { const float* src = (r < 16) ? c + (size_t)r * DM + k0 : cctx + k0;
                const f32x4 x0 = *(const f32x4*)src, x1 = *(const f32x4*)(src + 4);
                av[0] = silu_f(x0[0]); av[1] = silu_f(x0[1]); av[2] = silu_f(x0[2]); av[3] = silu_f(x0[3]);
                av[4] = silu_f(x1[0]); av[5] = silu_f(x1[1]); av[6] = silu_f(x1[2]); av[7] = silu_f(x1[3]);
            } else { for (int i = 0; i < 8; ++i) av[i] = 0.f; }
            u32x4 ap; ap.x = pk2(av[0], av[1]); ap.y = pk2(av[2], av[3]); ap.z = pk2(av[4], av[5]); ap.w = pk2(av[6], av[7]);
            float bv[8];
#pragma unroll
            for (int i = 0; i < 8; ++i) bv[i] = W[(size_t)(k0 + i) * 12288 + r];
            u32x4 bp; bp.x = pk2(bv[0], bv[1]); bp.y = pk2(bv[2], bv[3]); bp.z = pk2(bv[4], bv[5]); bp.w = pk2(bv[6], bv[7]);
            acc = __builtin_amdgcn_mfma_f32_32x32x16_bf16(__builtin_bit_cast(bf16x8, ap), __builtin_bit_cast(bf16x8, bp), acc, 0, 0, 0);
        }
        __syncthreads();
#pragma unroll
        for (int i = 0; i < 16; ++i) { const int row = (i & 3) + 8 * (i >> 2) + 4 * hh; red[(F.wave * 32 + row) * 32 + r] = acc[i]; }
        __syncthreads();
        for (int o = F.tid; o < 17 * 32; o += 512) { const int row = o >> 5, col = o & 31; float s = 0.f;
#pragma unroll
            for (int w = 0; w < 8; ++w) s += red[(w * 32 + row) * 32 + col];
            s += bmod[(size_t)l * 12288 + j0 + col];
            if (row < 16) modx[((size_t)l * 16 + row) * 12288 + j0 + col] = s; else modc[(size_t)l * 12288 + j0 + col] = s; }
    }
    __syncthreads();
}
DI void prologue(const Frame& F, const Args& a) {
    LAS float* scr = (LAS float*)(F.lds + 32768 + F.wave * 8704);
    unsigned char* ws = a.ws;
    constexpr int I0 = 32 * 208, I1 = 32 * 64, I2 = 32 * 130, I3 = 32 * 64, I4 = 8 * 48, I5 = 8 * 64, I6 = 32 * 64, I7 = 32 * 64;
    constexpr int NIT = I0 + I1 + I2 + I3 + I4 + I5 + I6 + I7;
    for (int it = F.gw; it < NIT; it += F.ngw) {
        int r = it;
        if (r < I0) { transpose_item_fp8(a.in[I_EVIN], 2048, 6656, ws + WS_WIN0, scr, r, F.lane); continue; } r -= I0;
        if (r < I1) { transpose_item_fp8(a.in[I_EVOUT], 2048, 2048, ws + WS_WOUT0, scr, r, F.lane); continue; } r -= I1;
        if (r < I2) { transpose_item_fp8(a.in[I_ODIN], 2048, 4160, ws + WS_WIN1, scr, r, F.lane); continue; } r -= I2;
        if (r < I3) { transpose_item_fp8(a.in[I_ODOUT], 2048, 2048, ws + WS_WOUT1, scr, r, F.lane); continue; } r -= I3;
        if (r < I4) { transpose_item_fp8(a.in[I_MQUP], 512, 1536, ws + WS_WQUP, scr, r, F.lane, FP8_WSC2); continue; } r -= I4;
        if (r < I5) { transpose_item_fp8(a.in[I_MKVUP], 512, 2048, ws + WS_WKVUP, scr, r, F.lane, FP8_WSC2); continue; } r -= I5;
        if (r < I6) { transpose_item(a.in[I_PWQ], 2048, 2048, (bf16_t*)(ws + WS_WPQ), scr, r, F.lane); continue; } r -= I6;
        transpose_item(a.in[I_PWQ] + (size_t)2048 * 2048, 2048, 2048, (bf16_t*)(ws + WS_WPQ) + (size_t)2048 * 2048, scr, r, F.lane);
    }
    { u32x4* z = (u32x4*)(ws + WS_WIN1 + (size_t)4160 * 2048); const size_t n16 = (size_t)192 * 2048 / 16;
      for (size_t i = (size_t)F.wg * 512 + F.tid; i < n16; i += (size_t)F.G * 512) z[i] = (u32x4){0u, 0u, 0u, 0u}; }
    cvt_bf16_stream(F, a.in[I_PKEYS], (bf16_t*)(ws + WS_KEYS), (size_t)2 * 8 * 2 * 128 * 128);
    __syncthreads();
    cvt_fp6_rows(F, a.in[I_PU], ws + WS_U, (float*)(ws + WS_SU), 16384);
    cvt_fp6_rows(F, a.in[I_PV], ws + WS_V, (float*)(ws + WS_SV), 16384);
    mod_gemv(F, a);
}

template <bool SRC_BF16, bool DST_FP8 = false>
DI void norm_mod_phase(const Frame& F, const void* srcX, const void* srcC, const float* nw, const float* modx_l, const float* modc_l, int sidx, bf16_t* dst, int nrows) {
    constexpr int SB = SRC_BF16 ? 2 : 4;
    for (int row = F.gw; row < nrows; row += F.ngw) {
        const char* src; const float* mod;
        if (row < MXR) { src = (const char*)srcX + (size_t)row * DM * SB; mod = modx_l + (size_t)(row >> 11) * 12288; } else { src = (const char*)srcC + (size_t)(row - MXR) * DM * SB; mod = modc_l; }
        const float* shift = mod + sidx * DM; const float* scale = shift + DM;
        f32x4 v[8]; float ss = 0.f;
#pragma unroll
        for (int j = 0; j < 4; ++j) { const int c = 8 * (F.lane + 64 * j);
            if (SRC_BF16) { const u32x4 rr = *(const u32x4*)(src + (size_t)c * 2); v[2 * j] = (f32x4){bflo(rr.x), bfhi(rr.x), bflo(rr.y), bfhi(rr.y)}; v[2 * j + 1] = (f32x4){bflo(rr.z), bfhi(rr.z), bflo(rr.w), bfhi(rr.w)}; }
            else { v[2 * j] = *(const f32x4*)(src + (size_t)c * 4); v[2 * j + 1] = *(const f32x4*)(src + (size_t)c * 4 + 16); }
#pragma unroll
            for (int q = 0; q < 2; ++q) ss += v[2 * j + q][0] * v[2 * j + q][0] + v[2 * j + q][1] * v[2 * j + q][1] + v[2 * j + q][2] * v[2 * j + q][2] + v[2 * j + q][3] * v[2 * j + q][3]; }
        const float rstd = __frsqrt_rn(wave_sum(ss) * (1.f / DM) + EPS);
        bf16_t* o = dst + (size_t)row * DM;
#pragma unroll
        for (int j = 0; j < 4; ++j) { const int c = 8 * (F.lane + 64 * j); unsigned pk[4];
#pragma unroll
            for (int q = 0; q < 2; ++q) { const f32x4 w = *(const f32x4*)(nw + c + 4 * q), sh = *(const f32x4*)(shift + c + 4 * q), sc = *(const f32x4*)(scale + c + 4 * q);
                f32x4 y;
#pragma unroll
                for (int e = 0; e < 4; ++e) y[e] = (v[2 * j + q][e] * rstd * w[e]) * (1.f + sc[e]) + sh[e];
                if (DST_FP8) pk[q] = (unsigned)pk4_fp8(y[0] * FP8_ASC, y[1] * FP8_ASC, y[2] * FP8_ASC, y[3] * FP8_ASC);
                else { pk[2 * q] = pk2(y[0], y[1]); pk[2 * q + 1] = pk2(y[2], y[3]); } }
            if (DST_FP8) *(u32x2*)((unsigned char*)dst + (size_t)row * DM + c) = (u32x2){pk[0], pk[1]};
            else *(u32x4*)(o + c) = (u32x4){pk[0], pk[1], pk[2], pk[3]}; }
    }
}

DI void rope_pair(float& a, float& bsub, int lane, int posA, int posB, float inv) {
    const float pa = __shfl_xor(a, 32), pb = __shfl_xor(bsub, 32);
    const float angA = (float)posA * inv, angB = (float)posB * inv;
    const float sA = __sinf(angA), cA = __cosf(angA), sB = __sinf(angB), cB = __cosf(angB);
    const float sg = (lane < 32) ? -1.f : 1.f;
    a = a * cA + sg * pa * sA; bsub = bsub * cB + sg * pb * sB;
}
DI void gqa_prep_phase(const Frame& F, const Args& a) {
    const bf16_t* Z = (const bf16_t*)(a.ws + WS_Z);
    const float* qn = a.in[I_GQN]; const float* kn = a.in[I_GKN];
    const float inv = exp2f(-(float)(F.lane & 31) * (13.287712379549449f / 32.f));
    const float wq0 = qn[F.lane], wq1 = qn[64 + F.lane], wk0 = kn[F.lane], wk1 = kn[64 + F.lane];
    unsigned short n0[10], n1[10];
    if (F.gw < MT) { const bf16_t* zr = Z + (size_t)F.gw * EV_IN;
#pragma unroll
        for (int hv = 0; hv < 10; ++hv) { n0[hv] = zr[hv * 128 + F.lane]; n1[hv] = zr[hv * 128 + 64 + F.lane]; } }
    for (int row = F.gw; row < MT; row += F.ngw) {
        const bool isx = row < MXR; const int t = row & 2047;
        unsigned short c0[10], c1[10];
#pragma unroll
        for (int hv = 0; hv < 10; ++hv) { c0[hv] = n0[hv]; c1[hv] = n1[hv]; }
        { const int nrow = (row + F.ngw < MT) ? row + F.ngw : row; const bf16_t* zn = Z + (size_t)nrow * EV_IN;
#pragma unroll
          for (int hv = 0; hv < 10; ++hv) { n0[hv] = zn[hv * 128 + F.lane]; n1[hv] = zn[hv * 128 + 64 + F.lane]; } }
        unsigned short o0[10], o1[10];
#pragma unroll
        for (int hv = 0; hv < 10; ++hv) {
            float v0 = __uint_as_float((unsigned)c0[hv] << 16), v1 = __uint_as_float((unsigned)c1[hv] << 16);
            const float ms = wave_sum(v0 * v0 + v1 * v1) * (1.f / 128.f);
            const float rs = __frsqrt_rn(ms + EPS);
            v0 = v0 * rs * (hv < 8 ? wq0 : wk0); v1 = v1 * rs * (hv < 8 ? wq1 : wk1);
            if (isx) rope_pair(v0, v1, F.lane, t >> 6, t & 63, inv);
            const float q8s = (hv < 8) ? QK8_SC * 1.020139447f : QK8_SC;
            o0[hv] = (unsigned short)(pk4_fp8(v0 * q8s, 0.f, 0.f, 0.f) & 0xff); o1[hv] = (unsigned short)(pk4_fp8(v1 * q8s, 0.f, 0.f, 0.f) & 0xff);
        }
        unsigned char* q8 = a.ws + WS_Q8 + (size_t)row * 1024; unsigned char* k8 = a.ws + WS_K8 + (size_t)row * 256;
#pragma unroll
        for (int hv = 0; hv < 10; ++hv) { unsigned char* dp = (hv < 8) ? (q8 + hv * 128) : (k8 + (hv - 8) * 128); dp[F.lane] = (unsigned char)o0[hv]; dp[64 + F.lane] = (unsigned char)o1[hv]; }
        { const bf16_t* zv = Z + (size_t)row * EV_IN + 1280; unsigned char* v8 = a.ws + WS_V8G + (size_t)row * 256;
#pragma unroll
          for (int q = 0; q < 4; ++q) v8[64 * q + F.lane] = (unsigned char)(pk4_fp8(__uint_as_float((unsigned)zv[64 * q + F.lane] << 16), 0.f, 0.f, 0.f) & 0xff); }
    }
}

struct AttnP {
    const bf16_t* Q; int ldq;
    const bf16_t* K1; int ldk1;
    const bf16_t* K2; int ldk2;
    const bf16_t* V; int ldv;
    unsigned char* O; int ldo;
    int qrow0;
    int orow0;
    int b;
    int nctx_tiles;
    int xtile0, nx_tiles;
    float sc_log2e;
    const float* rpb; int qgrow0;
};
template <int DK, bool NA, bool FAST>
DI void attn_unit(const Frame& F, const AttnP& p) {
    constexpr int KST = DK * 2 + 16;
    constexpr int VST = 320;
    constexpr int KBYTES = 64 * KST, VBYTES = 64 * VST;
    constexpr int NKS = DK / 16;
    constexpr int KCH = DK / 8;
    constexpr int KLD = (64 * KCH) / 512;
    LAS unsigned char* Ks = F.lds; LAS unsigned char* Vs = F.lds + KBYTES; LAS float* rp = (LAS float*)(F.lds + KBYTES + VBYTES);
    const int lane = F.lane, w = F.wave, r = lane & 31, hh = lane >> 5;
    const int ntiles = p.nctx_tiles + p.nx_tiles;
    if (NA) { for (int i = F.tid; i < 15 * 31; i += 512) rp[i] = p.rpb[i]; }
    bf16x8 qf[NKS];
    { const bf16_t* qp = p.Q + (size_t)(p.qrow0 + 32 * w + r) * p.ldq + 8 * hh;
#pragma unroll
      for (int ks = 0; ks < NKS; ++ks) qf[ks] = *(const bf16x8*)(qp + 16 * ks); }
    f32x16 oacc[4];
#pragma unroll
    for (int d = 0; d < 4; ++d) for (int i = 0; i < 16; ++i) oacc[d][i] = 0.f;
    float m_run = -1e30f, l_run = 0.f;
    u32x4 kreg[KLD], vreg[2];
#define ATT_TILE_ROW(j) (((j) < p.nctx_tiles) ? (MXR + p.b * CTXL + 64 * (j)) : (p.b * SEQ + 64 * (p.xtile0 + (j) - p.nctx_tiles)))
#define ATT_ISSUE(j) do { const int row0_ = ATT_TILE_ROW(j); \
        _Pragma("unroll") for (int i_ = 0; i_ < KLD; ++i_) { const int c_ = F.tid + 512 * i_, kr_ = c_ / KCH, kc_ = c_ % KCH; \
            if (DK == 128 || kc_ < 16) kreg[i_] = *(const u32x4*)(p.K1 + (size_t)(row0_ + kr_) * p.ldk1 + 8 * kc_); \
            else kreg[i_] = *(const u32x4*)(p.K2 + (size_t)(row0_ + kr_) * p.ldk2 + 8 * (kc_ - 16)); } \
        _Pragma("unroll") for (int i_ = 0; i_ < 2; ++i_) { const int c_ = F.tid + 512 * i_, vr_ = c_ >> 4, vc_ = c_ & 15; \
            vreg[i_] = *(const u32x4*)(p.V + (size_t)(row0_ + vr_) * p.ldv + 8 * vc_); } } while (0)
#define ATT_WRITE() do { \
        _Pragma("unroll") for (int i_ = 0; i_ < KLD; ++i_) { const int c_ = F.tid + 512 * i_, kr_ = c_ / KCH, kc_ = c_ % KCH; *(LAS u32x4*)(Ks + kr_ * KST + 16 * kc_) = kreg[i_]; } \
        _Pragma("unroll") for (int i_ = 0; i_ < 2; ++i_) { const int c_ = F.tid + 512 * i_, vr_ = c_ >> 4, vc_ = c_ & 15; *(LAS u32x4*)(Vs + vr_ * VST + 16 * vc_) = vreg[i_]; } } while (0)
    const int qgr = NA ? (p.qgrow0 + (w >> 1)) : 0;
    const int qc = 32 * (w & 1) + r;
    const int r0w = NA ? min(max(qgr - 4, 0), 24) : 0;
    const int csq = min(max(qc - 8, 0), 48);
    const int tq = (lane & 15) >> 2, tp = lane & 3, dsub = (lane >> 4) & 1;
    const unsigned vtr_base = (unsigned)(size_t)(Vs) + (unsigned)((4 * hh + tq) * VST + (16 * dsub + 4 * tp) * 2);
    const unsigned kfr_base = (unsigned)(size_t)(Ks) + (unsigned)(r * KST + 16 * hh);
    ATT_ISSUE(0);
    for (int j = 0; j < ntiles; ++j) {
        __syncthreads();
        ATT_WRITE();
        if (j + 1 < ntiles) ATT_ISSUE(j + 1);
        __syncthreads();
        bool active = true; int dr = 0;
        if (NA && j >= p.nctx_tiles) { const int kr = p.xtile0 + (j - p.nctx_tiles); active = (kr >= r0w) && (kr < r0w + 8); dr = kr - qgr + 7; }
        if (!active) continue;
        f32x16 st[2];
#pragma unroll
        for (int kb = 0; kb < 2; ++kb) for (int i = 0; i < 16; ++i) st[kb][i] = 0.f;
        {
            constexpr int NT = 2 * NKS;
            bf16x8 kr[4];
#define K_READ(R, T) asm volatile("ds_read_b128 %0, %1 offset:%2" : "=v"(R) : "v"(kfr_base), "n"(32 * ((T) / NKS) * KST + 32 * ((T) % NKS)) : "memory")
#define K_WAIT(R, N) asm volatile("s_waitcnt lgkmcnt(%1)" : "+v"(R) : "n"(N) : "memory")
            K_READ(kr[0], 0); K_READ(kr[1], 1); K_READ(kr[2], 2); K_READ(kr[3], 3);
#pragma unroll
            for (int t = 0; t < NT; ++t) {
                K_WAIT(kr[t & 3], (NT - 1 - t) < 3 ? (NT - 1 - t) : 3);
                st[t / NKS] = __builtin_amdgcn_mfma_f32_32x32x16_bf16(kr[t & 3], qf[t % NKS], st[t / NKS], 0, 0, 0);
                if (t + 4 < NT) K_READ(kr[t & 3], t + 4);
            }
#undef K_READ
#undef K_WAIT
        }
        s16x4 vlo[4], vhi[4];
#define V_READ(I, T) asm volatile("ds_read_b64_tr_b16 %0, %2 offset:%3\n\tds_read_b64_tr_b16 %1, %2 offset:%4" : "=&v"(vlo[I]), "=&v"(vhi[I]) : "v"(vtr_base), "n"(16 * ((T) >> 2) * VST + 64 * ((T) & 3)), "n"(16 * ((T) >> 2) * VST + 64 * ((T) & 3) + 8 * VST) : "memory")
#define V_WAIT(I, N) asm volatile("s_waitcnt lgkmcnt(%2)" : "+v"(vlo[I]), "+v"(vhi[I]) : "n"(N) : "memory")
        V_READ(0, 0); V_READ(1, 1); V_READ(2, 2); V_READ(3, 3);
        if constexpr (FAST) {
        float tmax = -1e30f;
        if (NA && j >= p.nctx_tiles) {
#pragma unroll
            for (int kb = 0; kb < 2; ++kb)
#pragma unroll
                for (int i = 0; i < 16; ++i) {
                    const int kc = 32 * kb + (i & 3) + 8 * (i >> 2) + 4 * hh; const bool inw = (kc >= csq) && (kc < csq + 16);
                    const int dc = min(max(kc - qc + 15, 0), 30); const float bias = rp[dr * 31 + dc];
                    const float sv = inw ? __builtin_fmaf(st[kb][i], p.sc_log2e, bias * 1.4426950408889634f) : -1e30f;
                    st[kb][i] = sv; tmax = fmaxf(tmax, sv); }
        } else {
#pragma unroll
            for (int kb = 0; kb < 2; ++kb)
#pragma unroll
                for (int i = 0; i < 16; ++i) tmax = fmaxf(tmax, st[kb][i]);
            tmax *= p.sc_log2e;
        }
        tmax = fmaxf(tmax, __shfl_xor(tmax, 32));
        if (__any(tmax > m_run + 11.5f)) {
            const float m_new = fmaxf(m_run, tmax);
            const float alpha = __builtin_amdgcn_exp2f(m_run - m_new);
            m_run = m_new; l_run *= alpha;
#pragma unroll
            for (int d = 0; d < 4; ++d)
#pragma unroll
                for (int i = 0; i < 16; ++i) oacc[d][i] *= alpha;
        }
        float psum = 0.f;
        if (NA && j >= p.nctx_tiles) {
#pragma unroll
            for (int kb = 0; kb < 2; ++kb)
#pragma unroll
                for (int i = 0; i < 16; ++i) { const float e = __builtin_amdgcn_exp2f(st[kb][i] - m_run); st[kb][i] = e; psum += e; }
        } else {
#pragma unroll
            for (int kb = 0; kb < 2; ++kb)
#pragma unroll
                for (int i = 0; i < 16; ++i) { const float e = __builtin_amdgcn_exp2f(__builtin_fmaf(st[kb][i], p.sc_log2e, -m_run)); st[kb][i] = e; psum += e; }
        }
        l_run += psum;
        } else {
        float tmax = -1e30f;
#pragma unroll
        for (int kb = 0; kb < 2; ++kb)
#pragma unroll
            for (int i = 0; i < 16; ++i) {
                float s = st[kb][i] * p.sc_log2e;
                if (NA && j >= p.nctx_tiles) { const int kc = 32 * kb + (i & 3) + 8 * (i >> 2) + 4 * hh; const bool inw = (kc >= csq) && (kc < csq + 16);
                    const int dc = min(max(kc - qc + 15, 0), 30); const float bias = rp[dr * 31 + dc];
                    s = inw ? (s + bias * 1.4426950408889634f) : -1e30f; }
                st[kb][i] = s; tmax = fmaxf(tmax, s); }
        tmax = fmaxf(tmax, __shfl_xor(tmax, 32));
        const float m_new = fmaxf(m_run, tmax);
        const float alpha = exp2f(m_run - m_new);
        m_run = m_new;
        float psum = 0.f;
#pragma unroll
        for (int kb = 0; kb < 2; ++kb)
#pragma unroll
            for (int i = 0; i < 16; ++i) { const float e = exp2f(st[kb][i] - m_new); st[kb][i] = e; psum += e; }
        l_run = l_run * alpha + psum;
#pragma unroll
        for (int d = 0; d < 4; ++d)
#pragma unroll
            for (int i = 0; i < 16; ++i) oacc[d][i] *= alpha;
        }
#pragma unroll
        for (int t = 0; t < 16; ++t) {
            const int T = t >> 2, KB = T >> 1, S = T & 1, d = t & 3;
            u32x4 pp; pp.x = pk2(st[KB][8 * S + 0], st[KB][8 * S + 1]); pp.y = pk2(st[KB][8 * S + 2], st[KB][8 * S + 3]);
            pp.z = pk2(st[KB][8 * S + 4], st[KB][8 * S + 5]); pp.w = pk2(st[KB][8 * S + 6], st[KB][8 * S + 7]);
            const bf16x8 pf = __builtin_bit_cast(bf16x8, pp);
            if (t < 13) V_WAIT(t & 3, 6); else if (t == 13) V_WAIT(t & 3, 4); else if (t == 14) V_WAIT(t & 3, 2); else V_WAIT(t & 3, 0);
            oacc[d] = __builtin_amdgcn_mfma_f32_32x32x16_bf16(__builtin_shufflevector(vlo[t & 3], vhi[t & 3], 0, 1, 2, 3, 4, 5, 6, 7), pf, oacc[d], 0, 0, 0);
            if (t + 4 < 16) {
                if ((t & 3) == 0) V_READ(0, t + 4); else if ((t & 3) == 1) V_READ(1, t + 4); else if ((t & 3) == 2) V_READ(2, t + 4); else V_READ(3, t + 4);
            }
        }
#undef V_READ
#undef V_WAIT
    }
    const float lt = l_run + __shfl_xor(l_run, 32);
    const float il = 1.f / lt;
    unsigned char* op = p.O + (size_t)(p.orow0 + 32 * w + r) * p.ldo;
    const float ils = il * FP8_ASC;
#pragma unroll
    for (int d = 0; d < 4; ++d)
#pragma unroll
        for (int g = 0; g < 4; ++g) *(int*)(op + 32 * d + 8 * g + 4 * hh) = pk4_fp8(oacc[d][4 * g + 0] * ils, oacc[d][4 * g + 1] * ils, oacc[d][4 * g + 2] * ils, oacc[d][4 * g + 3] * ils);
    __syncthreads();
#undef ATT_TILE_ROW
#undef ATT_ISSUE
#undef ATT_WRITE
}

typedef int i32x8 __attribute__((ext_vector_type(8)));
struct AttnQK8 { const unsigned char* Q8; int ldq8; const unsigned char* K8a; int ldk8a; const unsigned char* K8b; int ldk8b; const unsigned char* V8; int ldv8; };
template <int DK, bool QBF16, bool NA = false, bool QROPE = false>
DI void attn_unit_f8(const Frame& F, const AttnP& p, const AttnQK8& e) {
    constexpr int KST = DK + 16, VS8 = 144, KBYTES = 64 * KST, VBYTES = 64 * VS8;
    constexpr float QC = (DK == 192) ? 1.665880740f : 1.020139447f; constexpr int KSCALE = ((DK == 192) ? 115 : 116) * 0x01010101;
    constexpr float PTHR = 4.f;
    constexpr int NC = DK / 64, KCH = DK / 16, NCHUNK = 64 * KCH, KLD = (NCHUNK + 511) / 512, NT = 2 * NC;
    LAS unsigned char* Ks = F.lds; LAS unsigned char* Vs = F.lds + KBYTES; LAS float* rp = (LAS float*)(F.lds + KBYTES + VBYTES);
    const int lane = F.lane, w = F.wave, r = lane & 31, hh = lane >> 5;
    const int ntiles = p.nctx_tiles + p.nx_tiles;
    if (NA) { for (int i = F.tid; i < 15 * 31; i += 512) rp[i] = p.rpb[i]; }
    i32x8 qf[NC];
    if constexpr (QBF16) {
        const bf16_t* qp = p.Q + (size_t)(p.qrow0 + 32 * w + r) * p.ldq + 32 * hh;
#pragma unroll
        for (int c = 0; c < NC; ++c) {
#pragma unroll
            for (int g = 0; g < 4; ++g) { const u32x4 q4 = *(const u32x4*)(qp + 64 * c + 8 * g);
                qf[c][2 * g] = pk4_fp8(bflo(q4.x) * (QK8_SC * QC), bfhi(q4.x) * (QK8_SC * QC), bflo(q4.y) * (QK8_SC * QC), bfhi(q4.y) * (QK8_SC * QC));
                qf[c][2 * g + 1] = pk4_fp8(bflo(q4.z) * (QK8_SC * QC), bfhi(q4.z) * (QK8_SC * QC), bflo(q4.w) * (QK8_SC * QC), bfhi(q4.w) * (QK8_SC * QC)); } }
        if constexpr (QROPE) {
            float v[32];
#pragma unroll
            for (int g = 0; g < 4; ++g) { const u32x4 q4 = *(const u32x4*)(qp + 64 * (NC - 1) + 8 * g);
                v[8 * g + 0] = bflo(q4.x); v[8 * g + 1] = bfhi(q4.x); v[8 * g + 2] = bflo(q4.y); v[8 * g + 3] = bfhi(q4.y);
                v[8 * g + 4] = bflo(q4.z); v[8 * g + 5] = bfhi(q4.z); v[8 * g + 6] = bflo(q4.w); v[8 * g + 7] = bfhi(q4.w); }
            const int tpos = (p.qrow0 + 32 * w + r) & 2047; const float pos = (float)(hh ? (tpos & 63) : (tpos >> 6));
#pragma unroll
            for (int i = 0; i < 16; ++i) { const float ang = pos * exp2f(-(float)i * (13.287712379549449f / 16.f)); const float sn = __sinf(ang), cs = __cosf(ang);
                const float x0 = v[i], x1 = v[i + 16]; v[i] = x0 * cs - x1 * sn; v[i + 16] = x1 * cs + x0 * sn; }
#pragma unroll
            for (int g = 0; g < 8; ++g) qf[NC - 1][g] = pk4_fp8(v[4 * g] * (QK8_SC * QC), v[4 * g + 1] * (QK8_SC * QC), v[4 * g + 2] * (QK8_SC * QC), v[4 * g + 3] * (QK8_SC * QC));
        }
    } else {
      const unsigned char* qp = e.Q8 + (size_t)(p.qrow0 + 32 * w + r) * e.ldq8 + 32 * hh;
#pragma unroll
      for (int c = 0; c < NC; ++c) { const u32x4 qa = *(const u32x4*)(qp + 64 * c), qb = *(const u32x4*)(qp + 64 * c + 16); qf[c] = __builtin_bit_cast(i32x8, __builtin_shufflevector(qa, qb, 0, 1, 2, 3, 4, 5, 6, 7)); } }
    f32x16 oacc[4];
#pragma unroll
    for (int d = 0; d < 4; ++d) for (int i = 0; i < 16; ++i) oacc[d][i] = 0.f;
    constexpr bool LSUM = (DK == 128 && !NA);
    float l_run = 0.f;
    f32x16 lacc;
#pragma unroll
    for (int i = 0; i < 16; ++i) lacc[i] = 0.f;
    f32x16 cinit;
#pragma unroll
    for (int i = 0; i < 16; ++i) cinit[i] = 0.f;
    u32x4 kreg[KLD], vreg;
#define A8_TILE_ROW(j) (((j) < p.nctx_tiles) ? (MXR + p.b * CTXL + 64 * (j)) : (p.b * SEQ + 64 * (p.xtile0 + (j) - p.nctx_tiles)))
#define A8_ISSUE(j) do { const int row0_ = A8_TILE_ROW(j); \
        _Pragma("unroll") for (int i_ = 0; i_ < KLD; ++i_) { const int c_ = F.tid + 512 * i_, kr_ = c_ / KCH, kc_ = c_ % KCH; \
            if (c_ < NCHUNK) { if (DK == 128 || kc_ < 8) kreg[i_] = *(const u32x4*)(e.K8a + (size_t)(row0_ + kr_) * e.ldk8a + 16 * kc_); \
                               else kreg[i_] = *(const u32x4*)(e.K8b + (size_t)(row0_ + kr_) * e.ldk8b + 16 * (kc_ - 8)); } } \
        vreg = *(const u32x4*)(e.V8 + (size_t)(row0_ + (F.tid >> 3)) * e.ldv8 + 16 * (F.tid & 7)); } while (0)
#define A8_WRITE() do { \
        _Pragma("unroll") for (int i_ = 0; i_ < KLD; ++i_) { const int c_ = F.tid + 512 * i_, kr_ = c_ / KCH, kc_ = c_ % KCH; if (c_ < NCHUNK) *(LAS u32x4*)(Ks + kr_ * KST + 16 * kc_) = kreg[i_]; } \
        *(LAS u32x4*)(Vs + (F.tid >> 3) * VS8 + 16 * (F.tid & 7)) = vreg; } while (0)
    const int qgr = NA ? (p.qgrow0 + (w >> 1)) : 0;
    const int qc = 32 * (w & 1) + r;
    const int r0w = NA ? min(max(qgr - 4, 0), 24) : 0;
    const int csq = min(max(qc - 8, 0), 48);
    const unsigned vt_base = (unsigned)(size_t)(Vs) + (unsigned)((8 * (((lane & 15) >> 1) >> 2) + 4 * hh + (((lane & 15) >> 1) & 3)) * VS8 + 16 * ((lane >> 4) & 1) + 8 * (lane & 1));
    const unsigned kfr_base = (unsigned)(size_t)(Ks) + (unsigned)(r * KST + 32 * hh);
    A8_ISSUE(0);
    for (int j = 0; j < ntiles; ++j) {
        __syncthreads();
        A8_WRITE();
        if (j + 1 < ntiles) A8_ISSUE(j + 1);
        __syncthreads();
        bool active = true; int dr = 0;
        if (NA && j >= p.nctx_tiles) { const int krow = p.xtile0 + (j - p.nctx_tiles); active = (krow >= r0w) && (krow < r0w + 8); dr = krow - qgr + 7; }
        if (!active) continue;
        f32x16 st[2];
        {
            u32x4 klo[4], khi[4];
#define K8_READ(I, T) asm volatile("ds_read_b128 %0, %2 offset:%3\n\tds_read_b128 %1, %2 offset:%4" : "=&v"(klo[I]), "=&v"(khi[I]) : "v"(kfr_base), "n"(32 * ((T) / NC) * KST + 64 * ((T) % NC)), "n"(32 * ((T) / NC) * KST + 64 * ((T) % NC) + 16) : "memory")
#define K8_WAIT(I, N) asm volatile("s_waitcnt lgkmcnt(%2)" : "+v"(klo[I]), "+v"(khi[I]) : "n"(N) : "memory")
            K8_READ(0, 0); K8_READ(1, 1); K8_READ(2, 2); K8_READ(3, 3);
#pragma unroll
            for (int t = 0; t < NT; ++t) {
                const int last = (t + 3 < NT - 1) ? t + 3 : NT - 1;
                if ((t & 3) == 0) K8_WAIT(0, 2 * (last - t)); else if ((t & 3) == 1) K8_WAIT(1, 2 * (last - t)); else if ((t & 3) == 2) K8_WAIT(2, 2 * (last - t)); else K8_WAIT(3, 2 * (last - t));
                const i32x8 kf = __builtin_bit_cast(i32x8, __builtin_shufflevector(klo[t & 3], khi[t & 3], 0, 1, 2, 3, 4, 5, 6, 7));
                st[t / NC] = __builtin_amdgcn_mfma_scale_f32_32x32x64_f8f6f4(kf, qf[t % NC], (t % NC == 0) ? cinit : st[t / NC], 0, 0, 0, KSCALE, 0, 0x7f7f7f7f);
                if (t + 4 < NT) { if ((t & 3) == 0) K8_READ(0, t + 4); else if ((t & 3) == 1) K8_READ(1, t + 4); else if ((t & 3) == 2) K8_READ(2, t + 4); else K8_READ(3, t + 4); }
            }
#undef K8_READ
#undef K8_WAIT
        }
        u32x2 va[2][4];
#define V_READ(I, D) asm volatile("ds_read_b64_tr_b8 %0, %4 offset:%5\n\tds_read_b64_tr_b8 %1, %4 offset:%6\n\tds_read_b64_tr_b8 %2, %4 offset:%7\n\tds_read_b64_tr_b8 %3, %4 offset:%8" \
            : "=&v"(va[I][0]), "=&v"(va[I][1]), "=&v"(va[I][2]), "=&v"(va[I][3]) : "v"(vt_base), "n"(32 * (D)), "n"(16 * VS8 + 32 * (D)), "n"(32 * VS8 + 32 * (D)), "n"(48 * VS8 + 32 * (D)) : "memory")
#define V_WAIT(I, N) asm volatile("s_waitcnt lgkmcnt(%4)" : "+v"(va[I][0]), "+v"(va[I][1]), "+v"(va[I][2]), "+v"(va[I][3]) : "n"(N) : "memory")
        V_READ(0, 0); V_READ(1, 1);
        float tmax = -1e30f;
        const bool masked = NA && j >= p.nctx_tiles;
        if (masked) {
#pragma unroll
            for (int kb = 0; kb < 2; ++kb)
#pragma unroll
                for (int i = 0; i < 16; ++i) {
                    const int kc = 32 * kb + (i & 3) + 8 * (i >> 2) + 4 * hh; const bool inw = (kc >= csq) && (kc < csq + 16);
                    const int dc = min(max(kc - qc + 15, 0), 30); const float bias = rp[dr * 31 + dc];
                    const float sv = inw ? __builtin_fmaf(bias, 1.4426950408889634f, st[kb][i]) : -1e30f;
                    st[kb][i] = sv; tmax = fmaxf(tmax, sv); }
        } else {
#pragma unroll
            for (int kb = 0; kb < 2; ++kb)
#pragma unroll
                for (int i = 0; i < 16; ++i) tmax = fmaxf(tmax, st[kb][i]);
        }
        tmax = fmaxf(tmax, __shfl_xor(tmax, 32));
        if (j == 0 || __any(tmax > 4.f + PTHR)) {
            const float dm = (j == 0) ? (tmax - 4.f) : fmaxf(tmax - 4.f, 0.f);
            const float alpha = __builtin_amdgcn_exp2f(-dm);
            l_run *= alpha;
            if constexpr (LSUM) {
#pragma unroll
                for (int i = 0; i < 16; ++i) lacc[i] *= alpha; }
#pragma unroll
            for (int d = 0; d < 4; ++d)
#pragma unroll
                for (int i = 0; i < 16; ++i) oacc[d][i] *= alpha;
#pragma unroll
            for (int kb = 0; kb < 2; ++kb)
#pragma unroll
                for (int i = 0; i < 16; ++i) st[kb][i] -= dm;
            const float cn = cinit[0] - dm;
#pragma unroll
            for (int i = 0; i < 16; ++i) cinit[i] = cn;
        }
        float psum = 0.f;
#pragma unroll
        for (int kb = 0; kb < 2; ++kb)
#pragma unroll
            for (int i = 0; i < 16; ++i) { const float ex = __builtin_amdgcn_exp2f(st[kb][i]); st[kb][i] = ex; if constexpr (!LSUM) psum += ex; }
        l_run += psum;
        i32x8 pf;
#pragma unroll
        for (int v = 0; v < 8; ++v) { const int kb = v >> 2, m = v & 3;
            int t = __builtin_amdgcn_cvt_pk_fp8_f32(st[kb][4 * m], st[kb][4 * m + 1], 0, false); pf[v] = __builtin_amdgcn_cvt_pk_fp8_f32(st[kb][4 * m + 2], st[kb][4 * m + 3], t, true); }
        if constexpr (LSUM) { i32x8 ones; for (int v = 0; v < 8; ++v) ones[v] = 0x38383838;
            lacc = __builtin_amdgcn_mfma_scale_f32_32x32x64_f8f6f4(ones, pf, lacc, 0, 0, 0, 0x7f7f7f7f, 0, 0x7f7f7f7f); }
#pragma unroll
        for (int d = 0; d < 4; ++d) {
            if (d == 0) V_WAIT(0, 4); else if (d == 1) V_WAIT(1, 4); else if (d == 2) V_WAIT(0, 4); else V_WAIT(1, 0);
            const i32x8 vf = __builtin_bit_cast(i32x8, __builtin_shufflevector(__builtin_shufflevector(va[d & 1][0], va[d & 1][1], 0, 1, 2, 3), __builtin_shufflevector(va[d & 1][2], va[d & 1][3], 0, 1, 2, 3), 0, 1, 2, 3, 4, 5, 6, 7));
            oacc[d] = __builtin_amdgcn_mfma_scale_f32_32x32x64_f8f6f4(vf, pf, oacc[d], 0, 0, 0, 0x7f7f7f7f, 0, 0x7f7f7f7f);
            if (d == 0) V_READ(0, 2); else if (d == 1) V_READ(1, 3);
        }
#undef V_READ
#undef V_WAIT
    }
    const float lt = LSUM ? lacc[0] : (l_run + __shfl_xor(l_run, 32));
    const float il = 1.f / lt;
    unsigned char* op = p.O + (size_t)(p.orow0 + 32 * w + r) * p.ldo;
    const float ils = il * FP8_ASC;
#pragma unroll
    for (int d = 0; d < 4; ++d)
#pragma unroll
        for (int g = 0; g < 4; ++g) *(int*)(op + 32 * d + 8 * g + 4 * hh) = pk4_fp8(oacc[d][4 * g + 0] * ils, oacc[d][4 * g + 1] * ils, oacc[d][4 * g + 2] * ils, oacc[d][4 * g + 3] * ils);
    __syncthreads();
#undef A8_TILE_ROW
#undef A8_ISSUE
#undef A8_WRITE
}

DI int hg_tok_row(int b, int dir, int c, int t) {
    if (c < 8) { const int pos = 32 * c + t; return MXR + b * CTXL + (dir ? (CTXL - 1 - pos) : pos); }
    const int pos = 32 * (c - 8) + t; return b * SEQ + (dir ? (SEQ - 1 - pos) : pos);
}
DI void hgrn_pair(const Frame& F, const Args& a, int pair) {
    const int b = pair >> 3, h = pair & 7, dir = F.tid >> 8;
    const bf16_t* Z = (const bf16_t*)(a.ws + WS_Z);
    bf16_t* OUT = (bf16_t*)(a.ws + (dir ? WS_OB : WS_OF));
    LAS unsigned char* base = F.lds + dir * 65536;
    LAS float* G = (LAS float*)base;
    LAS unsigned char* QE1 = base + 16384;
    LAS unsigned char* KE = base + 25088;
    LAS unsigned char* QE2 = base + 33792;
    LAS unsigned char* KDr = base + 42496;
    LAS unsigned char* VVr = base + 51712;
    LAS float* DL = (LAS float*)(base + 60928);
    const int t256 = F.tid & 255, lane = F.lane, wl = F.wave & 3;
    const int tau = t256 >> 3, dq = (t256 & 7) * 16;
    LAS float* LB = (LAS float*)(base + 61440);
    if (t256 < 128) { const float* hl = a.in[I_HLB] + (size_t)dir * 3 * 1024 + h * 128 + t256; const float v0 = hl[0], v1 = hl[1024], v2 = hl[2048]; const float mx = fmaxf(v0, fmaxf(v1, v2));
        const float e0 = __expf(v0 - mx), e1 = __expf(v1 - mx), e2 = __expf(v2 - mx); LB[t256] = e0 / (e0 + e1 + e2); }
    __syncthreads();
    const int qcol = 1536 + h * 128 + dq, fcol = (dir ? 3584 : 2560) + h * 128 + dq, vcol = 4608 + h * 128 + dq;
    u32x4 rq[2], rf[2], rv[2];
#pragma unroll
    for (int g = 0; g < 2; ++g) {
        { const bf16_t* zr = Z + (size_t)hg_tok_row(b, dir, 0, tau) * EV_IN + 8 * g; rq[g] = *(const u32x4*)(zr + qcol); rf[g] = *(const u32x4*)(zr + fcol); rv[g] = *(const u32x4*)(zr + vcol); }
    }
    f32x4 S[2][8];
#pragma unroll
    for (int nb = 0; nb < 2; ++nb)
#pragma unroll
        for (int i = 0; i < 8; ++i) S[nb][i] = (f32x4){0.f, 0.f, 0.f, 0.f};
    const int fr = lane & 15, fg = lane >> 4;
    for (int c = 0; c < 72; ++c) {
        float kv[2][8], gv[2][8];
#pragma unroll
        for (int g = 0; g < 2; ++g) {
            const unsigned uf[4] = {rf[g].x, rf[g].y, rf[g].z, rf[g].w};
            const f32x4 lb0 = *(const LAS f32x4*)(LB + dq + 8 * g), lb1 = *(const LAS f32x4*)(LB + dq + 8 * g + 4); const float lbv[8] = {lb0[0], lb0[1], lb0[2], lb0[3], lb1[0], lb1[1], lb1[2], lb1[3]};
#pragma unroll
            for (int i = 0; i < 4; ++i) {
                const float f0 = bflo(uf[i]), f1 = bfhi(uf[i]);
                const float s0 = 1.f / (1.f + __expf(-f0)), s1 = 1.f / (1.f + __expf(-f1));
                const float l0 = lbv[2 * i], l1 = lbv[2 * i + 1];
                kv[g][2 * i] = (1.f - l0) * (1.f - s0); kv[g][2 * i + 1] = (1.f - l1) * (1.f - s1);
                gv[g][2 * i] = __logf(l0 + (1.f - l0) * s0); gv[g][2 * i + 1] = __logf(l1 + (1.f - l1) * s1); }
            *(LAS f32x4*)(G + tau * 128 + dq + 8 * g) = (f32x4){gv[g][0], gv[g][1], gv[g][2], gv[g][3]};
            *(LAS f32x4*)(G + tau * 128 + dq + 8 * g + 4) = (f32x4){gv[g][4], gv[g][5], gv[g][6], gv[g][7]}; }
        __syncthreads();
        if (t256 < 128) { float run = 0.f;
#pragma unroll
            for (int t = 0; t < 32; ++t) { run += G[t * 128 + t256]; G[t * 128 + t256] = run; } }
        __syncthreads();
#pragma unroll
        for (int g = 0; g < 2; ++g) { const int d0 = dq + 8 * g;
          const f32x4 c0 = *(const LAS f32x4*)(G + tau * 128 + d0), c1 = *(const LAS f32x4*)(G + tau * 128 + d0 + 4);
          const f32x4 m0 = *(const LAS f32x4*)(G + 15 * 128 + d0), m1 = *(const LAS f32x4*)(G + 15 * 128 + d0 + 4);
          const f32x4 e0 = *(const LAS f32x4*)(G + 31 * 128 + d0), e1 = *(const LAS f32x4*)(G + 31 * 128 + d0 + 4);
          float cu[8] = {c0[0], c0[1], c0[2], c0[3], c1[0], c1[1], c1[2], c1[3]};
          float mm[8] = {m0[0], m0[1], m0[2], m0[3], m1[0], m1[1], m1[2], m1[3]};
          float la[8] = {e0[0], e0[1], e0[2], e0[3], e1[0], e1[1], e1[2], e1[3]};
          const unsigned uq[4] = {rq[g].x, rq[g].y, rq[g].z, rq[g].w};
          float qv[8], q1[8], k1[8], q2[8], kd[8];
#pragma unroll
          for (int i = 0; i < 4; ++i) { qv[2 * i] = bflo(uq[i]); qv[2 * i + 1] = bfhi(uq[i]); }
#pragma unroll
          for (int i = 0; i < 8; ++i) { q1[i] = qv[i] * __expf(cu[i] - mm[i]); k1[i] = kv[g][i] * __expf(mm[i] - cu[i]); q2[i] = qv[i] * __expf(cu[i]); kd[i] = kv[g][i] * __expf(la[i] - cu[i]); }
          u32x4 o;
          o.x = pk2(q1[0], q1[1]); o.y = pk2(q1[2], q1[3]); o.z = pk2(q1[4], q1[5]); o.w = pk2(q1[6], q1[7]); *(LAS u32x4*)(QE1 + tau * 272 + d0 * 2) = o;
          o.x = pk2(k1[0], k1[1]); o.y = pk2(k1[2], k1[3]); o.z = pk2(k1[4], k1[5]); o.w = pk2(k1[6], k1[7]); *(LAS u32x4*)(KE + tau * 272 + d0 * 2) = o;
          o.x = pk2(q2[0], q2[1]); o.y = pk2(q2[2], q2[3]); o.z = pk2(q2[4], q2[5]); o.w = pk2(q2[6], q2[7]); *(LAS u32x4*)(QE2 + tau * 272 + d0 * 2) = o;
          o.x = pk2(kd[0], kd[1]); o.y = pk2(kd[2], kd[3]); o.z = pk2(kd[4], kd[5]); o.w = pk2(kd[6], kd[7]); *(LAS u32x4*)(KDr + tau * 288 + d0 * 2) = o;
          *(LAS u32x4*)(VVr + tau * 288 + d0 * 2) = rv[g];
          if (tau == 31) {
#pragma unroll
              for (int i = 0; i < 8; ++i) DL[d0 + i] = __expf(la[i]); } }
#pragma unroll
        for (int g = 0; g < 2; ++g) { const int cn = (c + 1 < 72) ? c + 1 : 71; const bf16_t* zr = Z + (size_t)hg_tok_row(b, dir, cn, tau) * EV_IN + 8 * g; rq[g] = *(const u32x4*)(zr + qcol); rf[g] = *(const u32x4*)(zr + fcol); rv[g] = *(const u32x4*)(zr + vcol); }
        __syncthreads();
        f32x4 X00 = {0.f, 0.f, 0.f, 0.f}, X01 = X00, X11 = X00;
#pragma unroll
        for (int ks = 0; ks < 4; ++ks) {
            const bf16x8 ke0 = *(const LAS bf16x8*)(KE + fr * 272 + (32 * ks + 8 * fg) * 2), ke1 = *(const LAS bf16x8*)(KE + (16 + fr) * 272 + (32 * ks + 8 * fg) * 2);
            const bf16x8 qe0 = *(const LAS bf16x8*)(QE1 + fr * 272 + (32 * ks + 8 * fg) * 2), qe1 = *(const LAS bf16x8*)(QE1 + (16 + fr) * 272 + (32 * ks + 8 * fg) * 2);
            X00 = __builtin_amdgcn_mfma_f32_16x16x32_bf16(ke0, qe0, X00, 0, 0, 0);
            X01 = __builtin_amdgcn_mfma_f32_16x16x32_bf16(ke0, qe1, X01, 0, 0, 0);
            X11 = __builtin_amdgcn_mfma_f32_16x16x32_bf16(ke1, qe1, X11, 0, 0, 0);
        }
#pragma unroll
        for (int i = 0; i < 4; ++i) { const bool keep = (4 * fg + i) <= fr; X00[i] = keep ? X00[i] : 0.f; X11[i] = keep ? X11[i] : 0.f; }
        u32x4 p0; p0.x = pk2(X00[0], X00[1]); p0.y = pk2(X00[2], X00[3]); p0.z = 0u; p0.w = 0u;
        u32x4 p1; p1.x = pk2(X01[0], X01[1]); p1.y = pk2(X01[2], X01[3]); p1.z = pk2(X11[0], X11[1]); p1.w = pk2(X11[2], X11[3]);
#pragma unroll
        for (int nb = 0; nb < 2; ++nb) {
            const int dvc = 32 * wl + 16 * nb;
            bf16x8 vf;
            { s16x4 v0, v1; const unsigned va = (unsigned)(size_t)VVr + (unsigned)((4 * fg + ((lane & 15) >> 2)) * 288 + (dvc + 4 * (lane & 3)) * 2);
              asm volatile("ds_read_b64_tr_b16 %0, %2\n\tds_read_b64_tr_b16 %1, %2 offset:4608\n\ts_waitcnt lgkmcnt(0)" : "=&v"(v0), "=&v"(v1) : "v"(va) : "memory");
              vf = __builtin_shufflevector(v0, v1, 0, 1, 2, 3, 4, 5, 6, 7); }
            f32x4 o0 = {0.f, 0.f, 0.f, 0.f}, o1 = o0;
            o0 = __builtin_amdgcn_mfma_f32_16x16x32_bf16(__builtin_bit_cast(bf16x8, p0), vf, o0, 0, 0, 0);
            o1 = __builtin_amdgcn_mfma_f32_16x16x32_bf16(__builtin_bit_cast(bf16x8, p1), vf, o1, 0, 0, 0);
#pragma unroll
            for (int ks = 0; ks < 4; ++ks) {
                u32x4 sp; sp.x = pk2(S[nb][2 * ks][0], S[nb][2 * ks][1]); sp.y = pk2(S[nb][2 * ks][2], S[nb][2 * ks][3]); sp.z = pk2(S[nb][2 * ks + 1][0], S[nb][2 * ks + 1][1]); sp.w = pk2(S[nb][2 * ks + 1][2], S[nb][2 * ks + 1][3]);
                const bf16x8 sf = __builtin_bit_cast(bf16x8, sp);
                const s16x4 a00 = *(const LAS s16x4*)(QE2 + fr * 272 + (32 * ks + 4 * fg) * 2), a01 = *(const LAS s16x4*)(QE2 + fr * 272 + (32 * ks + 16 + 4 * fg) * 2);
                const s16x4 a10 = *(const LAS s16x4*)(QE2 + (16 + fr) * 272 + (32 * ks + 4 * fg) * 2), a11 = *(const LAS s16x4*)(QE2 + (16 + fr) * 272 + (32 * ks + 16 + 4 * fg) * 2);
                o0 = __builtin_amdgcn_mfma_f32_16x16x32_bf16(__builtin_shufflevector(a00, a01, 0, 1, 2, 3, 4, 5, 6, 7), sf, o0, 0, 0, 0);
                o1 = __builtin_amdgcn_mfma_f32_16x16x32_bf16(__builtin_shufflevector(a10, a11, 0, 1, 2, 3, 4, 5, 6, 7), sf, o1, 0, 0, 0);
            }
#pragma unroll
            for (int db = 0; db < 8; ++db) {
                const f32x4 dl = *(const LAS f32x4*)(DL + 16 * db + 4 * fg);
                s16x4 k0, k1; { const unsigned ka = (unsigned)(size_t)KDr + (unsigned)((4 * fg + ((lane & 15) >> 2)) * 288 + (16 * db + 4 * (lane & 3)) * 2);
                  asm volatile("ds_read_b64_tr_b16 %0, %2\n\tds_read_b64_tr_b16 %1, %2 offset:4608\n\ts_waitcnt lgkmcnt(0)" : "=&v"(k0), "=&v"(k1) : "v"(ka) : "memory"); }
                f32x4 sc = S[nb][db] * dl;
                S[nb][db] = __builtin_amdgcn_mfma_f32_16x16x32_bf16(__builtin_shufflevector(k0, k1, 0, 1, 2, 3, 4, 5, 6, 7), vf, sc, 0, 0, 0);
            }
#pragma unroll
            for (int i = 0; i < 4; ++i) {
                OUT[(size_t)hg_tok_row(b, dir, c, 4 * fg + i) * 1024 + h * 128 + dvc + fr] = (bf16_t)(pk2(o0[i], 0.f) & 0xffffu);
                OUT[(size_t)hg_tok_row(b, dir, c, 16 + 4 * fg + i) * 1024 + h * 128 + dvc + fr] = (bf16_t)(pk2(o1[i], 0.f) & 0xffffu);
            }
        }
    }
    __syncthreads();
}

DI void hgrn_readout_phase(const Frame& F, const Args& a) {
    const bf16_t* OFp = (const bf16_t*)(a.ws + WS_OF); const bf16_t* OBp = (const bf16_t*)(a.ws + WS_OB);
    const bf16_t* Z = (const bf16_t*)(a.ws + WS_Z); unsigned char* Y = a.ws + WS_ACT;
    const float* wn = a.in[I_HON] + 16 * F.lane;
    float wv[16];
#pragma unroll
    for (int i = 0; i < 16; ++i) wv[i] = wn[i];
    for (int row = F.gw; row < MT; row += F.ngw) {
        const u32x4 f0 = *(const u32x4*)(OFp + (size_t)row * 1024 + 16 * F.lane), f1 = *(const u32x4*)(OFp + (size_t)row * 1024 + 16 * F.lane + 8);
        const u32x4 b0 = *(const u32x4*)(OBp + (size_t)row * 1024 + 16 * F.lane), b1 = *(const u32x4*)(OBp + (size_t)row * 1024 + 16 * F.lane + 8);
        const u32x4 g0 = *(const u32x4*)(Z + (size_t)row * EV_IN + 5632 + 16 * F.lane), g1 = *(const u32x4*)(Z + (size_t)row * EV_IN + 5632 + 16 * F.lane + 8);
        const unsigned uf[8] = {f0.x, f0.y, f0.z, f0.w, f1.x, f1.y, f1.z, f1.w}, ub[8] = {b0.x, b0.y, b0.z, b0.w, b1.x, b1.y, b1.z, b1.w}, ug[8] = {g0.x, g0.y, g0.z, g0.w, g1.x, g1.y, g1.z, g1.w};
        float o[16], gt[16]; float ss = 0.f;
#pragma unroll
        for (int i = 0; i < 8; ++i) { o[2 * i] = bflo(uf[i]) + bflo(ub[i]); o[2 * i + 1] = bfhi(uf[i]) + bfhi(ub[i]); gt[2 * i] = bflo(ug[i]); gt[2 * i + 1] = bfhi(ug[i]);
            ss += o[2 * i] * o[2 * i] + o[2 * i + 1] * o[2 * i + 1]; }
        ss += __shfl_xor(ss, 1); ss += __shfl_xor(ss, 2); ss += __shfl_xor(ss, 4);
        const float rs = __frsqrt_rn(ss * (1.f / 128.f) + EPS);
        unsigned pk[4];
#pragma unroll
        for (int i = 0; i < 4; ++i) { float y4[4];
#pragma unroll
            for (int e = 0; e < 4; ++e) y4[e] = o[4 * i + e] * rs * wv[4 * i + e] * silu_f(gt[4 * i + e]) * FP8_ASC;
            pk[i] = (unsigned)pk4_fp8(y4[0], y4[1], y4[2], y4[3]); }
        *(u32x4*)(Y + (size_t)row * DM + 1024 + 16 * F.lane) = (u32x4){pk[0], pk[1], pk[2], pk[3]};
    }
}

DI void mixer0_phase(const Frame& F, const Args& a) {
    for (int pair = F.wg; pair < 128; pair += F.G) hgrn_pair(F, a, pair);
    const bf16_t* Z = (const bf16_t*)(a.ws + WS_Z); unsigned char* Y = a.ws + WS_ACT;
    unsigned* qctr = (unsigned*)(a.ws + WS_CTL) + CW_QUEUE;
    volatile LAS unsigned* qslot = (volatile LAS unsigned*)(F.lds + LDS_MISC + 64);
    if (F.tid == 0) *qslot = __hip_atomic_fetch_add(qctr, 1u, __ATOMIC_RELAXED, __HIP_MEMORY_SCOPE_AGENT);
    __syncthreads();
    int u = (int)*qslot;
    while (u < 1024 + 128) {
        unsigned nxt = 0u;
        if (F.tid == 0) nxt = __hip_atomic_fetch_add(qctr, 1u, __ATOMIC_RELAXED, __HIP_MEMORY_SCOPE_AGENT);
        AttnP p{};
        p.ldq = EV_IN; p.ldk1 = EV_IN; p.K2 = nullptr; p.ldk2 = 0; p.ldv = EV_IN; p.ldo = DM; p.nctx_tiles = 4; p.xtile0 = 0;
        p.sc_log2e = 0.08838834764831845f * 1.4426950408889634f; p.rpb = nullptr; p.qgrow0 = 0;
        int b, head;
        if (u < 1024) { const int qb = u & 7; head = (u >> 3) & 7; b = u >> 6; p.qrow0 = b * SEQ + 256 * qb; p.nx_tiles = 32; }
        else { const int v = u - 1024; head = v & 7; b = v >> 3; p.qrow0 = MXR + b * CTXL; p.nx_tiles = 0; }
        const int kvh = head >> 2;
        p.b = b; p.orow0 = p.qrow0;
        p.Q = Z + head * 128; p.K1 = Z + 1024 + kvh * 128; p.V = Z + 1280 + kvh * 128; p.O = Y + head * 128;
        const AttnQK8 e{a.ws + WS_Q8 + head * 128, 1024, a.ws + WS_K8 + kvh * 128, 256, nullptr, 0, a.ws + WS_V8G + kvh * 128, 256};
        attn_unit_f8<128, false>(F, p, e);
        if (F.tid == 0) *qslot = nxt;
        __syncthreads();
        u = (int)*qslot;
    }
}

DI void rope64(float& v, int lane, int t, float inv16) {
    const float pv = __shfl_xor(v, 16);
    const int pos = (lane < 32) ? (t >> 6) : (t & 63);
    const float ang = (float)pos * inv16;
    const float sn = __sinf(ang), cs = __cosf(ang);
    const float sg = ((lane & 16) == 0) ? -1.f : 1.f;
    v = v * cs + sg * pv * sn;
}
DI void mla_prep_phase(const Frame& F, const Args& a) {
    bf16_t* Z = (bf16_t*)(a.ws + WS_Z);
    const float inv16 = exp2f(-(float)(F.lane & 15) * (13.287712379549449f / 16.f));
    f32x4 wq0 = *(const f32x4*)(a.in[I_MQN] + 8 * F.lane), wq1 = *(const f32x4*)(a.in[I_MQN] + 8 * F.lane + 4);
    f32x4 wk0 = *(const f32x4*)(a.in[I_MKVN] + 8 * F.lane), wk1 = *(const f32x4*)(a.in[I_MKVN] + 8 * F.lane + 4);
    for (int row = F.gw; row < MT; row += F.ngw) {
        bf16_t* zr = Z + (size_t)row * OD_INP;
#pragma unroll
        for (int part = 0; part < 2; ++part) {
            bf16_t* p = zr + 3072 + part * 512 + 8 * F.lane;
            const u32x4 u = *(const u32x4*)p; const unsigned uu[4] = {u.x, u.y, u.z, u.w};
            float v[8]; float ss = 0.f;
#pragma unroll
            for (int i = 0; i < 4; ++i) { v[2 * i] = bflo(uu[i]); v[2 * i + 1] = bfhi(uu[i]); ss += v[2 * i] * v[2 * i] + v[2 * i + 1] * v[2 * i + 1]; }
            const float rs = __frsqrt_rn(wave_sum(ss) * (1.f / 512.f) + EPS);
            const f32x4 w0 = part ? wk0 : wq0, w1 = part ? wk1 : wq1;
            u32x2 o; o.x = (unsigned)pk4_fp8(v[0] * rs * w0[0] * FP8_ASC, v[1] * rs * w0[1] * FP8_ASC, v[2] * rs * w0[2] * FP8_ASC, v[3] * rs * w0[3] * FP8_ASC);
            o.y = (unsigned)pk4_fp8(v[4] * rs * w1[0] * FP8_ASC, v[5] * rs * w1[1] * FP8_ASC, v[6] * rs * w1[2] * FP8_ASC, v[7] * rs * w1[3] * FP8_ASC);
            *(u32x2*)(a.ws + WS_ACT + (size_t)part * MT * 512 + (size_t)row * 512 + 8 * F.lane) = o;
        }
        { float v = __uint_as_float((unsigned)zr[4096 + F.lane] << 16); if (row < MXR) rope64(v, F.lane, row & 2047, inv16);
          (a.ws + WS_K8R)[(size_t)row * 64 + F.lane] = (unsigned char)(pk4_fp8(v * QK8_SC, 0.f, 0.f, 0.f) & 0xff); }
    }
}
DI void mla_qrope_phase(const Frame& F, const Args& a) {
    bf16_t* Q = (bf16_t*)(a.ws + WS_QUP);
    const float inv16 = exp2f(-(float)(F.lane & 15) * (13.287712379549449f / 16.f));
    unsigned short nx[8];
    if (F.gw < MXR) {
#pragma unroll
        for (int h = 0; h < 8; ++h) nx[h] = Q[(size_t)F.gw * 1536 + h * 192 + 128 + F.lane]; }
    for (int row = F.gw; row < MXR; row += F.ngw) {
        bf16_t* qr = Q + (size_t)row * 1536;
        unsigned short cu[8];
#pragma unroll
        for (int h = 0; h < 8; ++h) cu[h] = nx[h];
        { const int nrow = (row + F.ngw < MXR) ? row + F.ngw : row;
#pragma unroll
          for (int h = 0; h < 8; ++h) nx[h] = Q[(size_t)nrow * 1536 + h * 192 + 128 + F.lane]; }
#pragma unroll
        for (int h = 0; h < 8; ++h) { float v = __uint_as_float((unsigned)cu[h] << 16); rope64(v, F.lane, row & 2047, inv16); qr[h * 192 + 128 + F.lane] = (bf16_t)(pk2(v, 0.f) & 0xffffu); }
    }
}

DI void mixer1_phase(const Frame& F, const Args& a) {
    const bf16_t* Z = (const bf16_t*)(a.ws + WS_Z); unsigned char* Y = a.ws + WS_ACT;
    const bf16_t* QUP = (const bf16_t*)(a.ws + WS_QUP); const bf16_t* KVUP = (const bf16_t*)(a.ws + WS_KVUP);
    unsigned* qctr = (unsigned*)(a.ws + WS_CTL) + CW_QUEUE2;
    volatile LAS unsigned* qslot = (volatile LAS unsigned*)(F.lds + LDS_MISC + 64);
    if (F.tid == 0) *qslot = __hip_atomic_fetch_add(qctr, 1u, __ATOMIC_RELAXED, __HIP_MEMORY_SCOPE_AGENT);
    __syncthreads();
    int u = (int)*qslot;
    while (u < 1024) {
        unsigned nxt = 0u;
        if (F.tid == 0) nxt = __hip_atomic_fetch_add(qctr, 1u, __ATOMIC_RELAXED, __HIP_MEMORY_SCOPE_AGENT);
        AttnP p{};
        const int qb = u & 7, head = (u >> 3) & 7, b = u >> 6;
        p.b = b; p.qrow0 = b * SEQ + 256 * qb; p.orow0 = p.qrow0; p.ldo = DM; p.nctx_tiles = 4;
        p.Q = QUP + head * 192; p.ldq = 1536; p.K1 = KVUP + head * 256; p.ldk1 = 2048; p.K2 = Z + 4096; p.ldk2 = OD_INP; p.V = KVUP + head * 256 + 128; p.ldv = 2048;
        p.O = Y + 1024 + head * 128; p.xtile0 = 0; p.nx_tiles = 32; p.sc_log2e = 0.07216878364870323f * 1.4426950408889634f; p.rpb = nullptr; p.qgrow0 = 0;
        const AttnQK8 e{nullptr, 0, a.ws + WS_K8N + head * 128, 1024, a.ws + WS_K8R, 64, a.ws + WS_V8M + head * 128, 1024};
        attn_unit_f8<192, true, false, true>(F, p, e);
        if (F.tid == 0) *qslot = nxt;
        __syncthreads();
        u = (int)*qslot;
    }
    while (u < 2048) {
        unsigned nxt = 0u;
        if (F.tid == 0) nxt = __hip_atomic_fetch_add(qctr, 1u, __ATOMIC_RELAXED, __HIP_MEMORY_SCOPE_AGENT);
        AttnP p{};
        const int v = u - 1024, qb = v & 7, head = (v >> 3) & 7, b = v >> 6;
        p.b = b; p.qrow0 = b * SEQ + 256 * qb; p.orow0 = p.qrow0; p.ldo = DM; p.nctx_tiles = 4;
        p.Q = Z + head * 128; p.ldq = OD_INP; p.K1 = Z + 1024 + head * 128; p.ldk1 = OD_INP; p.K2 = nullptr; p.ldk2 = 0; p.V = Z + 2048 + head * 128; p.ldv = OD_INP;
        p.O = Y + head * 128; p.sc_log2e = 0.08838834764831845f * 1.4426950408889634f; p.rpb = a.in[I_RPB] + head * 15 * 31; p.qgrow0 = 4 * qb;
        const int rlo = min(max(4 * qb - 4, 0), 24), rhi = min(max(4 * qb + 3 - 4, 0), 24) + 8;
        p.xtile0 = rlo; p.nx_tiles = rhi - rlo;
        const AttnQK8 e{nullptr, 0, a.ws + WS_K8NA + head * 128, 1024, nullptr, 0, a.ws + WS_V8NA + head * 128, 1024};
        attn_unit_f8<128, true, true>(F, p, e);
        if (F.tid == 0) *qslot = nxt;
        __syncthreads();
        u = (int)*qslot;
    }
}

#define CEX(a, b) do { const float _hi = fmaxf(a, b), _lo = fminf(a, b); a = _hi; b = _lo; } while (0)
DI void bitonic_merge16(float (&c)[16]) {
#pragma unroll
    for (int st = 8; st >= 1; st >>= 1)
#pragma unroll
        for (int i = 0; i < 16; ++i) if ((i & st) == 0) CEX(c[i], c[i + st]);
}
DI void sort16_desc(float (&a)[16]) {
#pragma unroll
    for (int k = 2; k <= 16; k <<= 1)
#pragma unroll
        for (int j = k >> 1; j >= 1; j >>= 1)
#pragma unroll
            for (int i = 0; i < 16; ++i) { const int l = i ^ j; if (l > i) { const bool desc = (i & k) == 0;
                const float hi = fmaxf(a[i], a[l]), lo = fminf(a[i], a[l]); a[i] = desc ? hi : lo; a[l] = desc ? lo : hi; } }
}
DI void insert16(float (&a)[16], float x) {
#pragma unroll
    for (int i = 0; i < 16; ++i) { const float hi = fmaxf(a[i], x); x = fminf(a[i], x); a[i] = hi; }
}
struct CandTab { int ci[50], cj[50];
    constexpr CandTab() : ci{}, cj{} { int n = 0; for (int i = 0; i < 16; ++i) for (int j = 0; j < 16; ++j) if ((i + 1) * (j + 1) <= 16) { ci[n] = i; cj[n] = j; ++n; } } };
DI void peer_topk_wave(const Frame& F, const bf16_t* PQ, const LAS unsigned char* keysL  , int tok0, int head, int* eidx, float* gate, LAS unsigned char* scr  ) {
    const int lane = F.lane, r = lane & 31, hh = lane >> 5;
    float top[2][16];
#pragma unroll
    for (int p = 0; p < 2; ++p) {
        f32x16 st[4];
#pragma unroll
        for (int kb = 0; kb < 4; ++kb) for (int i = 0; i < 16; ++i) st[kb][i] = 0.f;
        const bf16_t* qp = PQ + (size_t)(tok0 + r) * DM + head * 256 + p * 128 + 8 * hh;
        const LAS unsigned char* kp = keysL + p * (128 * 272) + r * 272 + 16 * hh;
#pragma unroll 2
        for (int ks = 0; ks < 8; ++ks) {
            const bf16x8 qf = *(const bf16x8*)(qp + 16 * ks);
#pragma unroll
            for (int kb = 0; kb < 4; ++kb) { const bf16x8 kf = *(const LAS bf16x8*)(kp + kb * (32 * 272) + 32 * ks);
                st[kb] = __builtin_amdgcn_mfma_f32_32x32x16_bf16(kf, qf, st[kb], 0, 0, 0); }
        }
        float blk[4][16];
#pragma unroll
        for (int kb = 0; kb < 4; ++kb) {
#pragma unroll
            for (int i = 0; i < 16; ++i) { const unsigned key = 32 * kb + (i & 3) + 8 * (i >> 2) + 4 * hh; blk[kb][i] = __uint_as_float((__float_as_uint(st[kb][i]) & 0xffffff80u) | key); }
            sort16_desc(blk[kb]);
        }
        float m01[16], m23[16], aa[16];
#pragma unroll
        for (int i = 0; i < 16; ++i) { m01[i] = fmaxf(blk[0][i], blk[1][15 - i]); m23[i] = fmaxf(blk[2][i], blk[3][15 - i]); }
        bitonic_merge16(m01); bitonic_merge16(m23);
#pragma unroll
        for (int i = 0; i < 16; ++i) aa[i] = fmaxf(m01[i], m23[15 - i]);
        bitonic_merge16(aa);
        float cc[16];
#pragma unroll
        for (int i = 0; i < 16; ++i) cc[i] = fmaxf(aa[i], __shfl_xor(aa[15 - i], 32));
        bitonic_merge16(cc);
#pragma unroll
        for (int i = 0; i < 16; ++i) top[p][i] = cc[i];
    }
    LAS unsigned char* my = scr + r * 32;
#pragma unroll
    for (int p = 0; p < 2; ++p)
#pragma unroll
        for (int q4 = 0; q4 < 4; ++q4) { unsigned wv = 0;
#pragma unroll
            for (int e = 0; e < 4; ++e) wv |= (__float_as_uint(top[p][4 * q4 + e]) & 0x7fu) << (8 * e);
            *(LAS unsigned*)(my + p * 16 + 4 * q4) = wv; }
    float va[16], vb[16];
#pragma unroll
    for (int i = 0; i < 16; ++i) { va[i] = __uint_as_float(__float_as_uint(top[0][i]) & 0xffffff80u); vb[i] = __uint_as_float(__float_as_uint(top[1][i]) & 0xffffff80u); }
    float cd[16];
#pragma unroll
    for (int i = 0; i < 16; ++i) cd[i] = -3.0e38f;
#pragma unroll
    for (int k = 0; k < 25; ++k) {
        constexpr CandTab T{};
        const int i0 = T.ci[2 * k], j0 = T.cj[2 * k], i1 = T.ci[2 * k + 1], j1 = T.cj[2 * k + 1];
        const float s0 = va[i0] + vb[j0], s1 = va[i1] + vb[j1];
        const float x0 = __uint_as_float((__float_as_uint(s0) & 0xffffff00u) | (unsigned)(i0 * 16 + j0));
        const float x1 = __uint_as_float((__float_as_uint(s1) & 0xffffff00u) | (unsigned)(i1 * 16 + j1));
        insert16(cd, hh ? x1 : x0);
    }
    float cc[16];
#pragma unroll
    for (int i = 0; i < 16; ++i) cc[i] = fmaxf(cd[i], __shfl_xor(cd[15 - i], 32));
    bitonic_merge16(cc);
    float sv[16]; float den = 0.f;
    const float mx = __uint_as_float(__float_as_uint(cc[0]) & 0xffffff00u);
#pragma unroll
    for (int i = 0; i < 16; ++i) { sv[i] = __expf(__uint_as_float(__float_as_uint(cc[i]) & 0xffffff00u) - mx); den += sv[i]; }
    const float iden = 1.f / den;
    asm volatile("s_waitcnt lgkmcnt(0)" ::: "memory");
    if (hh == 0) {
        int* ep = eidx + (size_t)(tok0 + r) * 128 + head * 16; float* gp = gate + (size_t)(tok0 + r) * 128 + head * 16;
#pragma unroll
        for (int q4 = 0; q4 < 4; ++q4) { int ev[4]; float gv[4];
#pragma unroll
            for (int e = 0; e < 4; ++e) { const unsigned code = __float_as_uint(cc[4 * q4 + e]) & 0xffu; const unsigned ia = my[code >> 4], ib = my[16 + (code & 15u)];
                ev[e] = (int)(ia * 128u + ib); gv[e] = sv[4 * q4 + e] * iden; }
            *(int4*)(ep + 4 * q4) = make_int4(ev[0], ev[1], ev[2], ev[3]); *(f32x4*)(gp + 4 * q4) = (f32x4){gv[0], gv[1], gv[2], gv[3]}; }
    }
}
DI void peer_topk_phase(const Frame& F, const Args& a, int layer, int ntok) {
    const bf16_t* PQ = (const bf16_t*)(a.ws + WS_PQ); const int head = F.wg & 7;
    const bf16_t* keys = (const bf16_t*)(a.ws + WS_KEYS) + ((size_t)layer * 8 + head) * 2 * 128 * 128;
    int* eidx = (int*)(a.ws + WS_EIDX); float* gate = (float*)(a.ws + WS_GATE);
    LAS unsigned char* keysL = F.lds; LAS unsigned char* scr = F.lds + 2 * 128 * 272 + F.wave * 2048;
    for (int c = F.tid; c < 2 * 128 * 16; c += 512) { const int row = c >> 4, ch = c & 15; *(LAS u32x4*)(keysL + row * 272 + 16 * ch) = *(const u32x4*)(keys + (size_t)row * 128 + 8 * ch); }
    __syncthreads();
    const int nblk = ntok / 256;
    for (int blk = F.wg >> 3; blk < nblk; blk += F.G >> 3) peer_topk_wave(F, PQ, keysL, 256 * blk + 32 * F.wave, head, eidx, gate, scr);
    __syncthreads();
}

typedef __bf16 bf16p __attribute__((ext_vector_type(2)));
DI float fp6_dot32(const u32x6 r, const unsigned (&xw)[16]) {
    const bf16x32v d = __builtin_amdgcn_cvt_scalef32_pk32_bf16_fp6(r, 1.0f);
    float d0 = 0.f, d1 = 0.f;
#pragma unroll
    for (int i = 0; i < 8; ++i) {
        const bf16p lo = {d[4 * i], d[4 * i + 1]}, hi = {d[4 * i + 2], d[4 * i + 3]};
        d0 = __builtin_amdgcn_fdot2_f32_bf16(lo, __builtin_bit_cast(bf16p, xw[2 * i]), d0, false);
        d1 = __builtin_amdgcn_fdot2_f32_bf16(hi, __builtin_bit_cast(bf16p, xw[2 * i + 1]), d1, false);
    }
    return d0 + d1;
}
DI void fp6_axpy32(const u32x6 r, float w, f32x2 (&acc)[16]) {
    const f32x32v d = __builtin_amdgcn_cvt_scalef32_pk32_f32_fp6(r, 1.0f);
    const f32x2 w2 = {w, w};
#pragma unroll
    for (int i = 0; i < 16; ++i) { const f32x2 v2 = {d[2 * i], d[2 * i + 1]}; acc[i] = __builtin_elementwise_fma(w2, v2, acc[i]); }
}
DI u32x6 ld_row24(const unsigned char* p) { const u32x4 a = *(const u32x4*)p; const u32x2 b = *(const u32x2*)(p + 16); return (u32x6){a.x, a.y, a.z, a.w, b.x, b.y}; }
template <bool FINAL>
DI void peer_gather_phase(const Frame& F, const Args& a, int layer, int ntok) {
    const bf16_t* Fa = (const bf16_t*)(a.ws + WS_ACT); const unsigned char* U = a.ws + WS_U; const unsigned char* V = a.ws + WS_V;
    const float* SU = (const float*)(a.ws + WS_SU); const float* SV = (const float*)(a.ws + WS_SV);
    const int* eidx = (const int*)(a.ws + WS_EIDX); const float* gate = (const float*)(a.ws + WS_GATE);
    bf16_t* H = (bf16_t*)(a.ws + WS_H); float* HP = (float*)(a.ws + WS_HP);
    const float* modx = (const float*)(a.ws + WS_MODX) + (size_t)layer * 16 * 12288; const float* modc = (const float*)(a.ws + WS_MODC) + (size_t)layer * 12288;
    const int lane = F.lane, g8 = lane >> 3, p8 = lane & 7;
    LAS float* hpL = (LAS float*)(F.lds + F.wave * 13824); LAS unsigned short* eiL = (LAS unsigned short*)(F.lds + F.wave * 13824 + 18 * 512);
#pragma unroll 1
    for (int s = 0; s < 8; ++s) {
        const unsigned char* Us = U + (size_t)s * 16384 * SLB; const unsigned lo8 = 24u * (unsigned)p8;
#pragma unroll 1
        for (int tok = F.gw, kt = 0; tok < ntok; tok += F.ngw, ++kt) {
            unsigned xw[16];
            { const bf16_t* xp = Fa + (size_t)tok * DM + 256 * s + 32 * p8;
              const u32x4 x0 = *(const u32x4*)xp, x1 = *(const u32x4*)(xp + 8), x2 = *(const u32x4*)(xp + 16), x3 = *(const u32x4*)(xp + 24);
              xw[0] = x0.x; xw[1] = x0.y; xw[2] = x0.z; xw[3] = x0.w; xw[4] = x1.x; xw[5] = x1.y; xw[6] = x1.z; xw[7] = x1.w;
              xw[8] = x2.x; xw[9] = x2.y; xw[10] = x2.z; xw[11] = x2.w; xw[12] = x3.x; xw[13] = x3.y; xw[14] = x3.z; xw[15] = x3.w; }
            if (s == 0) { const int tp = 8 * (lane & 7) + (lane >> 3);
                eiL[kt * 128 + tp] = (unsigned short)eidx[(size_t)tok * 128 + lane]; eiL[kt * 128 + 64 + tp] = (unsigned short)eidx[(size_t)tok * 128 + 64 + lane]; }
            float hs[2] = {0.f, 0.f};
#pragma unroll
            for (int half = 0; half < 2; ++half) {
                u32x6 ra[8];
                const u32x4 ew = *(const LAS u32x4*)(eiL + kt * 128 + 64 * half + 8 * g8);
#pragma unroll
                for (int i = 0; i < 8; ++i) { const unsigned e = (i & 1) ? (ew[i >> 1] >> 16) : (ew[i >> 1] & 0xffffu); ra[i] = ld_row24(Us + (e * (unsigned)SLB + lo8)); }
                float d8[8];
#pragma unroll
                for (int i = 0; i < 8; ++i) d8[i] = fp6_dot32(ra[i], xw);
                float b4[4], c2[2];
                { const bool bit = (lane & 4) != 0;
#pragma unroll
                  for (int k = 0; k < 4; ++k) { const float kp = bit ? d8[4 + k] : d8[k], snd = bit ? d8[k] : d8[4 + k]; b4[k] = kp + __shfl_xor(snd, 4); } }
                { const bool bit = (lane & 2) != 0;
#pragma unroll
                  for (int k = 0; k < 2; ++k) { const float kp = bit ? b4[2 + k] : b4[k], snd = bit ? b4[k] : b4[2 + k]; c2[k] = kp + __shfl_xor(snd, 2); } }
                { const bool bit = (lane & 1) != 0; const float kp = bit ? c2[1] : c2[0], snd = bit ? c2[0] : c2[1]; hs[half] = kp + __shfl_xor(snd, 1); }
            }
            LAS float* hp = hpL + kt * 128 + lane;
            if (s > 0) { hs[0] += hp[0]; hs[1] += hp[64]; }
            hp[0] = hs[0]; hp[64] = hs[1];
        }
    }
#pragma unroll 1
    for (int s = 0; s < 8; ++s) {
        const unsigned char* Vs = V + (size_t)s * 16384 * SLB; const unsigned lo8 = 24u * (unsigned)p8;
#pragma unroll 1
        for (int tok = F.gw, kt = 0; tok < ntok; tok += F.ngw, ++kt) {
            LAS float* hp = hpL + kt * 128;
            if (s == 0) { const int e0 = eiL[kt * 128 + lane], e1 = eiL[kt * 128 + 64 + lane]; const int pp = 8 * (lane & 7) + (lane >> 3);
                hp[lane] = gate[(size_t)tok * 128 + pp] * gelu_tanh(hp[lane] * SU[e0]) * SV[e0]; hp[64 + lane] = gate[(size_t)tok * 128 + 64 + pp] * gelu_tanh(hp[64 + lane] * SU[e1]) * SV[e1]; }
            f32x2 acc[16];
#pragma unroll
            for (int i = 0; i < 16; ++i) acc[i] = (f32x2){0.f, 0.f};
#pragma unroll
            for (int half = 0; half < 2; ++half) {
                u32x6 ra[8]; float wj[8];
                const u32x4 ew = *(const LAS u32x4*)(eiL + kt * 128 + 64 * half + 8 * g8);
                const f32x4 wa = *(const LAS f32x4*)(hp + 64 * half + 8 * g8), wb = *(const LAS f32x4*)(hp + 64 * half + 8 * g8 + 4);
#pragma unroll
                for (int i = 0; i < 8; ++i) { const unsigned e = (i & 1) ? (ew[i >> 1] >> 16) : (ew[i >> 1] & 0xffffu); wj[i] = (i < 4) ? wa[i & 3] : wb[i & 3]; ra[i] = ld_row24(Vs + (e * (unsigned)SLB + lo8)); }
#pragma unroll
                for (int i = 0; i < 8; ++i) fp6_axpy32(ra[i], wj[i], acc);
            }
            float b[16], c[8]; f32x4 r4;
            { const bool bit = (lane & 32) != 0;
#pragma unroll
              for (int k = 0; k < 16; ++k) { const float lo = acc[k >> 1][k & 1], hi = acc[8 + (k >> 1)][k & 1]; const float snd = bit ? lo : hi, kp = bit ? hi : lo; b[k] = kp + __shfl_xor(snd, 32); } }
            { const bool bit = (lane & 16) != 0;
#pragma unroll
              for (int k = 0; k < 8; ++k) { const float snd = bit ? b[k] : b[8 + k], kp = bit ? b[8 + k] : b[k]; c[k] = kp + __shfl_xor(snd, 16); } }
            { const bool bit = (lane & 8) != 0;
#pragma unroll
              for (int k = 0; k < 4; ++k) { const float snd = bit ? c[k] : c[4 + k], kp = bit ? c[4 + k] : c[k]; r4[k] = kp + __shfl_xor(snd, 8); } }
            const float* g5 = ((tok < MXR) ? (modx + (size_t)(tok >> 11) * 12288) : modc) + 5 * DM;
            const int col = 256 * s + 32 * p8 + 4 * g8;
            bf16_t* hrow = H + (size_t)tok * DM;
            const u32x2 hb = *(const u32x2*)(hrow + col); const f32x4 h4 = {bflo(hb.x), bfhi(hb.x), bflo(hb.y), bfhi(hb.y)}, gg = *(const f32x4*)(g5 + col);
            { const f32x4 y4 = h4 + gg * r4; u32x2 ob; ob.x = pk2(y4[0], y4[1]); ob.y = pk2(y4[2], y4[3]); *(u32x2*)(hrow + col) = ob; }
            if (!FINAL && s == 7) {
                asm volatile("s_waitcnt vmcnt(0)" ::: "memory");
                f32x4 v[8]; float ss = 0.f;
#pragma unroll
                for (int j = 0; j < 8; ++j) { const u32x2 hb2 = *(const u32x2*)(hrow + 4 * (lane + 64 * j)); v[j] = (f32x4){bflo(hb2.x), bfhi(hb2.x), bflo(hb2.y), bfhi(hb2.y)}; ss += v[j][0] * v[j][0] + v[j][1] * v[j][1] + v[j][2] * v[j][2] + v[j][3] * v[j][3]; }
                const float rs = __frsqrt_rn(wave_sum(ss) * (1.f / DM) + EPS);
                const float* nw = a.in[I_N1W] + (size_t)(layer + 1) * DM;
                const float* mod1 = (tok < MXR) ? ((const float*)(a.ws + WS_MODX) + ((size_t)(layer + 1) * 16 + (tok >> 11)) * 12288) : ((const float*)(a.ws + WS_MODC) + (size_t)(layer + 1) * 12288);
                bf16_t* ao = (bf16_t*)(a.ws + WS_ACT) + (size_t)tok * DM;
#pragma unroll
                for (int j = 0; j < 8; ++j) { const int cc = 4 * (lane + 64 * j); const f32x4 w4 = *(const f32x4*)(nw + cc), sh = *(const f32x4*)(mod1 + cc), sc4 = *(const f32x4*)(mod1 + DM + cc);
                    f32x4 y;
#pragma unroll
                    for (int e = 0; e < 4; ++e) y[e] = (v[j][e] * rs * w4[e]) * (1.f + sc4[e]) + sh[e];
                    *(int*)((unsigned char*)(a.ws + WS_A8) + (size_t)tok * DM + cc) = pk4_fp8(y[0] * FP8_ASC, y[1] * FP8_ASC, y[2] * FP8_ASC, y[3] * FP8_ASC); }
            }
            if (FINAL && s == 7) {
                asm volatile("s_waitcnt vmcnt(0)" ::: "memory");
                f32x4 v[8]; float ss = 0.f;
#pragma unroll
                for (int j = 0; j < 8; ++j) { const u32x2 hb2 = *(const u32x2*)(hrow + 4 * (lane + 64 * j)); v[j] = (f32x4){bflo(hb2.x), bfhi(hb2.x), bflo(hb2.y), bfhi(hb2.y)}; ss += v[j][0] * v[j][0] + v[j][1] * v[j][1] + v[j][2] * v[j][2] + v[j][3] * v[j][3]; }
                const float rs = __frsqrt_rn(wave_sum(ss) * (1.f / DM) + EPS);
                const float* fw = a.in[I_FNW]; float* op = a.out + (size_t)tok * DM;
#pragma unroll
                for (int j = 0; j < 8; ++j) { const int cc = 4 * (lane + 64 * j); const f32x4 w4 = *(const f32x4*)(fw + cc);
                    f32x4 ov = v[j] * rs * w4;
#if DBG_SANITIZE
                    for (int e = 0; e < 4; ++e) if (!(fabsf(ov[e]) < 1e30f)) ov[e] = 1.0e4f;
#endif
                    *(f32x4*)(op + cc) = ov; }
            }
        }
    }
}

__global__ void __launch_bounds__(512, 2) fwd_kernel(Args args) {
    extern __shared__ __attribute__((aligned(16))) unsigned char lds_raw[];
    Frame F;
    F.lds = (LAS unsigned char*)lds_raw;
    F.tid = threadIdx.x; F.lane = F.tid & 63; F.wave = __builtin_amdgcn_readfirstlane(F.tid >> 6);
    F.G = gridDim.x; F.wg = blockIdx.x; F.gw = F.wg * 8 + F.wave; F.ngw = F.G * 8;
    volatile LAS unsigned* MISC = (volatile LAS unsigned*)(F.lds + LDS_MISC);
    if (F.tid < 4) MISC[F.tid] = 0u;
    __syncthreads();
    unsigned char* ws = args.ws;
    const int lo = args.ph_lo, hi = args.ph_hi;
    XcdBarrier bar; bar.bar = (unsigned*)(ws + WS_CTL) + CW_BAR; bar.x = 0; bar.st = nullptr;
    if (hi - lo > 1) bar = xcd_barrier_post((unsigned*)(ws + WS_CTL) + CW_BAR, MISC);
#ifndef PH_MASK
#define PH_MASK 0xffffffffu
#endif
#define IN(k) ((((PH_MASK) >> (k)) & 1u) && lo <= (k) && (k) < hi)
#define SEAM(k) do { if (IN(k) && IN((k) + 1)) xcd_barrier(bar); } while (0)
    const float* modx = (const float*)(ws + WS_MODX); const float* modc = (const float*)(ws + WS_MODC);
    bf16_t* ACT = (bf16_t*)(ws + WS_ACT); bf16_t* H = (bf16_t*)(ws + WS_H); bf16_t* Z = (bf16_t*)(ws + WS_Z);

#define REP2(k) if (((DBG_REPMASK) >> (k)) & 1u)
#define P0_BODY  { prologue(F, args); }
#define P1_BODY  { norm_mod_phase<false, true>(F, args.in[I_X], args.in[I_CTX], args.in[I_N1W], modx, modc, 0, ACT, MT); }
#define P2_BODY  { pg8::Gemm g{ACT, (const bf16_t*)(ws + WS_WIN0), MT, EV_IN, DM / 2, DM / 2, DM / 2}; pg8::StaticOrder S; S.init(MT, EV_IN, F.G, F.wg); \
        pg8::EpiBf16 E{Z, EV_IN, 1.f / (FP8_WSC * FP8_ASC)}; pg8::gemm_phase<pg8::EpiBf16, true>(F.lds, g, S, E); }
#define P3_BODY  { gqa_prep_phase(F, args); }
#define P4_BODY  { mixer0_phase(F, args); }
#define P5_BODY  { hgrn_readout_phase(F, args); }
#define P6_BODY  { pg8::Gemm g{ACT, (const bf16_t*)(ws + WS_WOUT0), MT, DM, DM / 2, DM / 2, DM / 2}; pg8::StaticOrder S; S.init(MT, DM, F.G, F.wg); \
        pg8::EpiResid<false> E{H, args.in[I_X], args.in[I_CTX], modx + 2 * DM, modc + 2 * DM, 12288, 1.f / (FP8_WSC * FP8_ASC)}; pg8::gemm_phase<pg8::EpiResid<false>, true>(F.lds, g, S, E); }
#define P7_BODY  { norm_mod_phase<true>(F, H, H + (size_t)MXR * DM, args.in[I_N2W], modx, modc, 3, ACT, MT); }
#define P8_BODY  { pg8::Gemm g{ACT, (const bf16_t*)(ws + WS_WPQ), MT, DM, DM, DM, DM}; pg8::StaticOrder S; S.init(MT, DM, F.G, F.wg); \
        pg8::EpiBf16 E{(bf16_t*)(ws + WS_PQ), DM}; pg8::gemm_phase(F.lds, g, S, E); }
#define P9_BODY  { peer_topk_phase(F, args, 0, MT); }
#define P10_BODY { peer_gather_phase<false>(F, args, 0, MT); }
#define P11_BODY { }
#define P12_BODY { pg8::Gemm g{(const bf16_t*)(ws + WS_A8), (const bf16_t*)(ws + WS_WIN1), MT, OD_INP, DM / 2, DM / 2, DM / 2}; pg8::StaticOrder S; S.init(MT, OD_INP, F.G, F.wg); \
        pg8::EpiZ1 E{Z, OD_INP, 1.f / (FP8_WSC * FP8_ASC), ws + WS_K8NA, QK8_SC / (FP8_WSC * FP8_ASC), ws + WS_V8NA}; pg8::gemm_phase<pg8::EpiZ1, true>(F.lds, g, S, E); }
#define P13_BODY { mla_prep_phase(F, args); }
#define P14_BODY { \
        { pg8::Gemm g{ACT, (const bf16_t*)(ws + WS_WQUP), MXR, 1536, 256, 256, 256}; pg8::StaticOrder S; S.init(MXR, 1536, F.G, F.wg); \
          pg8::EpiBf16 E{(bf16_t*)(ws + WS_QUP), 1536, 1.f / (FP8_WSC2 * FP8_ASC)}; pg8::gemm_phase<pg8::EpiBf16, true>(F.lds, g, S, E); } \
        { pg8::Gemm g{(const bf16_t*)(ws + WS_ACT + (size_t)MT * 512), (const bf16_t*)(ws + WS_WKVUP), MT, 2048, 256, 256, 256}; pg8::StaticOrder S; S.init(MT, 2048, F.G, F.wg); \
          pg8::EpiKV8 E{ws + WS_V8M, 1.f / (FP8_WSC2 * FP8_ASC), ws + WS_K8N, QK8_SC / (FP8_WSC2 * FP8_ASC)}; pg8::gemm_phase<pg8::EpiKV8, true>(F.lds, g, S, E); } }
#define P15_BODY { }
#define P16_BODY { mixer1_phase(F, args); }
#define P17_BODY { pg8::Gemm g{ACT, (const bf16_t*)(ws + WS_WOUT1), MXR, DM, DM / 2, DM / 2, DM / 2}; pg8::StaticOrder S; S.init(MXR, DM, F.G, F.wg); \
        pg8::EpiResid<true> E{H, H, H, modx + (size_t)16 * 12288 + 2 * DM, modc + 12288 + 2 * DM, 12288, 1.f / (FP8_WSC * FP8_ASC)}; pg8::gemm_phase<pg8::EpiResid<true>, true>(F.lds, g, S, E); }
#define P18_BODY { norm_mod_phase<true>(F, H, H, args.in[I_N2W] + DM, modx + (size_t)16 * 12288, modc + 12288, 3, ACT, MXR); \
        cvt_fp6_rows(F, args.in[I_PU] + (size_t)16384 * 2048, ws + WS_U, (float*)(ws + WS_SU), 16384); \
        cvt_fp6_rows(F, args.in[I_PV] + (size_t)16384 * 2048, ws + WS_V, (float*)(ws + WS_SV), 16384); }
#define P19_BODY { pg8::Gemm g{ACT, (const bf16_t*)(ws + WS_WPQ) + (size_t)2048 * 2048, MXR, DM, DM, DM, DM}; pg8::StaticOrder S; S.init(MXR, DM, F.G, F.wg); \
        pg8::EpiBf16 E{(bf16_t*)(ws + WS_PQ), DM}; pg8::gemm_phase(F.lds, g, S, E); }
#define P20_BODY { peer_topk_phase(F, args, 1, MXR); }
#define P21_BODY { peer_gather_phase<true>(F, args, 1, MXR); }
#define PHASE(k, BODY) if (IN(k)) { BODY REP2(k) BODY }
    PHASE(0, P0_BODY) SEAM(0);
    PHASE(1, P1_BODY) SEAM(1);
    PHASE(2, P2_BODY) SEAM(2);
    PHASE(3, P3_BODY) SEAM(3);
    PHASE(4, P4_BODY) SEAM(4);
    PHASE(5, P5_BODY) SEAM(5);
    PHASE(6, P6_BODY) SEAM(6);
    PHASE(7, P7_BODY) SEAM(7);
    PHASE(8, P8_BODY) SEAM(8);
    PHASE(9, P9_BODY) SEAM(9);
    PHASE(10, P10_BODY)
    PHASE(11, P11_BODY) SEAM(11);
    PHASE(12, P12_BODY) SEAM(12);
    PHASE(13, P13_BODY) SEAM(13);
    PHASE(14, P14_BODY)
    PHASE(15, P15_BODY) SEAM(15);
    PHASE(16, P16_BODY) SEAM(16);
    PHASE(17, P17_BODY) SEAM(17);
    PHASE(18, P18_BODY) SEAM(18);
    PHASE(19, P19_BODY) SEAM(19);
    PHASE(20, P20_BODY) SEAM(20);
    PHASE(21, P21_BODY)
#undef IN
#undef SEAM
}

extern "C" void kernel_launch(void* const* d_in, const int* in_sizes, int n_in, void* d_out, int out_size, void* d_ws, size_t ws_size, hipStream_t stream) {
    static int grid = 0;
    if (grid == 0) {
        if (n_in != N_IN || ws_size < WS_END) { fprintf(stderr, "kernel_launch: unexpected n_in %d or ws_size %zu (< %zu)\n", n_in, ws_size, (size_t)WS_END); grid = -1; return; }
        int dev = 0, cus = 0, per_cu = 0;
        if (hipGetDevice(&dev) != hipSuccess || hipDeviceGetAttribute(&cus, hipDeviceAttributeMultiprocessorCount, dev) != hipSuccess) { grid = -1; return; }
        if (hipFuncSetAttribute((const void*)fwd_kernel, hipFuncAttributeMaxDynamicSharedMemorySize, LDS_BYTES) != hipSuccess) { fprintf(stderr, "kernel_launch: hipFuncSetAttribute failed\n"); grid = -1; return; }
        if (hipOccupancyMaxActiveBlocksPerMultiprocessor(&per_cu, (const void*)fwd_kernel, 512, LDS_BYTES) != hipSuccess || per_cu < 1) { fprintf(stderr, "kernel_launch: occupancy query says %d\n", per_cu); }
        (void)hipGetLastError();
        if (cus < 256) { fprintf(stderr, "kernel_launch: this build is laid out for 256 CUs (MI355X); found %d\n", cus); grid = -1; return; }
        grid = 256;
    }
    if (grid < 0) return;
    (void)hipMemsetAsync((char*)d_ws + WS_CTL, 0, CTL_ZERO_BYTES, stream);
    Args a{};
    for (int i = 0; i < N_IN; ++i) a.in[i] = (const float*)d_in[i];
    a.out = (float*)d_out; a.ws = (unsigned char*)d_ws;
#if MK_N_LAUNCHES == 1
    a.ph_lo = 0; a.ph_hi = NPHASE;
    hipLaunchKernelGGL(fwd_kernel, dim3(grid), dim3(512), LDS_BYTES, stream, a);
#else
    for (int ph = 0; ph < NPHASE; ++ph) { a.ph_lo = ph; a.ph_hi = ph + 1; hipLaunchKernelGGL(fwd_kernel, dim3(grid), dim3(512), LDS_BYTES, stream, a); }
#endif
}
```

```cpp
#include <hip/hip_runtime.h>
#include <cstdio>
#include <cstdint>

#define DBG_SANITIZE 0
#ifndef DBG_REPMASK
#define DBG_REPMASK 0u
#endif
#ifndef MK_N_LAUNCHES
#define MK_N_LAUNCHES 1
#endif

#define DI __device__ __forceinline__
#define LAS __attribute__((address_space(3)))
typedef unsigned short bf16_t;
typedef short bf16x8 __attribute__((ext_vector_type(8)));
typedef short s16x4 __attribute__((ext_vector_type(4)));
typedef float f32x4 __attribute__((ext_vector_type(4)));
typedef float f32x16 __attribute__((ext_vector_type(16)));
typedef unsigned u32x4 __attribute__((ext_vector_type(4)));
typedef unsigned u32x2 __attribute__((ext_vector_type(2)));

constexpr int DM = 2048, NBATCH = 16, SEQ = 2048, CTXL = 256;
constexpr int MXR = NBATCH * SEQ;
constexpr int MCR = NBATCH * CTXL;
constexpr int MT = MXR + MCR;
constexpr int EV_IN = 6656, OD_IN = 4160, OD_INP = 4352;
constexpr float EPS = 1e-6f;
constexpr int NPHASE = 22;

constexpr size_t MiB = 1u << 20;
constexpr size_t WS_CTL = 0, CTL_ZERO_BYTES = 1 * MiB;
constexpr size_t WS_MODX = 1 * MiB;
constexpr size_t WS_MODC = WS_MODX + (size_t)2 * 16 * 12288 * 4;
constexpr size_t WS_WIN0 = 4 * MiB;
constexpr size_t WS_WOUT0 = 30 * MiB;
constexpr size_t WS_WIN1 = 38 * MiB;
constexpr size_t WS_WOUT1 = 55 * MiB;
constexpr size_t WS_WQUP = 63 * MiB;
constexpr size_t WS_WKVUP = 65 * MiB;
constexpr size_t WS_WPQ = 67 * MiB;
constexpr size_t WS_KEYS = 83 * MiB;
constexpr size_t WS_U = 84 * MiB, WS_V = 148 * MiB;
constexpr size_t WS_SU = 3 * MiB, WS_SV = 3 * MiB + 65536;
constexpr size_t WS_QUP = 84 * MiB;
constexpr size_t WS_ACT = 212 * MiB;
constexpr size_t WS_H = 356 * MiB;
constexpr size_t WS_OF = 356 * MiB, WS_OB = 428 * MiB;
constexpr size_t WS_A8 = 500 * MiB;
constexpr size_t WS_Q8 = 500 * MiB, WS_K8 = 540 * MiB;
constexpr size_t WS_K8N = 500 * MiB, WS_K8R = 540 * MiB;
constexpr size_t WS_K8NA = 572 * MiB;
constexpr size_t WS_V8G = 552 * MiB, WS_V8NA = 608 * MiB, WS_V8M = 950 * MiB;
constexpr float QK8_SC = 16.f;
constexpr size_t WS_Z = 644 * MiB;
constexpr size_t WS_PQ = 644 * MiB;
constexpr size_t WS_EIDX = 788 * MiB, WS_GATE = 806 * MiB;
constexpr size_t WS_HP = 824 * MiB;
constexpr size_t WS_KVUP = 950 * MiB;
constexpr size_t WS_END = 1112 * MiB;
constexpr int CW_BAR = 4096;
constexpr int CW_QUEUE2 = 8192 + 64;
constexpr int CW_QUEUE = 8192;

constexpr int LDS_BYTES = 147456;
constexpr int LDS_MISC = 131072 + 1024;

typedef __bf16 bf16v2 __attribute__((ext_vector_type(2)));
typedef float f32x2 __attribute__((ext_vector_type(2)));
DI unsigned pk2(float lo, float hi) { const f32x2 v = {lo, hi}; return __builtin_bit_cast(unsigned, __builtin_convertvector(v, bf16v2)); }
DI float bflo(unsigned u) { return __uint_as_float(u << 16); }
DI float bfhi(unsigned u) { return __uint_as_float(u & 0xffff0000u); }
DI int pk4_fp8(float a, float b, float c, float d) { int p = __builtin_amdgcn_cvt_pk_fp8_f32(fminf(fmaxf(a, -448.f), 448.f), fminf(fmaxf(b, -448.f), 448.f), 0, false);
    return __builtin_amdgcn_cvt_pk_fp8_f32(fminf(fmaxf(c, -448.f), 448.f), fminf(fmaxf(d, -448.f), 448.f), p, true); }
DI float wave_sum(float v) {
#pragma unroll
    for (int o = 1; o < 64; o <<= 1) v += __shfl_xor(v, o);
    return v;
}
DI float silu_f(float x) { return x / (1.f + __expf(-x)); }
DI float gelu_tanh(float x) { const float u = 0.7978845608028654f * (x + 0.044715f * x * x * x); const float e = __expf(2.f * u); const float t = 1.f - 2.f / (e + 1.f); return 0.5f * x * (1.f + t); }

#define XB_TMO      128
#define XB_XCNT(j)  (256  + 64 * (j))
#define XB_XSUB(j)  (1280 + 64 * (j))
#define XB_XGEN(j)  (2304 + 64 * (j))
#define XB_TOP      3328
#define XB_TOPGEN   3392
#define XCD_BAR_WORDS 3456
#define XB_SPIN_CAP (1u << 20)
DI unsigned xb_ld(unsigned* p)              { return __hip_atomic_load(p, __ATOMIC_RELAXED, __HIP_MEMORY_SCOPE_AGENT); }
DI unsigned xb_add(unsigned* p, unsigned v) { return __hip_atomic_fetch_add(p, v, __ATOMIC_RELAXED, __HIP_MEMORY_SCOPE_AGENT); }
DI unsigned xb_xcc_id() { return (unsigned)__builtin_amdgcn_s_getreg((3 << 11) | 20) & 0xFu; }
#define XB_SPIN(cond, bar) do { unsigned _sp = 0; while (cond) { __builtin_amdgcn_s_sleep(1); \
    if ((++_sp & 255u) == 0u) { if (xb_ld(&(bar)[XB_TMO])) break; if (_sp > XB_SPIN_CAP) { atomicAdd(&(bar)[XB_TMO], 1u); break; } } } } while (0)
struct XcdBarrier { unsigned* bar; unsigned x; volatile LAS unsigned* st; };
DI XcdBarrier xcd_barrier_post(unsigned* bar, volatile LAS unsigned* st) {
    XcdBarrier b; b.bar = bar; b.x = xb_xcc_id(); b.st = st;
    if (threadIdx.x == 0) (void)xb_add(&bar[XB_XCNT(b.x)], 1u);
    return b;
}
DI void xcd_barrier_complete(unsigned* bar, unsigned x, unsigned& nloc, unsigned& nx) {
    const unsigned G = gridDim.x * gridDim.y * gridDim.z;
    unsigned sum, cnt, mine, sp = 0u;
    for (;;) {
        sum = 0u; cnt = 0u; mine = 0u;
#pragma unroll
        for (unsigned j = 0; j < 16; ++j) { const unsigned c = xb_ld(&bar[XB_XCNT(j)]); sum += c; cnt += (c > 0u) ? 1u : 0u; mine = (j == x) ? c : mine; }
        if (sum == G) break;
        __builtin_amdgcn_s_sleep(1);
        if ((++sp & 255u) == 0u) { if (xb_ld(&bar[XB_TMO])) break; if (sp > XB_SPIN_CAP) { atomicAdd(&bar[XB_TMO], 1u); break; } }
    }
    nloc = mine > 0u ? mine : 1u; nx = cnt > 0u ? cnt : 1u;
}
DI void xcd_barrier(const XcdBarrier& b) {
    asm volatile("s_waitcnt vmcnt(0)" ::: "memory");
    __syncthreads();
    if (threadIdx.x == 0) {
        unsigned* bar = b.bar;
        __builtin_amdgcn_s_waitcnt(0);
        unsigned nloc = b.st[0], nx = b.st[1];
        if (nloc == 0u) { xcd_barrier_complete(bar, b.x, nloc, nx); b.st[0] = nloc; b.st[1] = nx; }
        const unsigned old = xb_add(&bar[XB_XSUB(b.x)], 1u);
        const unsigned gen = old / nloc;
        if (old + 1u == (gen + 1u) * nloc) {
            __builtin_amdgcn_fence(__ATOMIC_RELEASE, "agent");
            asm volatile("s_waitcnt vmcnt(0)" ::: "memory");
            const unsigned og = xb_add(&bar[XB_TOP], 1u);
            const unsigned tg = og / nx;
            if (og + 1u == (tg + 1u) * nx) xb_add(&bar[XB_TOPGEN], 1u);
            else XB_SPIN(xb_ld(&bar[XB_TOPGEN]) == tg, bar);
            __builtin_amdgcn_fence(__ATOMIC_ACQUIRE, "agent");
            xb_add(&bar[XB_XGEN(b.x)], 1u);
            asm volatile("s_waitcnt vmcnt(0)" ::: "memory");
        } else {
            XB_SPIN(xb_ld(&bar[XB_XGEN(b.x)]) == gen, bar);
            __builtin_amdgcn_fence(__ATOMIC_ACQUIRE, "agent");
            asm volatile("s_waitcnt vmcnt(0)" ::: "memory");
        }
    }
    __syncthreads();
}

namespace pg8 {
constexpr int BM = 256, BK = 64, HALF = 128, HTB = HALF * BK * 2, STAGE_BYTES = 8 * HTB, NXCD = 8, WGM = 8;
__host__ __device__ __forceinline__ int lds_byte(int r, int c) { const int st = (r >> 4) * 2 + (c >> 5), rr = r & 15, cc = c & 31, ob = rr * 64 + cc * 2; return st * 1024 + (ob ^ (((ob >> 9) & 1) << 5)); }
__host__ __device__ __forceinline__ void stage_rc(int b, int& R, int& C) { const int st = b / 1024, sb = b % 1024, swz = sb ^ (((sb >> 9) & 1) << 5); R = (st >> 1) * 16 + swz / 64; C = (st & 1) * 32 + (swz % 64) / 2; }
__host__ __device__ __forceinline__ int perm32(int rho) { const int n = rho >> 4, i = rho & 15; return 8 * (i >> 2) + 4 * n + (i & 3); }
struct Unit { int pm, pn; };
struct Gemm { const bf16_t* A; const bf16_t* Bt; int M, N, K, lda, ldb; };
struct StaticOrder {
    int nM, nN, nwg, G, c;
    __device__ void init(int M, int N, int G_, int c_) { nM = M / BM; nN = N / BM; nwg = nM * nN; G = G_; c = c_; }
    __device__ bool next(int i, Unit& u) const {
        const long L = (long)i * G + c; if (L >= nwg) return false;
        int wgid = (int)L; { const int q = nwg / NXCD, r = nwg % NXCD, xcd = wgid % NXCD, off = wgid / NXCD; wgid = (xcd < r ? xcd * (q + 1) : r * (q + 1) + (xcd - r) * q) + off; }
        const int nig = WGM * nN, gid = wgid / nig, fm = gid * WGM, gsz = (nM - fm) < WGM ? (nM - fm) : WGM;
        u.pm = fm + ((wgid % nig) % gsz); u.pn = (wgid % nig) / gsz; return true;
    }
};
struct EpiBf16 {
    static constexpr bool PERM = true;
    bf16_t* O; int ldc; float osc = 1.f;
    DI void operator()(const f32x4 (&acc)[2][2][4][2], const Unit& u, int wr, int wc, int fr, int fq) const {
        const int row0 = u.pm * BM + wr * 64 + fr, col0 = u.pn * BM + wc * 32 + 8 * fq;
#pragma unroll
        for (int ai = 0; ai < 2; ++ai)
#pragma unroll
            for (int m = 0; m < 4; ++m) { bf16_t* rowp = O + (size_t)(row0 + ai * HALF + m * 16) * ldc + col0;
#pragma unroll
                for (int bj = 0; bj < 2; ++bj) { const f32x4 v0 = acc[ai][bj][m][0] * osc, v1 = acc[ai][bj][m][1] * osc;
                    u32x4 w; w.x = pk2(v0[0], v0[1]); w.y = pk2(v0[2], v0[3]); w.z = pk2(v1[0], v1[1]); w.w = pk2(v1[2], v1[3]);
                    *(u32x4*)(rowp + bj * HALF) = w; } }
    }
};
struct EpiKV8 {
    static constexpr bool PERM = true;
    unsigned char* V8; float osc; unsigned char* K8; float ksc;
    DI void operator()(const f32x4 (&acc)[2][2][4][2], const Unit& u, int wr, int wc, int fr, int fq) const {
        const int row0 = u.pm * BM + wr * 64 + fr, cin = wc * 32 + 8 * fq;
#pragma unroll
        for (int ai = 0; ai < 2; ++ai)
#pragma unroll
            for (int m = 0; m < 4; ++m) { const size_t row = (size_t)(row0 + ai * HALF + m * 16);
                { const f32x4 v0 = acc[ai][0][m][0] * ksc, v1 = acc[ai][0][m][1] * ksc;
                  u32x2 w; w.x = (unsigned)pk4_fp8(v0[0], v0[1], v0[2], v0[3]); w.y = (unsigned)pk4_fp8(v1[0], v1[1], v1[2], v1[3]);
                  *(u32x2*)(K8 + row * 1024 + u.pn * 128 + cin) = w; }
                { const f32x4 v0 = acc[ai][1][m][0] * osc, v1 = acc[ai][1][m][1] * osc;
                  u32x2 w; w.x = (unsigned)pk4_fp8(v0[0], v0[1], v0[2], v0[3]); w.y = (unsigned)pk4_fp8(v1[0], v1[1], v1[2], v1[3]);
                  *(u32x2*)(V8 + row * 1024 + u.pn * 128 + cin) = w; } }
    }
};
struct EpiZ1 {
    static constexpr bool PERM = true;
    bf16_t* O; int ldc; float osc; unsigned char* K8; float ksc; unsigned char* V8;
    DI void operator()(const f32x4 (&acc)[2][2][4][2], const Unit& u, int wr, int wc, int fr, int fq) const {
        const int row0 = u.pm * BM + wr * 64 + fr, cin = wc * 32 + 8 * fq;
        if (u.pn >= 4 && u.pn < 12) {
            const bool isk = u.pn < 8; const float fs = isk ? ksc : osc; unsigned char* dst8 = isk ? (K8 + (u.pn - 4) * BM) : (V8 + (u.pn - 8) * BM);
#pragma unroll
            for (int ai = 0; ai < 2; ++ai)
#pragma unroll
                for (int m = 0; m < 4; ++m) { unsigned char* rowp = dst8 + (size_t)(row0 + ai * HALF + m * 16) * 1024 + cin;
#pragma unroll
                    for (int bj = 0; bj < 2; ++bj) { const f32x4 v0 = acc[ai][bj][m][0] * fs, v1 = acc[ai][bj][m][1] * fs;
                        u32x2 w; w.x = (unsigned)pk4_fp8(v0[0], v0[1], v0[2], v0[3]); w.y = (unsigned)pk4_fp8(v1[0], v1[1], v1[2], v1[3]);
                        *(u32x2*)(rowp + bj * HALF) = w; } }
        } else {
#pragma unroll
            for (int ai = 0; ai < 2; ++ai)
#pragma unroll
                for (int m = 0; m < 4; ++m) { bf16_t* rowp = O + (size_t)(row0 + ai * HALF + m * 16) * ldc + u.pn * BM + cin;
#pragma unroll
                    for (int bj = 0; bj < 2; ++bj) { const f32x4 v0 = acc[ai][bj][m][0] * osc, v1 = acc[ai][bj][m][1] * osc;
                        u32x4 w; w.x = pk2(v0[0], v0[1]); w.y = pk2(v0[2], v0[3]); w.z = pk2(v1[0], v1[1]); w.w = pk2(v1[2], v1[3]);
                        *(u32x4*)(rowp + bj * HALF) = w; } }
        }
    }
};
template <bool RBF16>
struct EpiResid {
    static constexpr bool PERM = true;
    bf16_t* H; const void* Rx; const void* Rc; const float* gx; const float* gc; int gstride; float osc = 1.f;
    DI void operator()(const f32x4 (&acc)[2][2][4][2], const Unit& u, int wr, int wc, int fr, int fq) const {
        const int rowt = u.pm * BM;
        const char* R; const float* g;
        constexpr int RB = RBF16 ? 2 : 4;
        if (rowt < MXR) { R = (const char*)Rx + (size_t)rowt * DM * RB; g = gx + (size_t)(rowt >> 11) * gstride; } else { R = (const char*)Rc + (size_t)(rowt - MXR) * DM * RB; g = gc; }
        bf16_t* Ho = H + (size_t)rowt * DM;
        const int rl0 = wr * 64 + fr, col0 = u.pn * BM + wc * 32 + 8 * fq;
        f32x4 gv[2][2];
#pragma unroll
        for (int bj = 0; bj < 2; ++bj)
#pragma unroll
            for (int n = 0; n < 2; ++n) gv[bj][n] = *(const f32x4*)(g + col0 + bj * HALF + 4 * n) * osc;
#pragma unroll
        for (int ai = 0; ai < 2; ++ai)
#pragma unroll
            for (int m = 0; m < 4; ++m) { const size_t ro = (size_t)(rl0 + ai * HALF + m * 16) * DM + col0;
#pragma unroll
                for (int bj = 0; bj < 2; ++bj) { f32x4 r0, r1;
                    if (RBF16) { const u32x4 rr = *(const u32x4*)(R + (ro + bj * HALF) * 2); r0 = (f32x4){bflo(rr.x), bfhi(rr.x), bflo(rr.y), bfhi(rr.y)}; r1 = (f32x4){bflo(rr.z), bfhi(rr.z), bflo(rr.w), bfhi(rr.w)}; }
                    else { r0 = *(const f32x4*)(R + (ro + bj * HALF) * 4); r1 = *(const f32x4*)(R + (ro + bj * HALF + 4) * 4); }
                    const f32x4 v0 = r0 + gv[bj][0] * acc[ai][bj][m][0], v1 = r1 + gv[bj][1] * acc[ai][bj][m][1];
                    u32x4 w; w.x = pk2(v0[0], v0[1]); w.y = pk2(v0[2], v0[3]); w.z = pk2(v1[0], v1[1]); w.w = pk2(v1[2], v1[3]);
                    *(u32x4*)(Ho + ro + bj * HALF) = w; } }
    }
};

template <class Epi, bool FP8 = false>
DI void gemm_phase(LAS unsigned char* lds, const Gemm g, const StaticOrder& S, const Epi& E) {
    const int tid = threadIdx.x, wid = __builtin_amdgcn_readfirstlane(tid >> 6), lane = tid & 63, wr = wid >> 2, wc = wid & 3, fr = lane & 15, fq = lane >> 4;
    const int K = g.K, nt = K / BK;
    unsigned voffA[2], voffB[2];
#pragma unroll
    for (int i = 0; i < 2; ++i) { int R, C; stage_rc(tid * 16 + i * 8192, R, C); const int Rb = Epi::PERM ? ((R & ~31) + perm32(R & 31)) : R;
        voffA[i] = (unsigned)(R * g.lda + C) * 2u; voffB[i] = (unsigned)(Rb * g.ldb + C) * 2u; }
    const size_t kstep = (size_t)(BK * 2);
    const size_t hA = (size_t)HALF * g.lda * 2, hB = (size_t)HALF * g.ldb * 2;
    const size_t tA = 2 * hA, tB = 2 * hB;
    const unsigned ldsw = (unsigned)wid * 1024u;
    const int aoff = lds_byte(wr * 64 + fr, fq * 8), boff = lds_byte(wc * 32 + fr, fq * 8);
#define PG8_SA(b, h) (((b) * 2 + (h)) * HTB)
#define PG8_SB(b, h) ((4 + (b) * 2 + (h)) * HTB)
#define PG8_STAGE(bufoff, gbase, voff) do { _Pragma("unroll") for (int _i = 0; _i < 2; ++_i) \
        __builtin_amdgcn_global_load_lds((const unsigned*)((const char*)(gbase) + (voff)[_i]), (LAS unsigned*)(lds + (bufoff) + ldsw + _i * 8192), 16, 0, 0); } while (0)
#define PG8_LD8(p) __builtin_shufflevector(*(const LAS u32x4*)(p), *(const LAS u32x4*)((p) + 1024), 0, 1, 2, 3, 4, 5, 6, 7)
#define PG8_LDA(dst, b, h) do { if constexpr (FP8) { _Pragma("unroll") for (int m = 0; m < 4; ++m) dst##8[m] = PG8_LD8(lds + PG8_SA(b, h) + aoff + m * 2048); } \
        else { _Pragma("unroll") for (int m = 0; m < 4; ++m) _Pragma("unroll") for (int k = 0; k < 2; ++k) dst[m][k] = *(const LAS bf16x8*)(lds + PG8_SA(b, h) + aoff + m * 2048 + k * 1024); } } while (0)
#define PG8_LDB(dst, b, h) do { if constexpr (FP8) { _Pragma("unroll") for (int n = 0; n < 2; ++n) dst##8[n] = PG8_LD8(lds + PG8_SB(b, h) + boff + n * 2048); } \
        else { _Pragma("unroll") for (int n = 0; n < 2; ++n) _Pragma("unroll") for (int k = 0; k < 2; ++k) dst[n][k] = *(const LAS bf16x8*)(lds + PG8_SB(b, h) + boff + n * 2048 + k * 1024); } } while (0)
#define PG8_MMA(ai, bj, At, Bt) do { __builtin_amdgcn_s_setprio(1); \
        if constexpr (FP8) { _Pragma("unroll") for (int m = 0; m < 4; ++m) _Pragma("unroll") for (int n = 0; n < 2; ++n) \
            asm volatile("v_mfma_scale_f32_16x16x128_f8f6f4 %0, %1, %2, %0, %3, %3 op_sel_hi:[0,0,0]" : "+v"(acc[ai][bj][m][n]) : "v"(Bt##8[n]), "v"(At##8[m]), "v"(one_scale)); } \
        else { _Pragma("unroll") for (int m = 0; m < 4; ++m) _Pragma("unroll") for (int n = 0; n < 2; ++n) _Pragma("unroll") for (int k = 0; k < 2; ++k) \
            acc[ai][bj][m][n] = __builtin_amdgcn_mfma_f32_16x16x32_bf16(Bt[n][k], At[m][k], acc[ai][bj][m][n], 0, 0, 0); } \
        __builtin_amdgcn_s_setprio(0); } while (0)
#define PG8_WAIT_V(n) asm volatile("s_waitcnt vmcnt(" #n ")" ::: "memory")
#define PG8_WAIT_L(n) asm volatile("s_waitcnt lgkmcnt(" #n ")" ::: "memory")
#define PG8_BAR __builtin_amdgcn_s_barrier()
#define PG8_SCHED __builtin_amdgcn_sched_barrier(0)
    Unit cur, nxt; int ui = 0;
    if (!S.next(0, cur)) return;
    f32x4 acc[2][2][4][2];
#pragma unroll
    for (int a = 0; a < 2; ++a)
#pragma unroll
        for (int b = 0; b < 2; ++b)
#pragma unroll
            for (int m = 0; m < 4; ++m)
#pragma unroll
                for (int n = 0; n < 2; ++n) acc[a][b][m][n] = (f32x4){0.f, 0.f, 0.f, 0.f};
    bf16x8 At[4][2], B0[2][2], B1[2][2];
    typedef unsigned u32x8 __attribute__((ext_vector_type(8))); typedef int i32x8 __attribute__((ext_vector_type(8)));
    u32x8 At8[4], B08[2], B18[2];
    const unsigned one_scale = 0x7f7f7f7fu;
    const char* cA = (const char*)g.A + (size_t)cur.pm * tA; const char* cB = (const char*)g.Bt + (size_t)cur.pn * tB;
    PG8_STAGE(PG8_SB(0, 0), cB, voffB); PG8_STAGE(PG8_SA(0, 0), cA, voffA); PG8_STAGE(PG8_SB(0, 1), cB + hB, voffB); PG8_STAGE(PG8_SA(0, 1), cA + hA, voffA);
    if (wr == 1) PG8_BAR;
    PG8_WAIT_V(4); PG8_BAR;
    PG8_STAGE(PG8_SB(1, 0), cB + kstep, voffB); PG8_STAGE(PG8_SA(1, 0), cA + kstep, voffA); PG8_STAGE(PG8_SB(1, 1), cB + hB + kstep, voffB);
    PG8_WAIT_V(6); PG8_BAR;
    for (;;) {
        const bool has_next = S.next(ui + 1, nxt);
        const char* nA = has_next ? (const char*)g.A + (size_t)nxt.pm * tA : cA; const char* nB = has_next ? (const char*)g.Bt + (size_t)nxt.pn * tB : cB;
        for (int t = 0; t < nt; t += 2) {
            const bool last = (t == nt - 2);
            const char* a1 = cA + (size_t)(t + 1) * kstep;
            const char* a2 = last ? nA : cA + (size_t)(t + 2) * kstep; const char* b2 = last ? nB : cB + (size_t)(t + 2) * kstep;
            const char* a3 = a2 + kstep; const char* b3 = b2 + kstep;
            PG8_LDB(B0, 0, 0); PG8_SCHED; PG8_LDA(At, 0, 0); PG8_STAGE(PG8_SA(1, 1), a1 + hA, voffA);
            PG8_WAIT_L(8); PG8_BAR; PG8_WAIT_L(0); PG8_MMA(0, 0, At, B0); PG8_BAR; PG8_SCHED;
            PG8_LDB(B1, 0, 1); PG8_STAGE(PG8_SB(0, 0), b2, voffB);
            PG8_BAR; PG8_WAIT_L(0); PG8_MMA(0, 1, At, B1); PG8_BAR;
            PG8_LDA(At, 0, 1); PG8_STAGE(PG8_SA(0, 0), a2, voffA);
            PG8_BAR; PG8_WAIT_L(0); PG8_MMA(1, 0, At, B0); PG8_BAR; PG8_SCHED;
            PG8_STAGE(PG8_SB(0, 1), b2 + hB, voffB);
            PG8_WAIT_V(6); PG8_BAR; PG8_MMA(1, 1, At, B1); PG8_BAR;
            PG8_LDB(B0, 1, 0); PG8_SCHED; PG8_LDA(At, 1, 0); PG8_STAGE(PG8_SA(0, 1), a2 + hA, voffA);
            PG8_WAIT_L(8); PG8_BAR; PG8_WAIT_L(0); PG8_MMA(0, 0, At, B0); PG8_BAR; PG8_SCHED;
            PG8_LDB(B1, 1, 1); PG8_STAGE(PG8_SB(1, 0), b3, voffB);
            PG8_BAR; PG8_WAIT_L(0); PG8_MMA(0, 1, At, B1); PG8_BAR;
            PG8_LDA(At, 1, 1); PG8_STAGE(PG8_SA(1, 0), a3, voffA);
            PG8_BAR; PG8_WAIT_L(0); PG8_MMA(1, 0, At, B0); PG8_BAR; PG8_SCHED;
            PG8_STAGE(PG8_SB(1, 1), b3 + hB, voffB);
            PG8_WAIT_V(6); PG8_BAR; PG8_MMA(1, 1, At, B1); PG8_BAR;
        }
        E(acc, cur, wr, wc, fr, fq);
        if (!has_next) break;
#pragma unroll
        for (int a = 0; a < 2; ++a)
#pragma unroll
            for (int b = 0; b < 2; ++b)
#pragma unroll
                for (int m = 0; m < 4; ++m)
#pragma unroll
                    for (int n = 0; n < 2; ++n) acc[a][b][m][n] = (f32x4){0.f, 0.f, 0.f, 0.f};
        cur = nxt; cA = nA; cB = nB; ++ui;
    }
    PG8_WAIT_V(0);
    if (wr == 0) PG8_BAR;
    PG8_BAR;
#undef PG8_SA
#undef PG8_SB
#undef PG8_STAGE
#undef PG8_LDA
#undef PG8_LDB
#undef PG8_MMA
#undef PG8_LD8
#undef PG8_WAIT_V
#undef PG8_WAIT_L
#undef PG8_BAR
#undef PG8_SCHED
}
}

enum { I_X = 0, I_C, I_CTX, I_CCTX, I_WMOD, I_BMOD, I_N1W, I_N2W, I_EVIN, I_EVOUT, I_GQN, I_GKN, I_HLB, I_HON, I_ODIN, I_ODOUT, I_RPB,
       I_MQN, I_MQUP, I_MKVN, I_MKVUP, I_PWQ, I_PKEYS, I_PU, I_PV, I_FNW, N_IN };
struct Args { const float* in[N_IN]; float* out; unsigned char* ws; int ph_lo, ph_hi; };
struct Frame {
    LAS unsigned char* lds;
    int tid, lane, wave, gw, ngw, G, wg;
};

constexpr float FP8_WSC = 2048.f, FP8_WSC2 = 1024.f, FP8_ASC = 16.f;
DI void transpose_item_fp8(const float* W, int K, int N, unsigned char* WT, LAS float* scr, int item, int lane, float wsc = FP8_WSC) {
    const int nblk = N / 32, kb = item / nblk, nb = item % nblk, k0 = 64 * kb, n0 = 32 * nb;
#pragma unroll 8
    for (int i = 0; i < 32; ++i) { const int kk = 2 * i + (lane >> 5); scr[kk * 33 + (lane & 31)] = W[(size_t)(k0 + kk) * N + n0 + (lane & 31)] * wsc; }
    asm volatile("s_waitcnt lgkmcnt(0)" ::: "memory");
    const int c = lane & 7;
#pragma unroll
    for (int j = 0; j < 4; ++j) { const int n = (lane >> 3) + 8 * j; const LAS float* sp = scr + (8 * c) * 33 + n;
        u32x2 o; o.x = (unsigned)pk4_fp8(sp[0 * 33], sp[1 * 33], sp[2 * 33], sp[3 * 33]); o.y = (unsigned)pk4_fp8(sp[4 * 33], sp[5 * 33], sp[6 * 33], sp[7 * 33]);
        *(u32x2*)(WT + (size_t)(n0 + n) * K + k0 + 8 * c) = o; }
    asm volatile("s_waitcnt lgkmcnt(0)" ::: "memory");
}
DI void transpose_item(const float* W, int K, int N, bf16_t* WT, LAS float* scr, int item, int lane) {
    const int nblk = N / 32, kb = item / nblk, nb = item % nblk, k0 = 64 * kb, n0 = 32 * nb;
#pragma unroll 8
    for (int i = 0; i < 32; ++i) { const int kk = 2 * i + (lane >> 5); scr[kk * 33 + (lane & 31)] = W[(size_t)(k0 + kk) * N + n0 + (lane & 31)]; }
    asm volatile("s_waitcnt lgkmcnt(0)" ::: "memory");
    const int c = lane & 7;
#pragma unroll
    for (int j = 0; j < 4; ++j) { const int n = (lane >> 3) + 8 * j; const LAS float* s = scr + (8 * c) * 33 + n;
        u32x4 o; o.x = pk2(s[0 * 33], s[1 * 33]); o.y = pk2(s[2 * 33], s[3 * 33]); o.z = pk2(s[4 * 33], s[5 * 33]); o.w = pk2(s[6 * 33], s[7 * 33]);
        *(u32x4*)(WT + (size_t)(n0 + n) * K + k0 + 8 * c) = o; }
    asm volatile("s_waitcnt lgkmcnt(0)" ::: "memory");
}
DI void cvt_bf16_stream(const Frame& F, const float* src, bf16_t* dst, size_t n) {
    const size_t nth = (size_t)F.G * 512, t0 = (size_t)F.wg * 512 + F.tid;
    for (size_t i = t0; i < n / 8; i += nth) {
        const f32x4 a = *(const f32x4*)(src + i * 8), b = *(const f32x4*)(src + i * 8 + 4);
        u32x4 o; o.x = pk2(a[0], a[1]); o.y = pk2(a[2], a[3]); o.z = pk2(b[0], b[1]); o.w = pk2(b[2], b[3]);
        *(u32x4*)(dst + i * 8) = o;
    }
}
typedef float f32x16v __attribute__((ext_vector_type(16)));
typedef float f32x32v __attribute__((ext_vector_type(32)));
typedef __bf16 bf16x32v __attribute__((ext_vector_type(32)));
typedef unsigned u32x6 __attribute__((ext_vector_type(6)));
constexpr int ROWB = 1536, SLB = 192;
DI void cvt_fp6_rows(const Frame& F, const float* src, unsigned char* dst, float* inv_scale, int nrows) {
    LAS float* stage = (LAS float*)(F.lds + F.wave * 8192);
    for (int row = F.gw; row < nrows; row += F.ngw) {
        const float* sp = src + (size_t)row * DM;
        f32x4 v[8]; float mx = 0.f;
#pragma unroll
        for (int j = 0; j < 8; ++j) { v[j] = *(const f32x4*)(sp + 4 * (F.lane + 64 * j));
            mx = fmaxf(mx, fmaxf(fmaxf(fabsf(v[j][0]), fabsf(v[j][1])), fmaxf(fabsf(v[j][2]), fabsf(v[j][3])))); }
#pragma unroll
        for (int o = 1; o < 64; o <<= 1) mx = fmaxf(mx, __shfl_xor(mx, o));
        mx = fmaxf(mx, 1e-30f);
        const float sc = exp2f(floorf(log2f(7.0f / mx)));
#pragma unroll
        for (int j = 0; j < 8; ++j) *(LAS f32x4*)(stage + 4 * (F.lane + 64 * j)) = v[j] * sc;
        asm volatile("s_waitcnt lgkmcnt(0)" ::: "memory");
        f32x16v a, b;
#pragma unroll
        for (int j = 0; j < 8; ++j) { const f32x4 t0 = *(const LAS f32x4*)(stage + 32 * F.lane + 4 * j);
            a[2 * j] = t0[0]; b[2 * j] = t0[1]; a[2 * j + 1] = t0[2]; b[2 * j + 1] = t0[3]; }
        const u32x6 p = __builtin_amdgcn_cvt_scalef32_2xpk16_fp6_f32(a, b, 1.0f);
        unsigned char* dp = dst + ((size_t)(F.lane >> 3) * 16384 + row) * SLB + 24 * (F.lane & 7);
        *(u32x2*)dp = (u32x2){p[0], p[1]}; *(u32x2*)(dp + 8) = (u32x2){p[2], p[3]}; *(u32x2*)(dp + 16) = (u32x2){p[4], p[5]};
        if (F.lane == 0) inv_scale[row] = 1.f / sc;
        asm volatile("s_waitcnt lgkmcnt(0)" ::: "memory");
    }
}
DI void mod_gemv(const Frame& F, const Args& a) {
    const float* c = a.in[I_C]; const float* cctx = a.in[I_CCTX]; const float* wmod = a.in[I_WMOD]; const float* bmod = a.in[I_BMOD];
    float* modx = (float*)(a.ws + WS_MODX); float* modc = (float*)(a.ws + WS_MODC);
    LAS float* red = (LAS float*)F.lds;
    const int r = F.lane & 31, hh = F.lane >> 5;
    for (int blk = F.wg; blk < 768; blk += F.G) {
        const int l = blk / 384, j0 = (blk % 384) * 32;
        const float* W = wmod + (size_t)l * DM * 12288 + j0;
        f32x16 acc; for (int i = 0; i < 16; ++i) acc[i] = 0.f;
        const int kbeg = F.wave * 256;
        for (int ks = 0; ks < 16; ++ks) {
            const int k0 = kbeg + ks * 16 + 8 * hh;
            float av[8];
            if (r < 17) { const float* src = (r < 16) ? c + (size_t)r * DM + k0 : cctx + k0;
                const f32x4 x0 = *(const f32x4*)src, x1 = *(const f32x4*)(src + 4);
                av[0] = silu_f(x0[0]); av[1] = silu_f(x0[1]); av[2] = silu_f(x0[2]); av[3] = silu_f(x0[3]);
                av[4] = silu_f(x1[0]); av[5] = silu_f(x1[1]); av[6] = silu_f(x1[2]); av[7] = silu_f(x1[3]);
            } else { for (int i = 0; i < 8; ++i) av[i] = 0.f; }
            u32x4 ap; ap.x = pk2(av[0], av[1]); ap.y = pk2(av[2], av[3]); ap.z = pk2(av[4], av[5]); ap.w = pk2(av[6], av[7]);
            float bv[8];
#pragma unroll
            for (int i = 0; i < 8; ++i) bv[i] = W[(size_t)(k0 + i) * 12288 + r];
            u32x4 bp; bp.x = pk2(bv[0], bv[1]); bp.y = pk2(bv[2], bv[3]); bp.z = pk2(bv[4], bv[5]); bp.w = pk2(bv[6], bv[7]);
            acc = __builtin_amdgcn_mfma_f32_32x32x16_bf16(__builtin_bit_cast(bf16x8, ap), __builtin_bit_cast(bf16x8, bp), acc, 0, 0, 0);
        }
        __syncthreads();
#pragma unroll
        for (int i = 0; i < 16; ++i) { const int row = (i & 3) + 8 * (i >> 2) + 4 * hh; red[(F.wave * 32 + row) * 32 + r] = acc[i]; }
        __syncthreads();
        for (int o = F.tid; o < 17 * 32; o += 512) { const int row = o >> 5, col = o & 31; float s = 0.f;
#pragma unroll
            for (int w = 0; w < 8; ++w) s += red[(w * 32 + row) * 32 + col];
            s += bmod[(size_t)l * 12288 + j0 + col];
            if (row < 16) modx[((size_t)l * 16 + row) * 12288 + j0 + col] = s; else modc[(size_t)l * 12288 + j0 + col] = s; }
    }
    __syncthreads();
}
DI void prologue(const Frame& F, const Args& a) {
    LAS float* scr = (LAS float*)(F.lds + 32768 + F.wave * 8704);
    unsigned char* ws = a.ws;
    constexpr int I0 = 32 * 208, I1 = 32 * 64, I2 = 32 * 130, I3 = 32 * 64, I4 = 8 * 48, I5 = 8 * 64, I6 = 32 * 64, I7 = 32 * 64;
    constexpr int NIT = I0 + I1 + I2 + I3 + I4 + I5 + I6 + I7;
    for (int it = F.gw; it < NIT; it += F.ngw) {
        int r = it;
        if (r < I0) { transpose_item_fp8(a.in[I_EVIN], 2048, 6656, ws + WS_WIN0, scr, r, F.lane); continue; } r -= I0;
        if (r < I1) { transpose_item_fp8(a.in[I_EVOUT], 2048, 2048, ws + WS_WOUT0, scr, r, F.lane); continue; } r -= I1;
        if (r < I2) { transpose_item_fp8(a.in[I_ODIN], 2048, 4160, ws + WS_WIN1, scr, r, F.lane); continue; } r -= I2;
        if (r < I3) { transpose_item_fp8(a.in[I_ODOUT], 2048, 2048, ws + WS_WOUT1, scr, r, F.lane); continue; } r -= I3;
        if (r < I4) { transpose_item_fp8(a.in[I_MQUP], 512, 1536, ws + WS_WQUP, scr, r, F.lane, FP8_WSC2); continue; } r -= I4;
        if (r < I5) { transpose_item_fp8(a.in[I_MKVUP], 512, 2048, ws + WS_WKVUP, scr, r, F.lane, FP8_WSC2); continue; } r -= I5;
        if (r < I6) { transpose_item(a.in[I_PWQ], 2048, 2048, (bf16_t*)(ws + WS_WPQ), scr, r, F.lane); continue; } r -= I6;
        transpose_item(a.in[I_PWQ] + (size_t)2048 * 2048, 2048, 2048, (bf16_t*)(ws + WS_WPQ) + (size_t)2048 * 2048, scr, r, F.lane);
    }
    { u32x4* z = (u32x4*)(ws + WS_WIN1 + (size_t)4160 * 2048); const size_t n16 = (size_t)192 * 2048 / 16;
      for (size_t i = (size_t)F.wg * 512 + F.tid; i < n16; i += (size_t)F.G * 512) z[i] = (u32x4){0u, 0u, 0u, 0u}; }
    cvt_bf16_stream(F, a.in[I_PKEYS], (bf16_t*)(ws + WS_KEYS), (size_t)2 * 8 * 2 * 128 * 128);
    __syncthreads();
    cvt_fp6_rows(F, a.in[I_PU], ws + WS_U, (float*)(ws + WS_SU), 16384);
    cvt_fp6_rows(F, a.in[I_PV], ws + WS_V, (float*)(ws + WS_SV), 16384);
    mod_gemv(F, a);
}

template <bool SRC_BF16, bool DST_FP8>
DI void norm_mod_row(const Frame& F, const char* src, const f32x4 (&w)[8], const f32x4 (&sh)[8], const f32x4 (&sc)[8], bf16_t* dst, size_t row) {
    f32x4 v[8]; float ss = 0.f;
#pragma unroll
    for (int j = 0; j < 4; ++j) { const int c = 8 * (F.lane + 64 * j);
        if (SRC_BF16) { const u32x4 rr = *(const u32x4*)(src + (size_t)c * 2); v[2 * j] = (f32x4){bflo(rr.x), bfhi(rr.x), bflo(rr.y), bfhi(rr.y)}; v[2 * j + 1] = (f32x4){bflo(rr.z), bfhi(rr.z), bflo(rr.w), bfhi(rr.w)}; }
        else { v[2 * j] = *(const f32x4*)(src + (size_t)c * 4); v[2 * j + 1] = *(const f32x4*)(src + (size_t)c * 4 + 16); }
#pragma unroll
        for (int q = 0; q < 2; ++q) ss += v[2 * j + q][0] * v[2 * j + q][0] + v[2 * j + q][1] * v[2 * j + q][1] + v[2 * j + q][2] * v[2 * j + q][2] + v[2 * j + q][3] * v[2 * j + q][3]; }
    const float rstd = __frsqrt_rn(wave_sum(ss) * (1.f / DM) + EPS);
    bf16_t* o = dst + row * DM;
#pragma unroll
    for (int j = 0; j < 4; ++j) { const int c = 8 * (F.lane + 64 * j); unsigned pk[4];
#pragma unroll
        for (int q = 0; q < 2; ++q) { f32x4 y;
#pragma unroll
            for (int e = 0; e < 4; ++e) y[e] = (v[2 * j + q][e] * rstd * w[2 * j + q][e]) * (1.f + sc[2 * j + q][e]) + sh[2 * j + q][e];
            if (DST_FP8) pk[q] = (unsigned)pk4_fp8(y[0] * FP8_ASC, y[1] * FP8_ASC, y[2] * FP8_ASC, y[3] * FP8_ASC);
            else { pk[2 * q] = pk2(y[0], y[1]); pk[2 * q + 1] = pk2(y[2], y[3]); } }
        if (DST_FP8) *(u32x2*)((unsigned char*)dst + row * DM + c) = (u32x2){pk[0], pk[1]};
        else *(u32x4*)(o + c) = (u32x4){pk[0], pk[1], pk[2], pk[3]}; }
}
template <bool SRC_BF16, bool DST_FP8 = false>
DI void norm_mod_phase(const Frame& F, const void* srcX, const void* srcC, const float* nw, const float* modx_l, const float* modc_l, int sidx, bf16_t* dst, int nrows) {
    constexpr int SB = SRC_BF16 ? 2 : 4;
    f32x4 w[8], sh[8], sc[8];
#pragma unroll
    for (int j = 0; j < 4; ++j) { const int c = 8 * (F.lane + 64 * j); w[2 * j] = *(const f32x4*)(nw + c); w[2 * j + 1] = *(const f32x4*)(nw + c + 4); }
    for (int blk = F.gw; blk < MXR / 16; blk += F.ngw) {
        const int row0 = 16 * blk; const float* shift = modx_l + (size_t)(row0 >> 11) * 12288 + sidx * DM; const float* scale = shift + DM;
#pragma unroll
        for (int j = 0; j < 4; ++j) { const int c = 8 * (F.lane + 64 * j); sh[2 * j] = *(const f32x4*)(shift + c); sh[2 * j + 1] = *(const f32x4*)(shift + c + 4); sc[2 * j] = *(const f32x4*)(scale + c); sc[2 * j + 1] = *(const f32x4*)(scale + c + 4); }
#pragma unroll 1
        for (int i = 0; i < 16; ++i) norm_mod_row<SRC_BF16, DST_FP8>(F, (const char*)srcX + (size_t)(row0 + i) * DM * SB, w, sh, sc, dst, (size_t)(row0 + i));
    }
    if (nrows > MXR) {
        const float* shift = modc_l + sidx * DM; const float* scale = shift + DM;
#pragma unroll
        for (int j = 0; j < 4; ++j) { const int c = 8 * (F.lane + 64 * j); sh[2 * j] = *(const f32x4*)(shift + c); sh[2 * j + 1] = *(const f32x4*)(shift + c + 4); sc[2 * j] = *(const f32x4*)(scale + c); sc[2 * j + 1] = *(const f32x4*)(scale + c + 4); }
        for (int row = MXR + F.gw; row < nrows; row += F.ngw) norm_mod_row<SRC_BF16, DST_FP8>(F, (const char*)srcC + (size_t)(row - MXR) * DM * SB, w, sh, sc, dst, (size_t)row);
    }
}

DI void rope_pair(float& a, float& bsub, int lane, int posA, int posB, float inv) {
    const float pa = __shfl_xor(a, 32), pb = __shfl_xor(bsub, 32);
    const float angA = (float)posA * inv, angB = (float)posB * inv;
    const float sA = __sinf(angA), cA = __cosf(angA), sB = __sinf(angB), cB = __cosf(angB);
    const float sg = (lane < 32) ? -1.f : 1.f;
    a = a * cA + sg * pa * sA; bsub = bsub * cB + sg * pb * sB;
}
DI void gqa_prep_phase(const Frame& F, const Args& a) {
    const bf16_t* Z = (const bf16_t*)(a.ws + WS_Z);
    const float* qn = a.in[I_GQN]; const float* kn = a.in[I_GKN];
    const float inv = exp2f(-(float)(F.lane & 31) * (13.287712379549449f / 32.f));
    const float wq0 = qn[F.lane], wq1 = qn[64 + F.lane], wk0 = kn[F.lane], wk1 = kn[64 + F.lane];
    LAS unsigned char* Lin = F.lds + F.wave * 4608; LAS unsigned char* Lout = Lin + 3072;
    u32x4 nx[3];
    if (F.gw < MT) { const unsigned char* zr = (const unsigned char*)(Z + (size_t)F.gw * EV_IN);
#pragma unroll
        for (int i = 0; i < 3; ++i) nx[i] = *(const u32x4*)(zr + 1024 * i + 16 * F.lane); }
    for (int row = F.gw; row < MT; row += F.ngw) {
        const bool isx = row < MXR; const int t = row & 2047;
#pragma unroll
        for (int i = 0; i < 3; ++i) *(LAS u32x4*)(Lin + 1024 * i + 16 * F.lane) = nx[i];
        { const int nrow = (row + F.ngw < MT) ? row + F.ngw : row; const unsigned char* zn = (const unsigned char*)(Z + (size_t)nrow * EV_IN);
#pragma unroll
          for (int i = 0; i < 3; ++i) nx[i] = *(const u32x4*)(zn + 1024 * i + 16 * F.lane); }
        const LAS unsigned short* Li = (const LAS unsigned short*)Lin;
#pragma unroll
        for (int hv = 0; hv < 10; ++hv) {
            float v0 = __uint_as_float((unsigned)Li[hv * 128 + F.lane] << 16), v1 = __uint_as_float((unsigned)Li[hv * 128 + 64 + F.lane] << 16);
            const float ms = wave_sum(v0 * v0 + v1 * v1) * (1.f / 128.f);
            const float rs = __frsqrt_rn(ms + EPS);
            v0 = v0 * rs * (hv < 8 ? wq0 : wk0); v1 = v1 * rs * (hv < 8 ? wq1 : wk1);
            if (isx) rope_pair(v0, v1, F.lane, t >> 6, t & 63, inv);
            const float q8s = (hv < 8) ? QK8_SC * 1.020139447f : QK8_SC;
            Lout[hv * 128 + F.lane] = (unsigned char)(pk4_fp8(v0 * q8s, 0.f, 0.f, 0.f) & 0xff); Lout[hv * 128 + 64 + F.lane] = (unsigned char)(pk4_fp8(v1 * q8s, 0.f, 0.f, 0.f) & 0xff);
        }
#pragma unroll
        for (int q = 0; q < 4; ++q) Lout[1280 + 64 * q + F.lane] = (unsigned char)(pk4_fp8(__uint_as_float((unsigned)Li[1280 + 64 * q + F.lane] << 16), 0.f, 0.f, 0.f) & 0xff);
        *(u32x4*)(a.ws + WS_Q8 + (size_t)row * 1024 + 16 * F.lane) = *(const LAS u32x4*)(Lout + 16 * F.lane);
        if (F.lane < 32) { const u32x4 w1 = *(const LAS u32x4*)(Lout + 1024 + 16 * F.lane);
            unsigned char* dp = (F.lane < 16) ? (a.ws + WS_K8 + (size_t)row * 256 + 16 * F.lane) : (a.ws + WS_V8G + (size_t)row * 256 + 16 * (F.lane - 16));
            *(u32x4*)dp = w1; }
    }
}

struct AttnP {
    const bf16_t* Q; int ldq;
    const bf16_t* K1; int ldk1;
    const bf16_t* K2; int ldk2;
    const bf16_t* V; int ldv;
    unsigned char* O; int ldo;
    int qrow0;
    int orow0;
    int b;
    int nctx_tiles;
    int xtile0, nx_tiles;
    float sc_log2e;
    const float* rpb; int qgrow0;
};
template <int DK, bool NA, bool FAST>
DI void attn_unit(const Frame& F, const AttnP& p) {
    constexpr int KST = DK * 2 + 16;
    constexpr int VST = 320;
    constexpr int KBYTES = 64 * KST, VBYTES = 64 * VST;
    constexpr int NKS = DK / 16;
    constexpr int KCH = DK / 8;
    constexpr int KLD = (64 * KCH) / 512;
    LAS unsigned char* Ks = F.lds; LAS unsigned char* Vs = F.lds + KBYTES; LAS float* rp = (LAS float*)(F.lds + KBYTES + VBYTES);
    const int lane = F.lane, w = F.wave, r = lane & 31, hh = lane >> 5;
    const int ntiles = p.nctx_tiles + p.nx_tiles;
    if (NA) { for (int i = F.tid; i < 15 * 31; i += 512) rp[i] = p.rpb[i]; }
    bf16x8 qf[NKS];
    { const bf16_t* qp = p.Q + (size_t)(p.qrow0 + 32 * w + r) * p.ldq + 8 * hh;
#pragma unroll
      for (int ks = 0; ks < NKS; ++ks) qf[ks] = *(const bf16x8*)(qp + 16 * ks); }
    f32x16 oacc[4];
#pragma unroll
    for (int d = 0; d < 4; ++d) for (int i = 0; i < 16; ++i) oacc[d][i] = 0.f;
    float m_run = -1e30f, l_run = 0.f;
    u32x4 kreg[KLD], vreg[2];
#define ATT_TILE_ROW(j) (((j) < p.nctx_tiles) ? (MXR + p.b * CTXL + 64 * (j)) : (p.b * SEQ + 64 * (p.xtile0 + (j) - p.nctx_tiles)))
#define ATT_ISSUE(j) do { const int row0_ = ATT_TILE_ROW(j); \
        _Pragma("unroll") for (int i_ = 0; i_ < KLD; ++i_) { const int c_ = F.tid + 512 * i_, kr_ = c_ / KCH, kc_ = c_ % KCH; \
            if (DK == 128 || kc_ < 16) kreg[i_] = *(const u32x4*)(p.K1 + (size_t)(row0_ + kr_) * p.ldk1 + 8 * kc_); \
            else kreg[i_] = *(const u32x4*)(p.K2 + (size_t)(row0_ + kr_) * p.ldk2 + 8 * (kc_ - 16)); } \
        _Pragma("unroll") for (int i_ = 0; i_ < 2; ++i_) { const int c_ = F.tid + 512 * i_, vr_ = c_ >> 4, vc_ = c_ & 15; \
            vreg[i_] = *(const u32x4*)(p.V + (size_t)(row0_ + vr_) * p.ldv + 8 * vc_); } } while (0)
#define ATT_WRITE() do { \
        _Pragma("unroll") for (int i_ = 0; i_ < KLD; ++i_) { const int c_ = F.tid + 512 * i_, kr_ = c_ / KCH, kc_ = c_ % KCH; *(LAS u32x4*)(Ks + kr_ * KST + 16 * kc_) = kreg[i_]; } \
        _Pragma("unroll") for (int i_ = 0; i_ < 2; ++i_) { const int c_ = F.tid + 512 * i_, vr_ = c_ >> 4, vc_ = c_ & 15; *(LAS u32x4*)(Vs + vr_ * VST + 16 * vc_) = vreg[i_]; } } while (0)
    const int qgr = NA ? (p.qgrow0 + (w >> 1)) : 0;
    const int qc = 32 * (w & 1) + r;
    const int r0w = NA ? min(max(qgr - 4, 0), 24) : 0;
    const int csq = min(max(qc - 8, 0), 48);
    const int tq = (lane & 15) >> 2, tp = lane & 3, dsub = (lane >> 4) & 1;
    const unsigned vtr_base = (unsigned)(size_t)(Vs) + (unsigned)((4 * hh + tq) * VST + (16 * dsub + 4 * tp) * 2);
    const unsigned kfr_base = (unsigned)(size_t)(Ks) + (unsigned)(r * KST + 16 * hh);
    ATT_ISSUE(0);
    for (int j = 0; j < ntiles; ++j) {
        __syncthreads();
        ATT_WRITE();
        if (j + 1 < ntiles) ATT_ISSUE(j + 1);
        __syncthreads();
        bool active = true; int dr = 0;
        if (NA && j >= p.nctx_tiles) { const int kr = p.xtile0 + (j - p.nctx_tiles); active = (kr >= r0w) && (kr < r0w + 8); dr = kr - qgr + 7; }
        if (!active) continue;
        f32x16 st[2];
#pragma unroll
        for (int kb = 0; kb < 2; ++kb) for (int i = 0; i < 16; ++i) st[kb][i] = 0.f;
        {
            constexpr int NT = 2 * NKS;
            bf16x8 kr[4];
#define K_READ(R, T) asm volatile("ds_read_b128 %0, %1 offset:%2" : "=v"(R) : "v"(kfr_base), "n"(32 * ((T) / NKS) * KST + 32 * ((T) % NKS)) : "memory")
#define K_WAIT(R, N) asm volatile("s_waitcnt lgkmcnt(%1)" : "+v"(R) : "n"(N) : "memory")
            K_READ(kr[0], 0); K_READ(kr[1], 1); K_READ(kr[2], 2); K_READ(kr[3], 3);
#pragma unroll
            for (int t = 0; t < NT; ++t) {
                K_WAIT(kr[t & 3], (NT - 1 - t) < 3 ? (NT - 1 - t) : 3);
                st[t / NKS] = __builtin_amdgcn_mfma_f32_32x32x16_bf16(kr[t & 3], qf[t % NKS], st[t / NKS], 0, 0, 0);
                if (t + 4 < NT) K_READ(kr[t & 3], t + 4);
            }
#undef K_READ
#undef K_WAIT
        }
        s16x4 vlo[4], vhi[4];
#define V_READ(I, T) asm volatile("ds_read_b64_tr_b16 %0, %2 offset:%3\n\tds_read_b64_tr_b16 %1, %2 offset:%4" : "=&v"(vlo[I]), "=&v"(vhi[I]) : "v"(vtr_base), "n"(16 * ((T) >> 2) * VST + 64 * ((T) & 3)), "n"(16 * ((T) >> 2) * VST + 64 * ((T) & 3) + 8 * VST) : "memory")
#define V_WAIT(I, N) asm volatile("s_waitcnt lgkmcnt(%2)" : "+v"(vlo[I]), "+v"(vhi[I]) : "n"(N) : "memory")
        V_READ(0, 0); V_READ(1, 1); V_READ(2, 2); V_READ(3, 3);
        if constexpr (FAST) {
        float tmax = -1e30f;
        if (NA && j >= p.nctx_tiles) {
#pragma unroll
            for (int kb = 0; kb < 2; ++kb)
#pragma unroll
                for (int i = 0; i < 16; ++i) {
                    const int kc = 32 * kb + (i & 3) + 8 * (i >> 2) + 4 * hh; const bool inw = (kc >= csq) && (kc < csq + 16);
                    const int dc = min(max(kc - qc + 15, 0), 30); const float bias = rp[dr * 31 + dc];
                    const float sv = inw ? __builtin_fmaf(st[kb][i], p.sc_log2e, bias * 1.4426950408889634f) : -1e30f;
                    st[kb][i] = sv; tmax = fmaxf(tmax, sv); }
        } else {
#pragma unroll
            for (int kb = 0; kb < 2; ++kb)
#pragma unroll
                for (int i = 0; i < 16; ++i) tmax = fmaxf(tmax, st[kb][i]);
            tmax *= p.sc_log2e;
        }
        tmax = fmaxf(tmax, __shfl_xor(tmax, 32));
        if (__any(tmax > m_run + 11.5f)) {
            const float m_new = fmaxf(m_run, tmax);
            const float alpha = __builtin_amdgcn_exp2f(m_run - m_new);
            m_run = m_new; l_run *= alpha;
#pragma unroll
            for (int d = 0; d < 4; ++d)
#pragma unroll
                for (int i = 0; i < 16; ++i) oacc[d][i] *= alpha;
        }
        float psum = 0.f;
        if (NA && j >= p.nctx_tiles) {
#pragma unroll
            for (int kb = 0; kb < 2; ++kb)
#pragma unroll
                for (int i = 0; i < 16; ++i) { const float e = __builtin_amdgcn_exp2f(st[kb][i] - m_run); st[kb][i] = e; psum += e; }
        } else {
#pragma unroll
            for (int kb = 0; kb < 2; ++kb)
#pragma unroll
                for (int i = 0; i < 16; ++i) { const float e = __builtin_amdgcn_exp2f(__builtin_fmaf(st[kb][i], p.sc_log2e, -m_run)); st[kb][i] = e; psum += e; }
        }
        l_run += psum;
        } else {
        float tmax = -1e30f;
#pragma unroll
        for (int kb = 0; kb < 2; ++kb)
#pragma unroll
            for (int i = 0; i < 16; ++i) {
                float s = st[kb][i] * p.sc_log2e;
                if (NA && j >= p.nctx_tiles) { const int kc = 32 * kb + (i & 3) + 8 * (i >> 2) + 4 * hh; const bool inw = (kc >= csq) && (kc < csq + 16);
                    const int dc = min(max(kc - qc + 15, 0), 30); const float bias = rp[dr * 31 + dc];
                    s = inw ? (s + bias * 1.4426950408889634f) : -1e30f; }
                st[kb][i] = s; tmax = fmaxf(tmax, s); }
        tmax = fmaxf(tmax, __shfl_xor(tmax, 32));
        const float m_new = fmaxf(m_run, tmax);
        const float alpha = exp2f(m_run - m_new);
        m_run = m_new;
        float psum = 0.f;
#pragma unroll
        for (int kb = 0; kb < 2; ++kb)
#pragma unroll
            for (int i = 0; i < 16; ++i) { const float e = exp2f(st[kb][i] - m_new); st[kb][i] = e; psum += e; }
        l_run = l_run * alpha + psum;
#pragma unroll
        for (int d = 0; d < 4; ++d)
#pragma unroll
            for (int i = 0; i < 16; ++i) oacc[d][i] *= alpha;
        }
#pragma unroll
        for (int t = 0; t < 16; ++t) {
            const int T = t >> 2, KB = T >> 1, S = T & 1, d = t & 3;
            u32x4 pp; pp.x = pk2(st[KB][8 * S + 0], st[KB][8 * S + 1]); pp.y = pk2(st[KB][8 * S + 2], st[KB][8 * S + 3]);
            pp.z = pk2(st[KB][8 * S + 4], st[KB][8 * S + 5]); pp.w = pk2(st[KB][8 * S + 6], st[KB][8 * S + 7]);
            const bf16x8 pf = __builtin_bit_cast(bf16x8, pp);
            if (t < 13) V_WAIT(t & 3, 6); else if (t == 13) V_WAIT(t & 3, 4); else if (t == 14) V_WAIT(t & 3, 2); else V_WAIT(t & 3, 0);
            oacc[d] = __builtin_amdgcn_mfma_f32_32x32x16_bf16(__builtin_shufflevector(vlo[t & 3], vhi[t & 3], 0, 1, 2, 3, 4, 5, 6, 7), pf, oacc[d], 0, 0, 0);
            if (t + 4 < 16) {
                if ((t & 3) == 0) V_READ(0, t + 4); else if ((t & 3) == 1) V_READ(1, t + 4); else if ((t & 3) == 2) V_READ(2, t + 4); else V_READ(3, t + 4);
            }
        }
#undef V_READ
#undef V_WAIT
    }
    const float lt = l_run + __shfl_xor(l_run, 32);
    const float il = 1.f / lt;
    unsigned char* op = p.O + (size_t)(p.orow0 + 32 * w + r) * p.ldo;
    const float ils = il * FP8_ASC;
#pragma unroll
    for (int d = 0; d < 4; ++d)
#pragma unroll
        for (int g = 0; g < 4; ++g) *(int*)(op + 32 * d + 8 * g + 4 * hh) = pk4_fp8(oacc[d][4 * g + 0] * ils, oacc[d][4 * g + 1] * ils, oacc[d][4 * g + 2] * ils, oacc[d][4 * g + 3] * ils);
    __syncthreads();
#undef ATT_TILE_ROW
#undef ATT_ISSUE
#undef ATT_WRITE
}

typedef int i32x8 __attribute__((ext_vector_type(8)));
struct AttnQK8 { const unsigned char* Q8; int ldq8; const unsigned char* K8a; int ldk8a; const unsigned char* K8b; int ldk8b; const unsigned char* V8; int ldv8; };
template <int DK, bool QBF16, bool NA = false, bool QROPE = false>
DI void attn_unit_f8(const Frame& F, const AttnP& p, const AttnQK8& e) {
    constexpr int KST = DK + 16, VS8 = 144, KBYTES = 64 * KST, VBYTES = 64 * VS8;
    constexpr float QC = (DK == 192) ? 1.665880740f : 1.020139447f; constexpr int KSCALE = ((DK == 192) ? 115 : 116) * 0x01010101;
    constexpr float PTHR = 4.f;
    constexpr int NC = DK / 64, KCH = DK / 16, NCHUNK = 64 * KCH, KLD = (NCHUNK + 511) / 512, NT = 2 * NC;
    LAS unsigned char* Ks = F.lds; LAS unsigned char* Vs = F.lds + KBYTES; LAS float* rp = (LAS float*)(F.lds + KBYTES + VBYTES);
    const int lane = F.lane, w = F.wave, r = lane & 31, hh = lane >> 5;
    const int ntiles = p.nctx_tiles + p.nx_tiles;
    if (NA) { for (int i = F.tid; i < 15 * 31; i += 512) rp[i] = p.rpb[i]; }
    i32x8 qf[NC];
    if constexpr (QBF16) {
        const bf16_t* qp = p.Q + (size_t)(p.qrow0 + 32 * w + r) * p.ldq + 32 * hh;
#pragma unroll
        for (int c = 0; c < NC; ++c) {
#pragma unroll
            for (int g = 0; g < 4; ++g) { const u32x4 q4 = *(const u32x4*)(qp + 64 * c + 8 * g);
                qf[c][2 * g] = pk4_fp8(bflo(q4.x) * (QK8_SC * QC), bfhi(q4.x) * (QK8_SC * QC), bflo(q4.y) * (QK8_SC * QC), bfhi(q4.y) * (QK8_SC * QC));
                qf[c][2 * g + 1] = pk4_fp8(bflo(q4.z) * (QK8_SC * QC), bfhi(q4.z) * (QK8_SC * QC), bflo(q4.w) * (QK8_SC * QC), bfhi(q4.w) * (QK8_SC * QC)); } }
        if constexpr (QROPE) {
            float v[32];
#pragma unroll
            for (int g = 0; g < 4; ++g) { const u32x4 q4 = *(const u32x4*)(qp + 64 * (NC - 1) + 8 * g);
                v[8 * g + 0] = bflo(q4.x); v[8 * g + 1] = bfhi(q4.x); v[8 * g + 2] = bflo(q4.y); v[8 * g + 3] = bfhi(q4.y);
                v[8 * g + 4] = bflo(q4.z); v[8 * g + 5] = bfhi(q4.z); v[8 * g + 6] = bflo(q4.w); v[8 * g + 7] = bfhi(q4.w); }
            const int tpos = (p.qrow0 + 32 * w + r) & 2047; const float pos = (float)(hh ? (tpos & 63) : (tpos >> 6));
#pragma unroll
            for (int i = 0; i < 16; ++i) { const float ang = pos * exp2f(-(float)i * (13.287712379549449f / 16.f)); const float sn = __sinf(ang), cs = __cosf(ang);
                const float x0 = v[i], x1 = v[i + 16]; v[i] = x0 * cs - x1 * sn; v[i + 16] = x1 * cs + x0 * sn; }
#pragma unroll
            for (int g = 0; g < 8; ++g) qf[NC - 1][g] = pk4_fp8(v[4 * g] * (QK8_SC * QC), v[4 * g + 1] * (QK8_SC * QC), v[4 * g + 2] * (QK8_SC * QC), v[4 * g + 3] * (QK8_SC * QC));
        }
    } else {
      const unsigned char* qp = e.Q8 + (size_t)(p.qrow0 + 32 * w + r) * e.ldq8 + 32 * hh;
#pragma unroll
      for (int c = 0; c < NC; ++c) { const u32x4 qa = *(const u32x4*)(qp + 64 * c), qb = *(const u32x4*)(qp + 64 * c + 16); qf[c] = __builtin_bit_cast(i32x8, __builtin_shufflevector(qa, qb, 0, 1, 2, 3, 4, 5, 6, 7)); } }
    f32x16 oacc[4];
#pragma unroll
    for (int d = 0; d < 4; ++d) for (int i = 0; i < 16; ++i) oacc[d][i] = 0.f;
    constexpr bool LSUM = (DK == 128 && !NA);
    float l_run = 0.f;
    f32x16 lacc;
#pragma unroll
    for (int i = 0; i < 16; ++i) lacc[i] = 0.f;
    f32x16 cinit;
#pragma unroll
    for (int i = 0; i < 16; ++i) cinit[i] = 0.f;
    u32x4 kreg[KLD], vreg;
#define A8_TILE_ROW(j) (((j) < p.nctx_tiles) ? (MXR + p.b * CTXL + 64 * (j)) : (p.b * SEQ + 64 * (p.xtile0 + (j) - p.nctx_tiles)))
#define A8_ISSUE(j) do { const int row0_ = A8_TILE_ROW(j); \
        _Pragma("unroll") for (int i_ = 0; i_ < KLD; ++i_) { const int c_ = F.tid + 512 * i_, kr_ = c_ / KCH, kc_ = c_ % KCH; \
            if (c_ < NCHUNK) { if (DK == 128 || kc_ < 8) kreg[i_] = *(const u32x4*)(e.K8a + (size_t)(row0_ + kr_) * e.ldk8a + 16 * kc_); \
                               else kreg[i_] = *(const u32x4*)(e.K8b + (size_t)(row0_ + kr_) * e.ldk8b + 16 * (kc_ - 8)); } } \
        vreg = *(const u32x4*)(e.V8 + (size_t)(row0_ + (F.tid >> 3)) * e.ldv8 + 16 * (F.tid & 7)); } while (0)
#define A8_WRITE() do { \
        _Pragma("unroll") for (int i_ = 0; i_ < KLD; ++i_) { const int c_ = F.tid + 512 * i_, kr_ = c_ / KCH, kc_ = c_ % KCH; if (c_ < NCHUNK) *(LAS u32x4*)(Ks + kr_ * KST + 16 * kc_) = kreg[i_]; } \
        *(LAS u32x4*)(Vs + (F.tid >> 3) * VS8 + 16 * (F.tid & 7)) = vreg; } while (0)
    const int qgr = NA ? (p.qgrow0 + (w >> 1)) : 0;
    const int qc = 32 * (w & 1) + r;
    const int r0w = NA ? min(max(qgr - 4, 0), 24) : 0;
    const int csq = min(max(qc - 8, 0), 48);
    const unsigned vt_base = (unsigned)(size_t)(Vs) + (unsigned)((8 * (((lane & 15) >> 1) >> 2) + 4 * hh + (((lane & 15) >> 1) & 3)) * VS8 + 16 * ((lane >> 4) & 1) + 8 * (lane & 1));
    const unsigned kfr_base = (unsigned)(size_t)(Ks) + (unsigned)(r * KST + 32 * hh);
    A8_ISSUE(0);
    for (int j = 0; j < ntiles; ++j) {
        __syncthreads();
        A8_WRITE();
        if (j + 1 < ntiles) A8_ISSUE(j + 1);
        __syncthreads();
        bool active = true; int dr = 0;
        if (NA && j >= p.nctx_tiles) { const int krow = p.xtile0 + (j - p.nctx_tiles); active = (krow >= r0w) && (krow < r0w + 8); dr = krow - qgr + 7; }
        if (!active) continue;
        f32x16 st[2];
        {
            u32x4 klo[4], khi[4];
#define K8_READ(I, T) asm volatile("ds_read_b128 %0, %2 offset:%3\n\tds_read_b128 %1, %2 offset:%4" : "=&v"(klo[I]), "=&v"(khi[I]) : "v"(kfr_base), "n"(32 * ((T) / NC) * KST + 64 * ((T) % NC)), "n"(32 * ((T) / NC) * KST + 64 * ((T) % NC) + 16) : "memory")
#define K8_WAIT(I, N) asm volatile("s_waitcnt lgkmcnt(%2)" : "+v"(klo[I]), "+v"(khi[I]) : "n"(N) : "memory")
            K8_READ(0, 0); K8_READ(1, 1); K8_READ(2, 2); K8_READ(3, 3);
#pragma unroll
            for (int t = 0; t < NT; ++t) {
                const int last = (t + 3 < NT - 1) ? t + 3 : NT - 1;
                if ((t & 3) == 0) K8_WAIT(0, 2 * (last - t)); else if ((t & 3) == 1) K8_WAIT(1, 2 * (last - t)); else if ((t & 3) == 2) K8_WAIT(2, 2 * (last - t)); else K8_WAIT(3, 2 * (last - t));
                const i32x8 kf = __builtin_bit_cast(i32x8, __builtin_shufflevector(klo[t & 3], khi[t & 3], 0, 1, 2, 3, 4, 5, 6, 7));
                st[t / NC] = __builtin_amdgcn_mfma_scale_f32_32x32x64_f8f6f4(kf, qf[t % NC], (t % NC == 0) ? cinit : st[t / NC], 0, 0, 0, KSCALE, 0, 0x7f7f7f7f);
                if (t + 4 < NT) { if ((t & 3) == 0) K8_READ(0, t + 4); else if ((t & 3) == 1) K8_READ(1, t + 4); else if ((t & 3) == 2) K8_READ(2, t + 4); else K8_READ(3, t + 4); }
            }
#undef K8_READ
#undef K8_WAIT
        }
        u32x2 va[2][4];
#define V_READ(I, D) asm volatile("ds_read_b64_tr_b8 %0, %4 offset:%5\n\tds_read_b64_tr_b8 %1, %4 offset:%6\n\tds_read_b64_tr_b8 %2, %4 offset:%7\n\tds_read_b64_tr_b8 %3, %4 offset:%8" \
            : "=&v"(va[I][0]), "=&v"(va[I][1]), "=&v"(va[I][2]), "=&v"(va[I][3]) : "v"(vt_base), "n"(32 * (D)), "n"(16 * VS8 + 32 * (D)), "n"(32 * VS8 + 32 * (D)), "n"(48 * VS8 + 32 * (D)) : "memory")
#define V_WAIT(I, N) asm volatile("s_waitcnt lgkmcnt(%4)" : "+v"(va[I][0]), "+v"(va[I][1]), "+v"(va[I][2]), "+v"(va[I][3]) : "n"(N) : "memory")
        V_READ(0, 0); V_READ(1, 1);
        float tmax = -1e30f;
        const bool masked = NA && j >= p.nctx_tiles;
        if (masked) {
#pragma unroll
            for (int kb = 0; kb < 2; ++kb)
#pragma unroll
                for (int i = 0; i < 16; ++i) {
                    const int kc = 32 * kb + (i & 3) + 8 * (i >> 2) + 4 * hh; const bool inw = (kc >= csq) && (kc < csq + 16);
                    const int dc = min(max(kc - qc + 15, 0), 30); const float bias = rp[dr * 31 + dc];
                    const float sv = inw ? __builtin_fmaf(bias, 1.4426950408889634f, st[kb][i]) : -1e30f;
                    st[kb][i] = sv; tmax = fmaxf(tmax, sv); }
        } else {
#pragma unroll
            for (int kb = 0; kb < 2; ++kb)
#pragma unroll
                for (int i = 0; i < 16; ++i) tmax = fmaxf(tmax, st[kb][i]);
        }
        tmax = fmaxf(tmax, __shfl_xor(tmax, 32));
        if (j == 0 || __any(tmax > 4.f + PTHR)) {
            const float dm = (j == 0) ? (tmax - 4.f) : fmaxf(tmax - 4.f, 0.f);
            const float alpha = __builtin_amdgcn_exp2f(-dm);
            l_run *= alpha;
            if constexpr (LSUM) {
#pragma unroll
                for (int i = 0; i < 16; ++i) lacc[i] *= alpha; }
#pragma unroll
            for (int d = 0; d < 4; ++d)
#pragma unroll
                for (int i = 0; i < 16; ++i) oacc[d][i] *= alpha;
#pragma unroll
            for (int kb = 0; kb < 2; ++kb)
#pragma unroll
                for (int i = 0; i < 16; ++i) st[kb][i] -= dm;
            const float cn = cinit[0] - dm;
#pragma unroll
            for (int i = 0; i < 16; ++i) cinit[i] = cn;
        }
        float psum = 0.f;
#pragma unroll
        for (int kb = 0; kb < 2; ++kb)
#pragma unroll
            for (int i = 0; i < 16; ++i) { const float ex = __builtin_amdgcn_exp2f(st[kb][i]); st[kb][i] = ex; if constexpr (!LSUM) psum += ex; }
        l_run += psum;
        i32x8 pf;
#pragma unroll
        for (int v = 0; v < 8; ++v) { const int kb = v >> 2, m = v & 3;
            int t = __builtin_amdgcn_cvt_pk_fp8_f32(st[kb][4 * m], st[kb][4 * m + 1], 0, false); pf[v] = __builtin_amdgcn_cvt_pk_fp8_f32(st[kb][4 * m + 2], st[kb][4 * m + 3], t, true); }
        if constexpr (LSUM) { i32x8 ones; for (int v = 0; v < 8; ++v) ones[v] = 0x38383838;
            lacc = __builtin_amdgcn_mfma_scale_f32_32x32x64_f8f6f4(ones, pf, lacc, 0, 0, 0, 0x7f7f7f7f, 0, 0x7f7f7f7f); }
#pragma unroll
        for (int d = 0; d < 4; ++d) {
            if (d == 0) V_WAIT(0, 4); else if (d == 1) V_WAIT(1, 4); else if (d == 2) V_WAIT(0, 4); else V_WAIT(1, 0);
            const i32x8 vf = __builtin_bit_cast(i32x8, __builtin_shufflevector(__builtin_shufflevector(va[d & 1][0], va[d & 1][1], 0, 1, 2, 3), __builtin_shufflevector(va[d & 1][2], va[d & 1][3], 0, 1, 2, 3), 0, 1, 2, 3, 4, 5, 6, 7));
            oacc[d] = __builtin_amdgcn_mfma_scale_f32_32x32x64_f8f6f4(vf, pf, oacc[d], 0, 0, 0, 0x7f7f7f7f, 0, 0x7f7f7f7f);
            if (d == 0) V_READ(0, 2); else if (d == 1) V_READ(1, 3);
        }
#undef V_READ
#undef V_WAIT
    }
    const float lt = LSUM ? lacc[0] : (l_run + __shfl_xor(l_run, 32));
    const float il = 1.f / lt;
    unsigned char* op = p.O + (size_t)(p.orow0 + 32 * w + r) * p.ldo;
    const float ils = il * FP8_ASC;
#pragma unroll
    for (int d = 0; d < 4; ++d) {
        unsigned wq[4];
#pragma unroll
        for (int g = 0; g < 4; ++g) wq[g] = (unsigned)pk4_fp8(oacc[d][4 * g + 0] * ils, oacc[d][4 * g + 1] * ils, oacc[d][4 * g + 2] * ils, oacc[d][4 * g + 3] * ils);
        const auto s02 = __builtin_amdgcn_permlane32_swap(wq[0], wq[2], false, false), s13 = __builtin_amdgcn_permlane32_swap(wq[1], wq[3], false, false);
        *(u32x4*)(op + 32 * d + 16 * hh) = (u32x4){s02[0], s02[1], s13[0], s13[1]};
    }
    __syncthreads();
#undef A8_TILE_ROW
#undef A8_ISSUE
#undef A8_WRITE
}

DI int hg_tok_row(int b, int dir, int c, int t) {
    if (c < 8) { const int pos = 32 * c + t; return MXR + b * CTXL + (dir ? (CTXL - 1 - pos) : pos); }
    const int pos = 32 * (c - 8) + t; return b * SEQ + (dir ? (SEQ - 1 - pos) : pos);
}
DI void hgrn_pair(const Frame& F, const Args& a, int pair) {
    const int b = pair >> 3, h = pair & 7, dir = F.tid >> 8;
    const bf16_t* Z = (const bf16_t*)(a.ws + WS_Z);
    bf16_t* OUT = (bf16_t*)(a.ws + (dir ? WS_OB : WS_OF));
    LAS unsigned char* base = F.lds + dir * 65536;
    LAS float* G = (LAS float*)base;
    LAS unsigned char* QE1 = base + 16384;
    LAS unsigned char* KE = base + 25088;
    LAS unsigned char* QE2 = base + 33792;
    LAS unsigned char* KDr = base + 42496;
    LAS unsigned char* VVr = base + 51712;
    LAS float* DL = (LAS float*)(base + 60928);
    const int t256 = F.tid & 255, lane = F.lane, wl = F.wave & 3;
    const int tau = t256 >> 3, dq = (t256 & 7) * 16;
    LAS float* LB = (LAS float*)(base + 61440);
    if (t256 < 128) { const float* hl = a.in[I_HLB] + (size_t)dir * 3 * 1024 + h * 128 + t256; const float v0 = hl[0], v1 = hl[1024], v2 = hl[2048]; const float mx = fmaxf(v0, fmaxf(v1, v2));
        const float e0 = __expf(v0 - mx), e1 = __expf(v1 - mx), e2 = __expf(v2 - mx); LB[t256] = e0 / (e0 + e1 + e2); }
    __syncthreads();
    const int qcol = 1536 + h * 128 + dq, fcol = (dir ? 3584 : 2560) + h * 128 + dq, vcol = 4608 + h * 128 + dq;
    u32x4 rq[2], rf[2], rv[2];
#pragma unroll
    for (int g = 0; g < 2; ++g) {
        { const bf16_t* zr = Z + (size_t)hg_tok_row(b, dir, 0, tau) * EV_IN + 8 * g; rq[g] = *(const u32x4*)(zr + qcol); rf[g] = *(const u32x4*)(zr + fcol); rv[g] = *(const u32x4*)(zr + vcol); }
    }
    f32x4 S[2][8];
#pragma unroll
    for (int nb = 0; nb < 2; ++nb)
#pragma unroll
        for (int i = 0; i < 8; ++i) S[nb][i] = (f32x4){0.f, 0.f, 0.f, 0.f};
    const int fr = lane & 15, fg = lane >> 4;
    for (int c = 0; c < 72; ++c) {
        float kv[2][8], gv[2][8];
#pragma unroll
        for (int g = 0; g < 2; ++g) {
            const unsigned uf[4] = {rf[g].x, rf[g].y, rf[g].z, rf[g].w};
            const f32x4 lb0 = *(const LAS f32x4*)(LB + dq + 8 * g), lb1 = *(const LAS f32x4*)(LB + dq + 8 * g + 4); const float lbv[8] = {lb0[0], lb0[1], lb0[2], lb0[3], lb1[0], lb1[1], lb1[2], lb1[3]};
#pragma unroll
            for (int i = 0; i < 4; ++i) {
                const float f0 = bflo(uf[i]), f1 = bfhi(uf[i]);
                const float s0 = 1.f / (1.f + __expf(-f0)), s1 = 1.f / (1.f + __expf(-f1));
                const float l0 = lbv[2 * i], l1 = lbv[2 * i + 1];
                kv[g][2 * i] = (1.f - l0) * (1.f - s0); kv[g][2 * i + 1] = (1.f - l1) * (1.f - s1);
                gv[g][2 * i] = __logf(l0 + (1.f - l0) * s0); gv[g][2 * i + 1] = __logf(l1 + (1.f - l1) * s1); }
            *(LAS f32x4*)(G + tau * 128 + dq + 8 * g) = (f32x4){gv[g][0], gv[g][1], gv[g][2], gv[g][3]};
            *(LAS f32x4*)(G + tau * 128 + dq + 8 * g + 4) = (f32x4){gv[g][4], gv[g][5], gv[g][6], gv[g][7]}; }
        __syncthreads();
        if (t256 < 128) { float run = 0.f;
#pragma unroll
            for (int t = 0; t < 32; ++t) { run += G[t * 128 + t256]; G[t * 128 + t256] = run; } }
        __syncthreads();
#pragma unroll
        for (int g = 0; g < 2; ++g) { const int d0 = dq + 8 * g;
          const f32x4 c0 = *(const LAS f32x4*)(G + tau * 128 + d0), c1 = *(const LAS f32x4*)(G + tau * 128 + d0 + 4);
          const f32x4 m0 = *(const LAS f32x4*)(G + 15 * 128 + d0), m1 = *(const LAS f32x4*)(G + 15 * 128 + d0 + 4);
          const f32x4 e0 = *(const LAS f32x4*)(G + 31 * 128 + d0), e1 = *(const LAS f32x4*)(G + 31 * 128 + d0 + 4);
          float cu[8] = {c0[0], c0[1], c0[2], c0[3], c1[0], c1[1], c1[2], c1[3]};
          float mm[8] = {m0[0], m0[1], m0[2], m0[3], m1[0], m1[1], m1[2], m1[3]};
          float la[8] = {e0[0], e0[1], e0[2], e0[3], e1[0], e1[1], e1[2], e1[3]};
          const unsigned uq[4] = {rq[g].x, rq[g].y, rq[g].z, rq[g].w};
          float qv[8], q1[8], k1[8], q2[8], kd[8];
#pragma unroll
          for (int i = 0; i < 4; ++i) { qv[2 * i] = bflo(uq[i]); qv[2 * i + 1] = bfhi(uq[i]); }
#pragma unroll
          for (int i = 0; i < 8; ++i) { q1[i] = qv[i] * __expf(cu[i] - mm[i]); k1[i] = kv[g][i] * __expf(mm[i] - cu[i]); q2[i] = qv[i] * __expf(cu[i]); kd[i] = kv[g][i] * __expf(la[i] - cu[i]); }
          u32x4 o;
          o.x = pk2(q1[0], q1[1]); o.y = pk2(q1[2], q1[3]); o.z = pk2(q1[4], q1[5]); o.w = pk2(q1[6], q1[7]); *(LAS u32x4*)(QE1 + tau * 272 + d0 * 2) = o;
          o.x = pk2(k1[0], k1[1]); o.y = pk2(k1[2], k1[3]); o.z = pk2(k1[4], k1[5]); o.w = pk2(k1[6], k1[7]); *(LAS u32x4*)(KE + tau * 272 + d0 * 2) = o;
          o.x = pk2(q2[0], q2[1]); o.y = pk2(q2[2], q2[3]); o.z = pk2(q2[4], q2[5]); o.w = pk2(q2[6], q2[7]); *(LAS u32x4*)(QE2 + tau * 272 + d0 * 2) = o;
          o.x = pk2(kd[0], kd[1]); o.y = pk2(kd[2], kd[3]); o.z = pk2(kd[4], kd[5]); o.w = pk2(kd[6], kd[7]); *(LAS u32x4*)(KDr + tau * 288 + d0 * 2) = o;
          *(LAS u32x4*)(VVr + tau * 288 + d0 * 2) = rv[g];
          if (tau == 31) {
#pragma unroll
              for (int i = 0; i < 8; ++i) DL[d0 + i] = __expf(la[i]); } }
#pragma unroll
        for (int g = 0; g < 2; ++g) { const int cn = (c + 1 < 72) ? c + 1 : 71; const bf16_t* zr = Z + (size_t)hg_tok_row(b, dir, cn, tau) * EV_IN + 8 * g; rq[g] = *(const u32x4*)(zr + qcol); rf[g] = *(const u32x4*)(zr + fcol); rv[g] = *(const u32x4*)(zr + vcol); }
        __syncthreads();
        f32x4 X00 = {0.f, 0.f, 0.f, 0.f}, X01 = X00, X11 = X00;
#pragma unroll
        for (int ks = 0; ks < 4; ++ks) {
            const bf16x8 ke0 = *(const LAS bf16x8*)(KE + fr * 272 + (32 * ks + 8 * fg) * 2), ke1 = *(const LAS bf16x8*)(KE + (16 + fr) * 272 + (32 * ks + 8 * fg) * 2);
            const bf16x8 qe0 = *(const LAS bf16x8*)(QE1 + fr * 272 + (32 * ks + 8 * fg) * 2), qe1 = *(const LAS bf16x8*)(QE1 + (16 + fr) * 272 + (32 * ks + 8 * fg) * 2);
            X00 = __builtin_amdgcn_mfma_f32_16x16x32_bf16(ke0, qe0, X00, 0, 0, 0);
            X01 = __builtin_amdgcn_mfma_f32_16x16x32_bf16(ke0, qe1, X01, 0, 0, 0);
            X11 = __builtin_amdgcn_mfma_f32_16x16x32_bf16(ke1, qe1, X11, 0, 0, 0);
        }
#pragma unroll
        for (int i = 0; i < 4; ++i) { const bool keep = (4 * fg + i) <= fr; X00[i] = keep ? X00[i] : 0.f; X11[i] = keep ? X11[i] : 0.f; }
        u32x4 p0; p0.x = pk2(X00[0], X00[1]); p0.y = pk2(X00[2], X00[3]); p0.z = 0u; p0.w = 0u;
        u32x4 p1; p1.x = pk2(X01[0], X01[1]); p1.y = pk2(X01[2], X01[3]); p1.z = pk2(X11[0], X11[1]); p1.w = pk2(X11[2], X11[3]);
#pragma unroll
        for (int nb = 0; nb < 2; ++nb) {
            const int dvc = 32 * wl + 16 * nb;
            bf16x8 vf;
            { s16x4 v0, v1; const unsigned va = (unsigned)(size_t)VVr + (unsigned)((4 * fg + ((lane & 15) >> 2)) * 288 + (dvc + 4 * (lane & 3)) * 2);
              asm volatile("ds_read_b64_tr_b16 %0, %2\n\tds_read_b64_tr_b16 %1, %2 offset:4608\n\ts_waitcnt lgkmcnt(0)" : "=&v"(v0), "=&v"(v1) : "v"(va) : "memory");
              vf = __builtin_shufflevector(v0, v1, 0, 1, 2, 3, 4, 5, 6, 7); }
            f32x4 o0 = {0.f, 0.f, 0.f, 0.f}, o1 = o0;
            o0 = __builtin_amdgcn_mfma_f32_16x16x32_bf16(__builtin_bit_cast(bf16x8, p0), vf, o0, 0, 0, 0);
            o1 = __builtin_amdgcn_mfma_f32_16x16x32_bf16(__builtin_bit_cast(bf16x8, p1), vf, o1, 0, 0, 0);
#pragma unroll
            for (int ks = 0; ks < 4; ++ks) {
                u32x4 sp; sp.x = pk2(S[nb][2 * ks][0], S[nb][2 * ks][1]); sp.y = pk2(S[nb][2 * ks][2], S[nb][2 * ks][3]); sp.z = pk2(S[nb][2 * ks + 1][0], S[nb][2 * ks + 1][1]); sp.w = pk2(S[nb][2 * ks + 1][2], S[nb][2 * ks + 1][3]);
                const bf16x8 sf = __builtin_bit_cast(bf16x8, sp);
                const s16x4 a00 = *(const LAS s16x4*)(QE2 + fr * 272 + (32 * ks + 4 * fg) * 2), a01 = *(const LAS s16x4*)(QE2 + fr * 272 + (32 * ks + 16 + 4 * fg) * 2);
                const s16x4 a10 = *(const LAS s16x4*)(QE2 + (16 + fr) * 272 + (32 * ks + 4 * fg) * 2), a11 = *(const LAS s16x4*)(QE2 + (16 + fr) * 272 + (32 * ks + 16 + 4 * fg) * 2);
                o0 = __builtin_amdgcn_mfma_f32_16x16x32_bf16(__builtin_shufflevector(a00, a01, 0, 1, 2, 3, 4, 5, 6, 7), sf, o0, 0, 0, 0);
                o1 = __builtin_amdgcn_mfma_f32_16x16x32_bf16(__builtin_shufflevector(a10, a11, 0, 1, 2, 3, 4, 5, 6, 7), sf, o1, 0, 0, 0);
            }
#pragma unroll
            for (int db = 0; db < 8; ++db) {
                const f32x4 dl = *(const LAS f32x4*)(DL + 16 * db + 4 * fg);
                s16x4 k0, k1; { const unsigned ka = (unsigned)(size_t)KDr + (unsigned)((4 * fg + ((lane & 15) >> 2)) * 288 + (16 * db + 4 * (lane & 3)) * 2);
                  asm volatile("ds_read_b64_tr_b16 %0, %2\n\tds_read_b64_tr_b16 %1, %2 offset:4608\n\ts_waitcnt lgkmcnt(0)" : "=&v"(k0), "=&v"(k1) : "v"(ka) : "memory"); }
                f32x4 sc = S[nb][db] * dl;
                S[nb][db] = __builtin_amdgcn_mfma_f32_16x16x32_bf16(__builtin_shufflevector(k0, k1, 0, 1, 2, 3, 4, 5, 6, 7), vf, sc, 0, 0, 0);
            }
#pragma unroll
            for (int i = 0; i < 4; ++i) {
                OUT[(size_t)hg_tok_row(b, dir, c, 4 * fg + i) * 1024 + h * 128 + dvc + fr] = (bf16_t)(pk2(o0[i], 0.f) & 0xffffu);
                OUT[(size_t)hg_tok_row(b, dir, c, 16 + 4 * fg + i) * 1024 + h * 128 + dvc + fr] = (bf16_t)(pk2(o1[i], 0.f) & 0xffffu);
            }
        }
    }
    __syncthreads();
}

DI void hgrn_readout_phase(const Frame& F, const Args& a) {
    const bf16_t* OFp = (const bf16_t*)(a.ws + WS_OF); const bf16_t* OBp = (const bf16_t*)(a.ws + WS_OB);
    const bf16_t* Z = (const bf16_t*)(a.ws + WS_Z); unsigned char* Y = a.ws + WS_ACT;
    const float* wn = a.in[I_HON] + 16 * F.lane;
    float wv[16];
#pragma unroll
    for (int i = 0; i < 16; ++i) wv[i] = wn[i];
    for (int row = F.gw; row < MT; row += F.ngw) {
        const u32x4 f0 = *(const u32x4*)(OFp + (size_t)row * 1024 + 16 * F.lane), f1 = *(const u32x4*)(OFp + (size_t)row * 1024 + 16 * F.lane + 8);
        const u32x4 b0 = *(const u32x4*)(OBp + (size_t)row * 1024 + 16 * F.lane), b1 = *(const u32x4*)(OBp + (size_t)row * 1024 + 16 * F.lane + 8);
        const u32x4 g0 = *(const u32x4*)(Z + (size_t)row * EV_IN + 5632 + 16 * F.lane), g1 = *(const u32x4*)(Z + (size_t)row * EV_IN + 5632 + 16 * F.lane + 8);
        const unsigned uf[8] = {f0.x, f0.y, f0.z, f0.w, f1.x, f1.y, f1.z, f1.w}, ub[8] = {b0.x, b0.y, b0.z, b0.w, b1.x, b1.y, b1.z, b1.w}, ug[8] = {g0.x, g0.y, g0.z, g0.w, g1.x, g1.y, g1.z, g1.w};
        float o[16], gt[16]; float ss = 0.f;
#pragma unroll
        for (int i = 0; i < 8; ++i) { o[2 * i] = bflo(uf[i]) + bflo(ub[i]); o[2 * i + 1] = bfhi(uf[i]) + bfhi(ub[i]); gt[2 * i] = bflo(ug[i]); gt[2 * i + 1] = bfhi(ug[i]);
            ss += o[2 * i] * o[2 * i] + o[2 * i + 1] * o[2 * i + 1]; }
        ss += __shfl_xor(ss, 1); ss += __shfl_xor(ss, 2); ss += __shfl_xor(ss, 4);
        const float rs = __frsqrt_rn(ss * (1.f / 128.f) + EPS);
        unsigned pk[4];
#pragma unroll
        for (int i = 0; i < 4; ++i) { float y4[4];
#pragma unroll
            for (int e = 0; e < 4; ++e) y4[e] = o[4 * i + e] * rs * wv[4 * i + e] * silu_f(gt[4 * i + e]) * FP8_ASC;
            pk[i] = (unsigned)pk4_fp8(y4[0], y4[1], y4[2], y4[3]); }
        *(u32x4*)(Y + (size_t)row * DM + 1024 + 16 * F.lane) = (u32x4){pk[0], pk[1], pk[2], pk[3]};
    }
}

DI void mixer0_phase(const Frame& F, const Args& a) {
    for (int pair = F.wg; pair < 128; pair += F.G) hgrn_pair(F, a, pair);
    const bf16_t* Z = (const bf16_t*)(a.ws + WS_Z); unsigned char* Y = a.ws + WS_ACT;
    unsigned* qctr = (unsigned*)(a.ws + WS_CTL) + CW_QUEUE;
    volatile LAS unsigned* qslot = (volatile LAS unsigned*)(F.lds + LDS_MISC + 64);
    if (F.tid == 0) *qslot = __hip_atomic_fetch_add(qctr, 1u, __ATOMIC_RELAXED, __HIP_MEMORY_SCOPE_AGENT);
    __syncthreads();
    int u = (int)*qslot;
    while (u < 1024 + 128) {
        unsigned nxt = 0u;
        if (F.tid == 0) nxt = __hip_atomic_fetch_add(qctr, 1u, __ATOMIC_RELAXED, __HIP_MEMORY_SCOPE_AGENT);
        AttnP p{};
        p.ldq = EV_IN; p.ldk1 = EV_IN; p.K2 = nullptr; p.ldk2 = 0; p.ldv = EV_IN; p.ldo = DM; p.nctx_tiles = 4; p.xtile0 = 0;
        p.sc_log2e = 0.08838834764831845f * 1.4426950408889634f; p.rpb = nullptr; p.qgrow0 = 0;
        int b, head;
        if (u < 1024) { const int qb = u & 7; head = (u >> 3) & 7; b = u >> 6; p.qrow0 = b * SEQ + 256 * qb; p.nx_tiles = 32; }
        else { const int v = u - 1024; head = v & 7; b = v >> 3; p.qrow0 = MXR + b * CTXL; p.nx_tiles = 0; }
        const int kvh = head >> 2;
        p.b = b; p.orow0 = p.qrow0;
        p.Q = Z + head * 128; p.K1 = Z + 1024 + kvh * 128; p.V = Z + 1280 + kvh * 128; p.O = Y + head * 128;
        const AttnQK8 e{a.ws + WS_Q8 + head * 128, 1024, a.ws + WS_K8 + kvh * 128, 256, nullptr, 0, a.ws + WS_V8G + kvh * 128, 256};
        attn_unit_f8<128, false>(F, p, e);
        if (F.tid == 0) *qslot = nxt;
        __syncthreads();
        u = (int)*qslot;
    }
}

DI void rope64(float& v, int lane, int t, float inv16) {
    const float pv = __shfl_xor(v, 16);
    const int pos = (lane < 32) ? (t >> 6) : (t & 63);
    const float ang = (float)pos * inv16;
    const float sn = __sinf(ang), cs = __cosf(ang);
    const float sg = ((lane & 16) == 0) ? -1.f : 1.f;
    v = v * cs + sg * pv * sn;
}
DI void mla_prep_phase(const Frame& F, const Args& a) {
    bf16_t* Z = (bf16_t*)(a.ws + WS_Z);
    const float inv16 = exp2f(-(float)(F.lane & 15) * (13.287712379549449f / 16.f));
    f32x4 wq0 = *(const f32x4*)(a.in[I_MQN] + 8 * F.lane), wq1 = *(const f32x4*)(a.in[I_MQN] + 8 * F.lane + 4);
    f32x4 wk0 = *(const f32x4*)(a.in[I_MKVN] + 8 * F.lane), wk1 = *(const f32x4*)(a.in[I_MKVN] + 8 * F.lane + 4);
    for (int row = F.gw; row < MT; row += F.ngw) {
        bf16_t* zr = Z + (size_t)row * OD_INP;
#pragma unroll
        for (int part = 0; part < 2; ++part) {
            bf16_t* p = zr + 3072 + part * 512 + 8 * F.lane;
            const u32x4 u = *(const u32x4*)p; const unsigned uu[4] = {u.x, u.y, u.z, u.w};
            float v[8]; float ss = 0.f;
#pragma unroll
            for (int i = 0; i < 4; ++i) { v[2 * i] = bflo(uu[i]); v[2 * i + 1] = bfhi(uu[i]); ss += v[2 * i] * v[2 * i] + v[2 * i + 1] * v[2 * i + 1]; }
            const float rs = __frsqrt_rn(wave_sum(ss) * (1.f / 512.f) + EPS);
            const f32x4 w0 = part ? wk0 : wq0, w1 = part ? wk1 : wq1;
            u32x2 o; o.x = (unsigned)pk4_fp8(v[0] * rs * w0[0] * FP8_ASC, v[1] * rs * w0[1] * FP8_ASC, v[2] * rs * w0[2] * FP8_ASC, v[3] * rs * w0[3] * FP8_ASC);
            o.y = (unsigned)pk4_fp8(v[4] * rs * w1[0] * FP8_ASC, v[5] * rs * w1[1] * FP8_ASC, v[6] * rs * w1[2] * FP8_ASC, v[7] * rs * w1[3] * FP8_ASC);
            *(u32x2*)(a.ws + WS_ACT + (size_t)part * MT * 512 + (size_t)row * 512 + 8 * F.lane) = o;
        }
        { float v = __uint_as_float((unsigned)zr[4096 + F.lane] << 16); if (row < MXR) rope64(v, F.lane, row & 2047, inv16);
          (a.ws + WS_K8R)[(size_t)row * 64 + F.lane] = (unsigned char)(pk4_fp8(v * QK8_SC, 0.f, 0.f, 0.f) & 0xff); }
    }
}
DI void mla_qrope_phase(const Frame& F, const Args& a) {
    bf16_t* Q = (bf16_t*)(a.ws + WS_QUP);
    const float inv16 = exp2f(-(float)(F.lane & 15) * (13.287712379549449f / 16.f));
    unsigned short nx[8];
    if (F.gw < MXR) {
#pragma unroll
        for (int h = 0; h < 8; ++h) nx[h] = Q[(size_t)F.gw * 1536 + h * 192 + 128 + F.lane]; }
    for (int row = F.gw; row < MXR; row += F.ngw) {
        bf16_t* qr = Q + (size_t)row * 1536;
        unsigned short cu[8];
#pragma unroll
        for (int h = 0; h < 8; ++h) cu[h] = nx[h];
        { const int nrow = (row + F.ngw < MXR) ? row + F.ngw : row;
#pragma unroll
          for (int h = 0; h < 8; ++h) nx[h] = Q[(size_t)nrow * 1536 + h * 192 + 128 + F.lane]; }
#pragma unroll
        for (int h = 0; h < 8; ++h) { float v = __uint_as_float((unsigned)cu[h] << 16); rope64(v, F.lane, row & 2047, inv16); qr[h * 192 + 128 + F.lane] = (bf16_t)(pk2(v, 0.f) & 0xffffu); }
    }
}

DI void mixer1_phase(const Frame& F, const Args& a) {
    const bf16_t* Z = (const bf16_t*)(a.ws + WS_Z); unsigned char* Y = a.ws + WS_ACT;
    const bf16_t* QUP = (const bf16_t*)(a.ws + WS_QUP); const bf16_t* KVUP = (const bf16_t*)(a.ws + WS_KVUP);
    unsigned* qctr = (unsigned*)(a.ws + WS_CTL) + CW_QUEUE2;
    volatile LAS unsigned* qslot = (volatile LAS unsigned*)(F.lds + LDS_MISC + 64);
    if (F.tid == 0) *qslot = __hip_atomic_fetch_add(qctr, 1u, __ATOMIC_RELAXED, __HIP_MEMORY_SCOPE_AGENT);
    __syncthreads();
    int u = (int)*qslot;
    while (u < 1024) {
        unsigned nxt = 0u;
        if (F.tid == 0) nxt = __hip_atomic_fetch_add(qctr, 1u, __ATOMIC_RELAXED, __HIP_MEMORY_SCOPE_AGENT);
        AttnP p{};
        const int qb = u & 7, head = (u >> 3) & 7, b = u >> 6;
        p.b = b; p.qrow0 = b * SEQ + 256 * qb; p.orow0 = p.qrow0; p.ldo = DM; p.nctx_tiles = 4;
        p.Q = QUP + head * 192; p.ldq = 1536; p.K1 = KVUP + head * 256; p.ldk1 = 2048; p.K2 = Z + 4096; p.ldk2 = OD_INP; p.V = KVUP + head * 256 + 128; p.ldv = 2048;
        p.O = Y + 1024 + head * 128; p.xtile0 = 0; p.nx_tiles = 32; p.sc_log2e = 0.07216878364870323f * 1.4426950408889634f; p.rpb = nullptr; p.qgrow0 = 0;
        const AttnQK8 e{nullptr, 0, a.ws + WS_K8N + head * 128, 1024, a.ws + WS_K8R, 64, a.ws + WS_V8M + head * 128, 1024};
        attn_unit_f8<192, true, false, true>(F, p, e);
        if (F.tid == 0) *qslot = nxt;
        __syncthreads();
        u = (int)*qslot;
    }
    while (u < 2048) {
        unsigned nxt = 0u;
        if (F.tid == 0) nxt = __hip_atomic_fetch_add(qctr, 1u, __ATOMIC_RELAXED, __HIP_MEMORY_SCOPE_AGENT);
        AttnP p{};
        const int v = u - 1024, qb = v & 7, head = (v >> 3) & 7, b = v >> 6;
        p.b = b; p.qrow0 = b * SEQ + 256 * qb; p.orow0 = p.qrow0; p.ldo = DM; p.nctx_tiles = 4;
        p.Q = Z + head * 128; p.ldq = OD_INP; p.K1 = Z + 1024 + head * 128; p.ldk1 = OD_INP; p.K2 = nullptr; p.ldk2 = 0; p.V = Z + 2048 + head * 128; p.ldv = OD_INP;
        p.O = Y + head * 128; p.sc_log2e = 0.08838834764831845f * 1.4426950408889634f; p.rpb = a.in[I_RPB] + head * 15 * 31; p.qgrow0 = 4 * qb;
        const int rlo = min(max(4 * qb - 4, 0), 24), rhi = min(max(4 * qb + 3 - 4, 0), 24) + 8;
        p.xtile0 = rlo; p.nx_tiles = rhi - rlo;
        const AttnQK8 e{nullptr, 0, a.ws + WS_K8NA + head * 128, 1024, nullptr, 0, a.ws + WS_V8NA + head * 128, 1024};
        attn_unit_f8<128, true, true>(F, p, e);
        if (F.tid == 0) *qslot = nxt;
        __syncthreads();
        u = (int)*qslot;
    }
}

#define CEX(a, b) do { const float _hi = fmaxf(a, b), _lo = fminf(a, b); a = _hi; b = _lo; } while (0)
DI void bitonic_merge16(float (&c)[16]) {
#pragma unroll
    for (int st = 8; st >= 1; st >>= 1)
#pragma unroll
        for (int i = 0; i < 16; ++i) if ((i & st) == 0) CEX(c[i], c[i + st]);
}
DI void sort16_desc(float (&a)[16]) {
#pragma unroll
    for (int k = 2; k <= 16; k <<= 1)
#pragma unroll
        for (int j = k >> 1; j >= 1; j >>= 1)
#pragma unroll
            for (int i = 0; i < 16; ++i) { const int l = i ^ j; if (l > i) { const bool desc = (i & k) == 0;
                const float hi = fmaxf(a[i], a[l]), lo = fminf(a[i], a[l]); a[i] = desc ? hi : lo; a[l] = desc ? lo : hi; } }
}
DI void insert16(float (&a)[16], float x) {
#pragma unroll
    for (int i = 0; i < 16; ++i) { const float hi = fmaxf(a[i], x); x = fminf(a[i], x); a[i] = hi; }
}
struct CandTab { int ci[50], cj[50];
    constexpr CandTab() : ci{}, cj{} { int n = 0; for (int i = 0; i < 16; ++i) for (int j = 0; j < 16; ++j) if ((i + 1) * (j + 1) <= 16) { ci[n] = i; cj[n] = j; ++n; } } };
DI void peer_topk_wave(const Frame& F, const bf16_t* PQ, const LAS unsigned char* keysL  , int tok0, int head, int* eidx, float* gate, LAS unsigned char* scr  ) {
    const int lane = F.lane, r = lane & 31, hh = lane >> 5;
    float top[2][16];
#pragma unroll
    for (int p = 0; p < 2; ++p) {
        f32x16 st[4];
#pragma unroll
        for (int kb = 0; kb < 4; ++kb) for (int i = 0; i < 16; ++i) st[kb][i] = 0.f;
        const bf16_t* qp = PQ + (size_t)(tok0 + r) * DM + head * 256 + p * 128 + 8 * hh;
        const LAS unsigned char* kp = keysL + p * (128 * 272) + r * 272 + 16 * hh;
#pragma unroll 2
        for (int ks = 0; ks < 8; ++ks) {
            const bf16x8 qf = *(const bf16x8*)(qp + 16 * ks);
#pragma unroll
            for (int kb = 0; kb < 4; ++kb) { const bf16x8 kf = *(const LAS bf16x8*)(kp + kb * (32 * 272) + 32 * ks);
                st[kb] = __builtin_amdgcn_mfma_f32_32x32x16_bf16(kf, qf, st[kb], 0, 0, 0); }
        }
        float blk[4][16];
#pragma unroll
        for (int kb = 0; kb < 4; ++kb) {
#pragma unroll
            for (int i = 0; i < 16; ++i) { const unsigned key = 32 * kb + (i & 3) + 8 * (i >> 2) + 4 * hh; blk[kb][i] = __uint_as_float((__float_as_uint(st[kb][i]) & 0xffffff80u) | key); }
            sort16_desc(blk[kb]);
        }
        float m01[16], m23[16], aa[16];
#pragma unroll
        for (int i = 0; i < 16; ++i) { m01[i] = fmaxf(blk[0][i], blk[1][15 - i]); m23[i] = fmaxf(blk[2][i], blk[3][15 - i]); }
        bitonic_merge16(m01); bitonic_merge16(m23);
#pragma unroll
        for (int i = 0; i < 16; ++i) aa[i] = fmaxf(m01[i], m23[15 - i]);
        bitonic_merge16(aa);
        float cc[16];
#pragma unroll
        for (int i = 0; i < 16; ++i) cc[i] = fmaxf(aa[i], __shfl_xor(aa[15 - i], 32));
        bitonic_merge16(cc);
#pragma unroll
        for (int i = 0; i < 16; ++i) top[p][i] = cc[i];
    }
    LAS unsigned char* my = scr + r * 32;
#pragma unroll
    for (int p = 0; p < 2; ++p)
#pragma unroll
        for (int q4 = 0; q4 < 4; ++q4) { unsigned wv = 0;
#pragma unroll
            for (int e = 0; e < 4; ++e) wv |= (__float_as_uint(top[p][4 * q4 + e]) & 0x7fu) << (8 * e);
            *(LAS unsigned*)(my + p * 16 + 4 * q4) = wv; }
    float va[16], vb[16];
#pragma unroll
    for (int i = 0; i < 16; ++i) { va[i] = __uint_as_float(__float_as_uint(top[0][i]) & 0xffffff80u); vb[i] = __uint_as_float(__float_as_uint(top[1][i]) & 0xffffff80u); }
    float cd[16];
#pragma unroll
    for (int i = 0; i < 16; ++i) cd[i] = -3.0e38f;
#pragma unroll
    for (int k = 0; k < 25; ++k) {
        constexpr CandTab T{};
        const int i0 = T.ci[2 * k], j0 = T.cj[2 * k], i1 = T.ci[2 * k + 1], j1 = T.cj[2 * k + 1];
        const float s0 = va[i0] + vb[j0], s1 = va[i1] + vb[j1];
        const float x0 = __uint_as_float((__float_as_uint(s0) & 0xffffff00u) | (unsigned)(i0 * 16 + j0));
        const float x1 = __uint_as_float((__float_as_uint(s1) & 0xffffff00u) | (unsigned)(i1 * 16 + j1));
        insert16(cd, hh ? x1 : x0);
    }
    float cc[16];
#pragma unroll
    for (int i = 0; i < 16; ++i) cc[i] = fmaxf(cd[i], __shfl_xor(cd[15 - i], 32));
    bitonic_merge16(cc);
    float sv[16]; float den = 0.f;
    const float mx = __uint_as_float(__float_as_uint(cc[0]) & 0xffffff00u);
#pragma unroll
    for (int i = 0; i < 16; ++i) { sv[i] = __expf(__uint_as_float(__float_as_uint(cc[i]) & 0xffffff00u) - mx); den += sv[i]; }
    const float iden = 1.f / den;
    asm volatile("s_waitcnt lgkmcnt(0)" ::: "memory");
    if (hh == 0) {
        int* ep = eidx + (size_t)(tok0 + r) * 128 + head * 16; float* gp = gate + (size_t)(tok0 + r) * 128 + head * 16;
#pragma unroll
        for (int q4 = 0; q4 < 4; ++q4) { int ev[4]; float gv[4];
#pragma unroll
            for (int e = 0; e < 4; ++e) { const unsigned code = __float_as_uint(cc[4 * q4 + e]) & 0xffu; const unsigned ia = my[code >> 4], ib = my[16 + (code & 15u)];
                ev[e] = (int)(ia * 128u + ib); gv[e] = sv[4 * q4 + e] * iden; }
            *(int4*)(ep + 4 * q4) = make_int4(ev[0], ev[1], ev[2], ev[3]); *(f32x4*)(gp + 4 * q4) = (f32x4){gv[0], gv[1], gv[2], gv[3]}; }
    }
}
DI void peer_topk_phase(const Frame& F, const Args& a, int layer, int ntok) {
    const bf16_t* PQ = (const bf16_t*)(a.ws + WS_PQ); const int head = F.wg & 7;
    const bf16_t* keys = (const bf16_t*)(a.ws + WS_KEYS) + ((size_t)layer * 8 + head) * 2 * 128 * 128;
    int* eidx = (int*)(a.ws + WS_EIDX); float* gate = (float*)(a.ws + WS_GATE);
    LAS unsigned char* keysL = F.lds; LAS unsigned char* scr = F.lds + 2 * 128 * 272 + F.wave * 2048;
    for (int c = F.tid; c < 2 * 128 * 16; c += 512) { const int row = c >> 4, ch = c & 15; *(LAS u32x4*)(keysL + row * 272 + 16 * ch) = *(const u32x4*)(keys + (size_t)row * 128 + 8 * ch); }
    __syncthreads();
    const int nblk = ntok / 256;
    for (int blk = F.wg >> 3; blk < nblk; blk += F.G >> 3) peer_topk_wave(F, PQ, keysL, 256 * blk + 32 * F.wave, head, eidx, gate, scr);
    __syncthreads();
}

typedef __bf16 bf16p __attribute__((ext_vector_type(2)));
DI float fp6_dot32(const u32x6 r, const unsigned (&xw)[16]) {
    const bf16x32v d = __builtin_amdgcn_cvt_scalef32_pk32_bf16_fp6(r, 1.0f);
    float d0 = 0.f, d1 = 0.f;
#pragma unroll
    for (int i = 0; i < 8; ++i) {
        const bf16p lo = {d[4 * i], d[4 * i + 1]}, hi = {d[4 * i + 2], d[4 * i + 3]};
        d0 = __builtin_amdgcn_fdot2_f32_bf16(lo, __builtin_bit_cast(bf16p, xw[2 * i]), d0, false);
        d1 = __builtin_amdgcn_fdot2_f32_bf16(hi, __builtin_bit_cast(bf16p, xw[2 * i + 1]), d1, false);
    }
    return d0 + d1;
}
DI void fp6_axpy32(const u32x6 r, float w, f32x2 (&acc)[16]) {
    const f32x32v d = __builtin_amdgcn_cvt_scalef32_pk32_f32_fp6(r, 1.0f);
    const f32x2 w2 = {w, w};
#pragma unroll
    for (int i = 0; i < 16; ++i) { const f32x2 v2 = {d[2 * i], d[2 * i + 1]}; acc[i] = __builtin_elementwise_fma(w2, v2, acc[i]); }
}
DI u32x6 ld_row24(const unsigned char* p) { const u32x4 a = *(const u32x4*)p; const u32x2 b = *(const u32x2*)(p + 16); return (u32x6){a.x, a.y, a.z, a.w, b.x, b.y}; }
template <bool FINAL>
DI void peer_gather_phase(const Frame& F, const Args& a, int layer, int ntok) {
    const bf16_t* Fa = (const bf16_t*)(a.ws + WS_ACT); const unsigned char* U = a.ws + WS_U; const unsigned char* V = a.ws + WS_V;
    const float* SU = (const float*)(a.ws + WS_SU); const float* SV = (const float*)(a.ws + WS_SV);
    const int* eidx = (const int*)(a.ws + WS_EIDX); const float* gate = (const float*)(a.ws + WS_GATE);
    bf16_t* H = (bf16_t*)(a.ws + WS_H); float* HP = (float*)(a.ws + WS_HP);
    const float* modx = (const float*)(a.ws + WS_MODX) + (size_t)layer * 16 * 12288; const float* modc = (const float*)(a.ws + WS_MODC) + (size_t)layer * 12288;
    const int lane = F.lane, g8 = lane >> 3, p8 = lane & 7;
    LAS float* hpL = (LAS float*)(F.lds + F.wave * 13824); LAS unsigned short* eiL = (LAS unsigned short*)(F.lds + F.wave * 13824 + 18 * 512);
#pragma unroll 1
    for (int s = 0; s < 8; ++s) {
        const unsigned char* Us = U + (size_t)s * 16384 * SLB; const unsigned lo8 = 24u * (unsigned)p8;
#pragma unroll 1
        for (int tok = F.gw, kt = 0; tok < ntok; tok += F.ngw, ++kt) {
            unsigned xw[16];
            { const bf16_t* xp = Fa + (size_t)tok * DM + 256 * s + 32 * p8;
              const u32x4 x0 = *(const u32x4*)xp, x1 = *(const u32x4*)(xp + 8), x2 = *(const u32x4*)(xp + 16), x3 = *(const u32x4*)(xp + 24);
              xw[0] = x0.x; xw[1] = x0.y; xw[2] = x0.z; xw[3] = x0.w; xw[4] = x1.x; xw[5] = x1.y; xw[6] = x1.z; xw[7] = x1.w;
              xw[8] = x2.x; xw[9] = x2.y; xw[10] = x2.z; xw[11] = x2.w; xw[12] = x3.x; xw[13] = x3.y; xw[14] = x3.z; xw[15] = x3.w; }
            if (s == 0) { const int tp = 8 * (lane & 7) + (lane >> 3);
                eiL[kt * 128 + tp] = (unsigned short)eidx[(size_t)tok * 128 + lane]; eiL[kt * 128 + 64 + tp] = (unsigned short)eidx[(size_t)tok * 128 + 64 + lane]; }
            float hs[2] = {0.f, 0.f};
#pragma unroll
            for (int half = 0; half < 2; ++half) {
                u32x6 ra[8];
                const u32x4 ew = *(const LAS u32x4*)(eiL + kt * 128 + 64 * half + 8 * g8);
#pragma unroll
                for (int i = 0; i < 8; ++i) { const unsigned e = (i & 1) ? (ew[i >> 1] >> 16) : (ew[i >> 1] & 0xffffu); ra[i] = ld_row24(Us + (e * (unsigned)SLB + lo8)); }
                float d8[8];
#pragma unroll
                for (int i = 0; i < 8; ++i) d8[i] = fp6_dot32(ra[i], xw);
                float b4[4], c2[2];
                { const bool bit = (lane & 4) != 0;
#pragma unroll
                  for (int k = 0; k < 4; ++k) { const float kp = bit ? d8[4 + k] : d8[k], snd = bit ? d8[k] : d8[4 + k]; b4[k] = kp + __shfl_xor(snd, 4); } }
                { const bool bit = (lane & 2) != 0;
#pragma unroll
                  for (int k = 0; k < 2; ++k) { const float kp = bit ? b4[2 + k] : b4[k], snd = bit ? b4[k] : b4[2 + k]; c2[k] = kp + __shfl_xor(snd, 2); } }
                { const bool bit = (lane & 1) != 0; const float kp = bit ? c2[1] : c2[0], snd = bit ? c2[0] : c2[1]; hs[half] = kp + __shfl_xor(snd, 1); }
            }
            LAS float* hp = hpL + kt * 128 + lane;
            if (s > 0) { hs[0] += hp[0]; hs[1] += hp[64]; }
            hp[0] = hs[0]; hp[64] = hs[1];
        }
    }
#pragma unroll 1
    for (int s = 0; s < 8; ++s) {
        const unsigned char* Vs = V + (size_t)s * 16384 * SLB; const unsigned lo8 = 24u * (unsigned)p8;
#pragma unroll 1
        for (int tok = F.gw, kt = 0; tok < ntok; tok += F.ngw, ++kt) {
            LAS float* hp = hpL + kt * 128;
            if (s == 0) { const int e0 = eiL[kt * 128 + lane], e1 = eiL[kt * 128 + 64 + lane]; const int pp = 8 * (lane & 7) + (lane >> 3);
                hp[lane] = gate[(size_t)tok * 128 + pp] * gelu_tanh(hp[lane] * SU[e0]) * SV[e0]; hp[64 + lane] = gate[(size_t)tok * 128 + 64 + pp] * gelu_tanh(hp[64 + lane] * SU[e1]) * SV[e1]; }
            f32x2 acc[16];
#pragma unroll
            for (int i = 0; i < 16; ++i) acc[i] = (f32x2){0.f, 0.f};
#pragma unroll
            for (int half = 0; half < 2; ++half) {
                u32x6 ra[8]; float wj[8];
                const u32x4 ew = *(const LAS u32x4*)(eiL + kt * 128 + 64 * half + 8 * g8);
                const f32x4 wa = *(const LAS f32x4*)(hp + 64 * half + 8 * g8), wb = *(const LAS f32x4*)(hp + 64 * half + 8 * g8 + 4);
#pragma unroll
                for (int i = 0; i < 8; ++i) { const unsigned e = (i & 1) ? (ew[i >> 1] >> 16) : (ew[i >> 1] & 0xffffu); wj[i] = (i < 4) ? wa[i & 3] : wb[i & 3]; ra[i] = ld_row24(Vs + (e * (unsigned)SLB + lo8)); }
#pragma unroll
                for (int i = 0; i < 8; ++i) fp6_axpy32(ra[i], wj[i], acc);
            }
            float b[16], c[8]; f32x4 r4;
            { const bool bit = (lane & 32) != 0;
#pragma unroll
              for (int k = 0; k < 16; ++k) { const float lo = acc[k >> 1][k & 1], hi = acc[8 + (k >> 1)][k & 1]; const float snd = bit ? lo : hi, kp = bit ? hi : lo; b[k] = kp + __shfl_xor(snd, 32); } }
            { const bool bit = (lane & 16) != 0;
#pragma unroll
              for (int k = 0; k < 8; ++k) { const float snd = bit ? b[k] : b[8 + k], kp = bit ? b[8 + k] : b[k]; c[k] = kp + __shfl_xor(snd, 16); } }
            { const bool bit = (lane & 8) != 0;
#pragma unroll
              for (int k = 0; k < 4; ++k) { const float snd = bit ? c[k] : c[4 + k], kp = bit ? c[4 + k] : c[k]; r4[k] = kp + __shfl_xor(snd, 8); } }
            const float* g5 = ((tok < MXR) ? (modx + (size_t)(tok >> 11) * 12288) : modc) + 5 * DM;
            const int col = 256 * s + 32 * p8 + 4 * g8;
            bf16_t* hrow = H + (size_t)tok * DM;
            const u32x2 hb = *(const u32x2*)(hrow + col); const f32x4 h4 = {bflo(hb.x), bfhi(hb.x), bflo(hb.y), bfhi(hb.y)}, gg = *(const f32x4*)(g5 + col);
            { const f32x4 y4 = h4 + gg * r4; u32x2 ob; ob.x = pk2(y4[0], y4[1]); ob.y = pk2(y4[2], y4[3]); *(u32x2*)(hrow + col) = ob; }
            if (!FINAL && s == 7) {
                asm volatile("s_waitcnt vmcnt(0)" ::: "memory");
                f32x4 v[8]; float ss = 0.f;
#pragma unroll
                for (int j = 0; j < 8; ++j) { const u32x2 hb2 = *(const u32x2*)(hrow + 4 * (lane + 64 * j)); v[j] = (f32x4){bflo(hb2.x), bfhi(hb2.x), bflo(hb2.y), bfhi(hb2.y)}; ss += v[j][0] * v[j][0] + v[j][1] * v[j][1] + v[j][2] * v[j][2] + v[j][3] * v[j][3]; }
                const float rs = __frsqrt_rn(wave_sum(ss) * (1.f / DM) + EPS);
                const float* nw = a.in[I_N1W] + (size_t)(layer + 1) * DM;
                const float* mod1 = (tok < MXR) ? ((const float*)(a.ws + WS_MODX) + ((size_t)(layer + 1) * 16 + (tok >> 11)) * 12288) : ((const float*)(a.ws + WS_MODC) + (size_t)(layer + 1) * 12288);
                bf16_t* ao = (bf16_t*)(a.ws + WS_ACT) + (size_t)tok * DM;
#pragma unroll
                for (int j = 0; j < 8; ++j) { const int cc = 4 * (lane + 64 * j); const f32x4 w4 = *(const f32x4*)(nw + cc), sh = *(const f32x4*)(mod1 + cc), sc4 = *(const f32x4*)(mod1 + DM + cc);
                    f32x4 y;
#pragma unroll
                    for (int e = 0; e < 4; ++e) y[e] = (v[j][e] * rs * w4[e]) * (1.f + sc4[e]) + sh[e];
                    *(int*)((unsigned char*)(a.ws + WS_A8) + (size_t)tok * DM + cc) = pk4_fp8(y[0] * FP8_ASC, y[1] * FP8_ASC, y[2] * FP8_ASC, y[3] * FP8_ASC); }
            }
            if (FINAL && s == 7) {
                asm volatile("s_waitcnt vmcnt(0)" ::: "memory");
                f32x4 v[8]; float ss = 0.f;
#pragma unroll
                for (int j = 0; j < 8; ++j) { const u32x2 hb2 = *(const u32x2*)(hrow + 4 * (lane + 64 * j)); v[j] = (f32x4){bflo(hb2.x), bfhi(hb2.x), bflo(hb2.y), bfhi(hb2.y)}; ss += v[j][0] * v[j][0] + v[j][1] * v[j][1] + v[j][2] * v[j][2] + v[j][3] * v[j][3]; }
                const float rs = __frsqrt_rn(wave_sum(ss) * (1.f / DM) + EPS);
                const float* fw = a.in[I_FNW]; float* op = a.out + (size_t)tok * DM;
#pragma unroll
                for (int j = 0; j < 8; ++j) { const int cc = 4 * (lane + 64 * j); const f32x4 w4 = *(const f32x4*)(fw + cc);
                    f32x4 ov = v[j] * rs * w4;
#if DBG_SANITIZE
                    for (int e = 0; e < 4; ++e) if (!(fabsf(ov[e]) < 1e30f)) ov[e] = 1.0e4f;
#endif
                    *(f32x4*)(op + cc) = ov; }
            }
        }
    }
}

__global__ void __launch_bounds__(512, 2) fwd_kernel(Args args) {
    extern __shared__ __attribute__((aligned(16))) unsigned char lds_raw[];
    Frame F;
    F.lds = (LAS unsigned char*)lds_raw;
    F.tid = threadIdx.x; F.lane = F.tid & 63; F.wave = __builtin_amdgcn_readfirstlane(F.tid >> 6);
    F.G = gridDim.x; F.wg = blockIdx.x; F.gw = F.wg * 8 + F.wave; F.ngw = F.G * 8;
    volatile LAS unsigned* MISC = (volatile LAS unsigned*)(F.lds + LDS_MISC);
    if (F.tid < 4) MISC[F.tid] = 0u;
    __syncthreads();
    unsigned char* ws = args.ws;
    const int lo = args.ph_lo, hi = args.ph_hi;
    XcdBarrier bar; bar.bar = (unsigned*)(ws + WS_CTL) + CW_BAR; bar.x = 0; bar.st = nullptr;
    if (hi - lo > 1) bar = xcd_barrier_post((unsigned*)(ws + WS_CTL) + CW_BAR, MISC);
#ifndef PH_MASK
#define PH_MASK 0xffffffffu
#endif
#define IN(k) ((((PH_MASK) >> (k)) & 1u) && lo <= (k) && (k) < hi)
#define SEAM(k) do { if (IN(k) && IN((k) + 1)) xcd_barrier(bar); } while (0)
    const float* modx = (const float*)(ws + WS_MODX); const float* modc = (const float*)(ws + WS_MODC);
    bf16_t* ACT = (bf16_t*)(ws + WS_ACT); bf16_t* H = (bf16_t*)(ws + WS_H); bf16_t* Z = (bf16_t*)(ws + WS_Z);

#define REP2(k) if (((DBG_REPMASK) >> (k)) & 1u)
#define P0_BODY  { prologue(F, args); }
#define P1_BODY  { norm_mod_phase<false, true>(F, args.in[I_X], args.in[I_CTX], args.in[I_N1W], modx, modc, 0, ACT, MT); }
#define P2_BODY  { pg8::Gemm g{ACT, (const bf16_t*)(ws + WS_WIN0), MT, EV_IN, DM / 2, DM / 2, DM / 2}; pg8::StaticOrder S; S.init(MT, EV_IN, F.G, F.wg); \
        pg8::EpiBf16 E{Z, EV_IN, 1.f / (FP8_WSC * FP8_ASC)}; pg8::gemm_phase<pg8::EpiBf16, true>(F.lds, g, S, E); }
#define P3_BODY  { gqa_prep_phase(F, args); }
#define P4_BODY  { mixer0_phase(F, args); }
#define P5_BODY  { hgrn_readout_phase(F, args); }
#define P6_BODY  { pg8::Gemm g{ACT, (const bf16_t*)(ws + WS_WOUT0), MT, DM, DM / 2, DM / 2, DM / 2}; pg8::StaticOrder S; S.init(MT, DM, F.G, F.wg); \
        pg8::EpiResid<false> E{H, args.in[I_X], args.in[I_CTX], modx + 2 * DM, modc + 2 * DM, 12288, 1.f / (FP8_WSC * FP8_ASC)}; pg8::gemm_phase<pg8::EpiResid<false>, true>(F.lds, g, S, E); }
#define P7_BODY  { norm_mod_phase<true>(F, H, H + (size_t)MXR * DM, args.in[I_N2W], modx, modc, 3, ACT, MT); }
#define P8_BODY  { pg8::Gemm g{ACT, (const bf16_t*)(ws + WS_WPQ), MT, DM, DM, DM, DM}; pg8::StaticOrder S; S.init(MT, DM, F.G, F.wg); \
        pg8::EpiBf16 E{(bf16_t*)(ws + WS_PQ), DM}; pg8::gemm_phase(F.lds, g, S, E); }
#define P9_BODY  { peer_topk_phase(F, args, 0, MT); }
#define P10_BODY { peer_gather_phase<false>(F, args, 0, MT); }
#define P11_BODY { }
#define P12_BODY { pg8::Gemm g{(const bf16_t*)(ws + WS_A8), (const bf16_t*)(ws + WS_WIN1), MT, OD_INP, DM / 2, DM / 2, DM / 2}; pg8::StaticOrder S; S.init(MT, OD_INP, F.G, F.wg); \
        pg8::EpiZ1 E{Z, OD_INP, 1.f / (FP8_WSC * FP8_ASC), ws + WS_K8NA, QK8_SC / (FP8_WSC * FP8_ASC), ws + WS_V8NA}; pg8::gemm_phase<pg8::EpiZ1, true>(F.lds, g, S, E); }
#define P13_BODY { mla_prep_phase(F, args); }
#define P14_BODY { \
        { pg8::Gemm g{ACT, (const bf16_t*)(ws + WS_WQUP), MXR, 1536, 256, 256, 256}; pg8::StaticOrder S; S.init(MXR, 1536, F.G, F.wg); \
          pg8::EpiBf16 E{(bf16_t*)(ws + WS_QUP), 1536, 1.f / (FP8_WSC2 * FP8_ASC)}; pg8::gemm_phase<pg8::EpiBf16, true>(F.lds, g, S, E); } \
        { pg8::Gemm g{(const bf16_t*)(ws + WS_ACT + (size_t)MT * 512), (const bf16_t*)(ws + WS_WKVUP), MT, 2048, 256, 256, 256}; pg8::StaticOrder S; S.init(MT, 2048, F.G, F.wg); \
          pg8::EpiKV8 E{ws + WS_V8M, 1.f / (FP8_WSC2 * FP8_ASC), ws + WS_K8N, QK8_SC / (FP8_WSC2 * FP8_ASC)}; pg8::gemm_phase<pg8::EpiKV8, true>(F.lds, g, S, E); } }
#define P15_BODY { }
#define P16_BODY { mixer1_phase(F, args); }
#define P17_BODY { pg8::Gemm g{ACT, (const bf16_t*)(ws + WS_WOUT1), MXR, DM, DM / 2, DM / 2, DM / 2}; pg8::StaticOrder S; S.init(MXR, DM, F.G, F.wg); \
        pg8::EpiResid<true> E{H, H, H, modx + (size_t)16 * 12288 + 2 * DM, modc + 12288 + 2 * DM, 12288, 1.f / (FP8_WSC * FP8_ASC)}; pg8::gemm_phase<pg8::EpiResid<true>, true>(F.lds, g, S, E); }
#define P18_BODY { norm_mod_phase<true>(F, H, H, args.in[I_N2W] + DM, modx + (size_t)16 * 12288, modc + 12288, 3, ACT, MXR); \
        cvt_fp6_rows(F, args.in[I_PU] + (size_t)16384 * 2048, ws + WS_U, (float*)(ws + WS_SU), 16384); \
        cvt_fp6_rows(F, args.in[I_PV] + (size_t)16384 * 2048, ws + WS_V, (float*)(ws + WS_SV), 16384); }
#define P19_BODY { pg8::Gemm g{ACT, (const bf16_t*)(ws + WS_WPQ) + (size_t)2048 * 2048, MXR, DM, DM, DM, DM}; pg8::StaticOrder S; S.init(MXR, DM, F.G, F.wg); \
        pg8::EpiBf16 E{(bf16_t*)(ws + WS_PQ), DM}; pg8::gemm_phase(F.lds, g, S, E); }
#define P20_BODY { peer_topk_phase(F, args, 1, MXR); }
#define P21_BODY { peer_gather_phase<true>(F, args, 1, MXR); }
#define PHASE(k, BODY) if (IN(k)) { BODY REP2(k) BODY }
    PHASE(0, P0_BODY) SEAM(0);
    PHASE(1, P1_BODY) SEAM(1);
    PHASE(2, P2_BODY) SEAM(2);
    PHASE(3, P3_BODY) SEAM(3);
    PHASE(4, P4_BODY) SEAM(4);
    PHASE(5, P5_BODY) SEAM(5);
    PHASE(6, P6_BODY) SEAM(6);
    PHASE(7, P7_BODY) SEAM(7);
    PHASE(8, P8_BODY) SEAM(8);
    PHASE(9, P9_BODY) SEAM(9);
    PHASE(10, P10_BODY)
    PHASE(11, P11_BODY) SEAM(11);
    PHASE(12, P12_BODY) SEAM(12);
    PHASE(13, P13_BODY) SEAM(13);
    PHASE(14, P14_BODY)
    PHASE(15, P15_BODY) SEAM(15);
    PHASE(16, P16_BODY) SEAM(16);
    PHASE(17, P17_BODY) SEAM(17);
    PHASE(18, P18_BODY) SEAM(18);
    PHASE(19, P19_BODY) SEAM(19);
    PHASE(20, P20_BODY) SEAM(20);
    PHASE(21, P21_BODY)
#undef IN
#undef SEAM
}

extern "C" void kernel_launch(void* const* d_in, const int* in_sizes, int n_in, void* d_out, int out_size, void* d_ws, size_t ws_size, hipStream_t stream) {
    static int grid = 0;
    if (grid == 0) {
        if (n_in != N_IN || ws_size < WS_END) { fprintf(stderr, "kernel_launch: unexpected n_in %d or ws_size %zu (< %zu)\n", n_in, ws_size, (size_t)WS_END); grid = -1; return; }
        int dev = 0, cus = 0, per_cu = 0;
        if (hipGetDevice(&dev) != hipSuccess || hipDeviceGetAttribute(&cus, hipDeviceAttributeMultiprocessorCount, dev) != hipSuccess) { grid = -1; return; }
        if (hipFuncSetAttribute((const void*)fwd_kernel, hipFuncAttributeMaxDynamicSharedMemorySize, LDS_BYTES) != hipSuccess) { fprintf(stderr, "kernel_launch: hipFuncSetAttribute failed\n"); grid = -1; return; }
        if (hipOccupancyMaxActiveBlocksPerMultiprocessor(&per_cu, (const void*)fwd_kernel, 512, LDS_BYTES) != hipSuccess || per_cu < 1) { fprintf(stderr, "kernel_launch: occupancy query says %d\n", per_cu); }
        (void)hipGetLastError();
        if (cus < 256) { fprintf(stderr, "kernel_launch: this build is laid out for 256 CUs (MI355X); found %d\n", cus); grid = -1; return; }
        grid = 256;
    }
    if (grid < 0) return;
    (void)hipMemsetAsync((char*)d_ws + WS_CTL, 0, CTL_ZERO_BYTES, stream);
    Args a{};
    for (int i = 0; i < N_IN; ++i) a.in[i] = (const float*)d_in[i];
    a.out = (float*)d_out; a.ws = (unsigned char*)d_ws;
#if MK_N_LAUNCHES == 1
    a.ph_lo = 0; a.ph_hi = NPHASE;
    hipLaunchKernelGGL(fwd_kernel, dim3(grid), dim3(512), LDS_BYTES, stream, a);
#else
    for (int ph = 0; ph < NPHASE; ++ph) { a.ph_lo = ph; a.ph_hi = ph + 1; hipLaunchKernelGGL(fwd_kernel, dim3(grid), dim3(512), LDS_BYTES, stream, a); }
#endif
}
```

```cpp
#include <hip/hip_runtime.h>
#include <cstdio>
#include <cstdint>

#define DBG_SANITIZE 0
#ifndef DBG_REPMASK
#define DBG_REPMASK 0u
#endif
#ifndef MK_N_LAUNCHES
#define MK_N_LAUNCHES 1
#endif

#define DI __device__ __forceinline__
#define LAS __attribute__((address_space(3)))
typedef unsigned short bf16_t;
typedef short bf16x8 __attribute__((ext_vector_type(8)));
typedef short s16x4 __attribute__((ext_vector_type(4)));
typedef float f32x4 __attribute__((ext_vector_type(4)));
typedef float f32x16 __attribute__((ext_vector_type(16)));
typedef unsigned u32x4 __attribute__((ext_vector_type(4)));
typedef unsigned u32x2 __attribute__((ext_vector_type(2)));

constexpr int DM = 2048, NBATCH = 16, SEQ = 2048, CTXL = 256;
constexpr int MXR = NBATCH * SEQ;
constexpr int MCR = NBATCH * CTXL;
constexpr int MT = MXR + MCR;
constexpr int EV_IN = 6656, OD_IN = 4160, OD_INP = 4352;
constexpr float EPS = 1e-6f;
constexpr int NPHASE = 22;

constexpr size_t MiB = 1u << 20;
constexpr size_t WS_CTL = 0, CTL_ZERO_BYTES = 1 * MiB;
constexpr size_t WS_MODX = 1 * MiB;
constexpr size_t WS_MODC = WS_MODX + (size_t)2 * 16 * 12288 * 4;
constexpr size_t WS_WIN0 = 4 * MiB;
constexpr size_t WS_WOUT0 = 30 * MiB;
constexpr size_t WS_WIN1 = 38 * MiB;
constexpr size_t WS_WOUT1 = 55 * MiB;
constexpr size_t WS_WQUP = 63 * MiB;
constexpr size_t WS_WKVUP = 65 * MiB;
constexpr size_t WS_WPQ = 67 * MiB;
constexpr size_t WS_KEYS = 83 * MiB;
constexpr size_t WS_U = 84 * MiB, WS_V = 148 * MiB;
constexpr size_t WS_SU = 3 * MiB, WS_SV = 3 * MiB + 65536;
constexpr size_t WS_QUP = 84 * MiB;
constexpr size_t WS_ACT = 212 * MiB;
constexpr size_t WS_H = 356 * MiB;
constexpr size_t WS_OF = 356 * MiB, WS_OB = 428 * MiB;
constexpr size_t WS_A8 = 500 * MiB;
constexpr size_t WS_Q8 = 500 * MiB, WS_K8 = 540 * MiB;
constexpr size_t WS_K8N = 500 * MiB, WS_K8R = 540 * MiB;
constexpr size_t WS_K8NA = 572 * MiB;
constexpr size_t WS_V8G = 552 * MiB, WS_V8NA = 608 * MiB, WS_V8M = 950 * MiB;
constexpr float QK8_SC = 16.f;
constexpr size_t WS_Z = 644 * MiB;
constexpr size_t WS_PQ = 644 * MiB;
constexpr size_t WS_EIDX = 788 * MiB, WS_GATE = 806 * MiB;
constexpr size_t WS_HP = 824 * MiB;
constexpr size_t WS_KVUP = 950 * MiB;
constexpr size_t WS_END = 1112 * MiB;
constexpr int CW_BAR = 4096;
constexpr int CW_QUEUE2 = 8192 + 64;
constexpr int CW_QUEUE = 8192;

constexpr int LDS_BYTES = 147456;
constexpr int LDS_MISC = 131072 + 1024;

typedef __bf16 bf16v2 __attribute__((ext_vector_type(2)));
typedef float f32x2 __attribute__((ext_vector_type(2)));
DI unsigned pk2(float lo, float hi) { const f32x2 v = {lo, hi}; return __builtin_bit_cast(unsigned, __builtin_convertvector(v, bf16v2)); }
DI float bflo(unsigned u) { return __uint_as_float(u << 16); }
DI float bfhi(unsigned u) { return __uint_as_float(u & 0xffff0000u); }
DI int pk4_fp8(float a, float b, float c, float d) { int p = __builtin_amdgcn_cvt_pk_fp8_f32(fminf(fmaxf(a, -448.f), 448.f), fminf(fmaxf(b, -448.f), 448.f), 0, false);
    return __builtin_amdgcn_cvt_pk_fp8_f32(fminf(fmaxf(c, -448.f), 448.f), fminf(fmaxf(d, -448.f), 448.f), p, true); }
DI float wave_sum(float v) {
#pragma unroll
    for (int o = 1; o < 64; o <<= 1) v += __shfl_xor(v, o);
    return v;
}
DI float silu_f(float x) { return x / (1.f + __expf(-x)); }
DI float gelu_tanh(float x) { const float u = 0.7978845608028654f * (x + 0.044715f * x * x * x); const float e = __expf(2.f * u); const float t = 1.f - 2.f / (e + 1.f); return 0.5f * x * (1.f + t); }

#define XB_TMO      128
#define XB_XCNT(j)  (256  + 64 * (j))
#define XB_XSUB(j)  (1280 + 64 * (j))
#define XB_XGEN(j)  (2304 + 64 * (j))
#define XB_TOP      3328
#define XB_TOPGEN   3392
#define XCD_BAR_WORDS 3456
#define XB_SPIN_CAP (1u << 20)
DI unsigned xb_ld(unsigned* p)              { return __hip_atomic_load(p, __ATOMIC_RELAXED, __HIP_MEMORY_SCOPE_AGENT); }
DI unsigned xb_add(unsigned* p, unsigned v) { return __hip_atomic_fetch_add(p, v, __ATOMIC_RELAXED, __HIP_MEMORY_SCOPE_AGENT); }
DI unsigned xb_xcc_id() { return (unsigned)__builtin_amdgcn_s_getreg((3 << 11) | 20) & 0xFu; }
#define XB_SPIN(cond, bar) do { unsigned _sp = 0; while (cond) { __builtin_amdgcn_s_sleep(1); \
    if ((++_sp & 255u) == 0u) { if (xb_ld(&(bar)[XB_TMO])) break; if (_sp > XB_SPIN_CAP) { atomicAdd(&(bar)[XB_TMO], 1u); break; } } } } while (0)
struct XcdBarrier { unsigned* bar; unsigned x; volatile LAS unsigned* st; };
DI XcdBarrier xcd_barrier_post(unsigned* bar, volatile LAS unsigned* st) {
    XcdBarrier b; b.bar = bar; b.x = xb_xcc_id(); b.st = st;
    if (threadIdx.x == 0) (void)xb_add(&bar[XB_XCNT(b.x)], 1u);
    return b;
}
DI void xcd_barrier_complete(unsigned* bar, unsigned x, unsigned& nloc, unsigned& nx) {
    const unsigned G = gridDim.x * gridDim.y * gridDim.z;
    unsigned sum, cnt, mine, sp = 0u;
    for (;;) {
        sum = 0u; cnt = 0u; mine = 0u;
#pragma unroll
        for (unsigned j = 0; j < 16; ++j) { const unsigned c = xb_ld(&bar[XB_XCNT(j)]); sum += c; cnt += (c > 0u) ? 1u : 0u; mine = (j == x) ? c : mine; }
        if (sum == G) break;
        __builtin_amdgcn_s_sleep(1);
        if ((++sp & 255u) == 0u) { if (xb_ld(&bar[XB_TMO])) break; if (sp > XB_SPIN_CAP) { atomicAdd(&bar[XB_TMO], 1u); break; } }
    }
    nloc = mine > 0u ? mine : 1u; nx = cnt > 0u ? cnt : 1u;
}
DI void xcd_barrier(const XcdBarrier& b) {
    asm volatile("s_waitcnt vmcnt(0)" ::: "memory");
    __syncthreads();
    if (threadIdx.x == 0) {
        unsigned* bar = b.bar;
        __builtin_amdgcn_s_waitcnt(0);
        unsigned nloc = b.st[0], nx = b.st[1];
        if (nloc == 0u) { xcd_barrier_complete(bar, b.x, nloc, nx); b.st[0] = nloc; b.st[1] = nx; }
        const unsigned old = xb_add(&bar[XB_XSUB(b.x)], 1u);
        const unsigned gen = old / nloc;
        if (old + 1u == (gen + 1u) * nloc) {
            __builtin_amdgcn_fence(__ATOMIC_RELEASE, "agent");
            asm volatile("s_waitcnt vmcnt(0)" ::: "memory");
            const unsigned og = xb_add(&bar[XB_TOP], 1u);
            const unsigned tg = og / nx;
            if (og + 1u == (tg + 1u) * nx) xb_add(&bar[XB_TOPGEN], 1u);
            else XB_SPIN(xb_ld(&bar[XB_TOPGEN]) == tg, bar);
            __builtin_amdgcn_fence(__ATOMIC_ACQUIRE, "agent");
            xb_add(&bar[XB_XGEN(b.x)], 1u);
            asm volatile("s_waitcnt vmcnt(0)" ::: "memory");
        } else {
            XB_SPIN(xb_ld(&bar[XB_XGEN(b.x)]) == gen, bar);
            __builtin_amdgcn_fence(__ATOMIC_ACQUIRE, "agent");
            asm volatile("s_waitcnt vmcnt(0)" ::: "memory");
        }
    }
    __syncthreads();
}

namespace pg8 {
constexpr int BM = 256, BK = 64, HALF = 128, HTB = HALF * BK * 2, STAGE_BYTES = 8 * HTB, NXCD = 8, WGM = 8;
__host__ __device__ __forceinline__ int lds_byte(int r, int c) { const int st = (r >> 4) * 2 + (c >> 5), rr = r & 15, cc = c & 31, ob = rr * 64 + cc * 2; return st * 1024 + (ob ^ (((ob >> 9) & 1) << 5)); }
__host__ __device__ __forceinline__ void stage_rc(int b, int& R, int& C) { const int st = b / 1024, sb = b % 1024, swz = sb ^ (((sb >> 9) & 1) << 5); R = (st >> 1) * 16 + swz / 64; C = (st & 1) * 32 + (swz % 64) / 2; }
__host__ __device__ __forceinline__ int perm32(int rho) { const int n = rho >> 4, i = rho & 15; return 8 * (i >> 2) + 4 * n + (i & 3); }
struct Unit { int pm, pn; };
struct Gemm { const bf16_t* A; const bf16_t* Bt; int M, N, K, lda, ldb; };
struct StaticOrder {
    int nM, nN, nwg, G, c;
    __device__ void init(int M, int N, int G_, int c_) { nM = M / BM; nN = N / BM; nwg = nM * nN; G = G_; c = c_; }
    __device__ bool next(int i, Unit& u) const {
        const long L = (long)i * G + c; if (L >= nwg) return false;
        int wgid = (int)L; { const int q = nwg / NXCD, r = nwg % NXCD, xcd = wgid % NXCD, off = wgid / NXCD; wgid = (xcd < r ? xcd * (q + 1) : r * (q + 1) + (xcd - r) * q) + off; }
        const int nig = WGM * nN, gid = wgid / nig, fm = gid * WGM, gsz = (nM - fm) < WGM ? (nM - fm) : WGM;
        u.pm = fm + ((wgid % nig) % gsz); u.pn = (wgid % nig) / gsz; return true;
    }
};
struct EpiBf16 {
    static constexpr bool PERM = true;
    bf16_t* O; int ldc; float osc = 1.f;
    DI void operator()(const f32x4 (&acc)[2][2][4][2], const Unit& u, int wr, int wc, int fr, int fq) const {
        const int row0 = u.pm * BM + wr * 64 + fr, col0 = u.pn * BM + wc * 32 + 8 * fq;
#pragma unroll
        for (int ai = 0; ai < 2; ++ai)
#pragma unroll
            for (int m = 0; m < 4; ++m) { bf16_t* rowp = O + (size_t)(row0 + ai * HALF + m * 16) * ldc + col0;
#pragma unroll
                for (int bj = 0; bj < 2; ++bj) { const f32x4 v0 = acc[ai][bj][m][0] * osc, v1 = acc[ai][bj][m][1] * osc;
                    u32x4 w; w.x = pk2(v0[0], v0[1]); w.y = pk2(v0[2], v0[3]); w.z = pk2(v1[0], v1[1]); w.w = pk2(v1[2], v1[3]);
                    *(u32x4*)(rowp + bj * HALF) = w; } }
    }
};
struct EpiKV8 {
    static constexpr bool PERM = true;
    unsigned char* V8; float osc; unsigned char* K8; float ksc;
    DI void operator()(const f32x4 (&acc)[2][2][4][2], const Unit& u, int wr, int wc, int fr, int fq) const {
        const int row0 = u.pm * BM + wr * 64 + fr, cin = wc * 32 + 8 * fq;
#pragma unroll
        for (int ai = 0; ai < 2; ++ai)
#pragma unroll
            for (int m = 0; m < 4; ++m) { const size_t row = (size_t)(row0 + ai * HALF + m * 16);
                { const f32x4 v0 = acc[ai][0][m][0] * ksc, v1 = acc[ai][0][m][1] * ksc;
                  u32x2 w; w.x = (unsigned)pk4_fp8(v0[0], v0[1], v0[2], v0[3]); w.y = (unsigned)pk4_fp8(v1[0], v1[1], v1[2], v1[3]);
                  *(u32x2*)(K8 + row * 1024 + u.pn * 128 + cin) = w; }
                { const f32x4 v0 = acc[ai][1][m][0] * osc, v1 = acc[ai][1][m][1] * osc;
                  u32x2 w; w.x = (unsigned)pk4_fp8(v0[0], v0[1], v0[2], v0[3]); w.y = (unsigned)pk4_fp8(v1[0], v1[1], v1[2], v1[3]);
                  *(u32x2*)(V8 + row * 1024 + u.pn * 128 + cin) = w; } }
    }
};
struct EpiZ1 {
    static constexpr bool PERM = true;
    bf16_t* O; int ldc; float osc; unsigned char* K8; float ksc; unsigned char* V8;
    DI void operator()(const f32x4 (&acc)[2][2][4][2], const Unit& u, int wr, int wc, int fr, int fq) const {
        const int row0 = u.pm * BM + wr * 64 + fr, cin = wc * 32 + 8 * fq;
        if (u.pn >= 4 && u.pn < 12) {
            const bool isk = u.pn < 8; const float fs = isk ? ksc : osc; unsigned char* dst8 = isk ? (K8 + (u.pn - 4) * BM) : (V8 + (u.pn - 8) * BM);
#pragma unroll
            for (int ai = 0; ai < 2; ++ai)
#pragma unroll
                for (int m = 0; m < 4; ++m) { unsigned char* rowp = dst8 + (size_t)(row0 + ai * HALF + m * 16) * 1024 + cin;
#pragma unroll
                    for (int bj = 0; bj < 2; ++bj) { const f32x4 v0 = acc[ai][bj][m][0] * fs, v1 = acc[ai][bj][m][1] * fs;
                        u32x2 w; w.x = (unsigned)pk4_fp8(v0[0], v0[1], v0[2], v0[3]); w.y = (unsigned)pk4_fp8(v1[0], v1[1], v1[2], v1[3]);
                        *(u32x2*)(rowp + bj * HALF) = w; } }
        } else {
#pragma unroll
            for (int ai = 0; ai < 2; ++ai)
#pragma unroll
                for (int m = 0; m < 4; ++m) { bf16_t* rowp = O + (size_t)(row0 + ai * HALF + m * 16) * ldc + u.pn * BM + cin;
#pragma unroll
                    for (int bj = 0; bj < 2; ++bj) { const f32x4 v0 = acc[ai][bj][m][0] * osc, v1 = acc[ai][bj][m][1] * osc;
                        u32x4 w; w.x = pk2(v0[0], v0[1]); w.y = pk2(v0[2], v0[3]); w.z = pk2(v1[0], v1[1]); w.w = pk2(v1[2], v1[3]);
                        *(u32x4*)(rowp + bj * HALF) = w; } }
        }
    }
};
template <bool RBF16>
struct EpiResid {
    static constexpr bool PERM = true;
    bf16_t* H; const void* Rx; const void* Rc; const float* gx; const float* gc; int gstride; float osc = 1.f;
    DI void operator()(const f32x4 (&acc)[2][2][4][2], const Unit& u, int wr, int wc, int fr, int fq) const {
        const int rowt = u.pm * BM;
        const char* R; const float* g;
        constexpr int RB = RBF16 ? 2 : 4;
        if (rowt < MXR) { R = (const char*)Rx + (size_t)rowt * DM * RB; g = gx + (size_t)(rowt >> 11) * gstride; } else { R = (const char*)Rc + (size_t)(rowt - MXR) * DM * RB; g = gc; }
        bf16_t* Ho = H + (size_t)rowt * DM;
        const int rl0 = wr * 64 + fr, col0 = u.pn * BM + wc * 32 + 8 * fq;
        f32x4 gv[2][2];
#pragma unroll
        for (int bj = 0; bj < 2; ++bj)
#pragma unroll
            for (int n = 0; n < 2; ++n) gv[bj][n] = *(const f32x4*)(g + col0 + bj * HALF + 4 * n) * osc;
#pragma unroll
        for (int ai = 0; ai < 2; ++ai)
#pragma unroll
            for (int m = 0; m < 4; ++m) { const size_t ro = (size_t)(rl0 + ai * HALF + m * 16) * DM + col0;
#pragma unroll
                for (int bj = 0; bj < 2; ++bj) { f32x4 r0, r1;
                    if (RBF16) { const u32x4 rr = *(const u32x4*)(R + (ro + bj * HALF) * 2); r0 = (f32x4){bflo(rr.x), bfhi(rr.x), bflo(rr.y), bfhi(rr.y)}; r1 = (f32x4){bflo(rr.z), bfhi(rr.z), bflo(rr.w), bfhi(rr.w)}; }
                    else { r0 = *(const f32x4*)(R + (ro + bj * HALF) * 4); r1 = *(const f32x4*)(R + (ro + bj * HALF + 4) * 4); }
                    const f32x4 v0 = r0 + gv[bj][0] * acc[ai][bj][m][0], v1 = r1 + gv[bj][1] * acc[ai][bj][m][1];
                    u32x4 w; w.x = pk2(v0[0], v0[1]); w.y = pk2(v0[2], v0[3]); w.z = pk2(v1[0], v1[1]); w.w = pk2(v1[2], v1[3]);
                    *(u32x4*)(Ho + ro + bj * HALF) = w; } }
    }
};

template <class Epi, bool FP8 = false>
DI void gemm_phase(LAS unsigned char* lds, const Gemm g, const StaticOrder& S, const Epi& E) {
    const int tid = threadIdx.x, wid = __builtin_amdgcn_readfirstlane(tid >> 6), lane = tid & 63, wr = wid >> 2, wc = wid & 3, fr = lane & 15, fq = lane >> 4;
    const int K = g.K, nt = K / BK;
    unsigned voffA[2], voffB[2];
#pragma unroll
    for (int i = 0; i < 2; ++i) { int R, C; stage_rc(tid * 16 + i * 8192, R, C); const int Rb = Epi::PERM ? ((R & ~31) + perm32(R & 31)) : R;
        voffA[i] = (unsigned)(R * g.lda + C) * 2u; voffB[i] = (unsigned)(Rb * g.ldb + C) * 2u; }
    const size_t kstep = (size_t)(BK * 2);
    const size_t hA = (size_t)HALF * g.lda * 2, hB = (size_t)HALF * g.ldb * 2;
    const size_t tA = 2 * hA, tB = 2 * hB;
    const unsigned ldsw = (unsigned)wid * 1024u;
    const int aoff = lds_byte(wr * 64 + fr, fq * 8), boff = lds_byte(wc * 32 + fr, fq * 8);
#define PG8_SA(b, h) (((b) * 2 + (h)) * HTB)
#define PG8_SB(b, h) ((4 + (b) * 2 + (h)) * HTB)
#define PG8_STAGE(bufoff, gbase, voff) do { _Pragma("unroll") for (int _i = 0; _i < 2; ++_i) \
        __builtin_amdgcn_global_load_lds((const unsigned*)((const char*)(gbase) + (voff)[_i]), (LAS unsigned*)(lds + (bufoff) + ldsw + _i * 8192), 16, 0, 0); } while (0)
#define PG8_LD8(p) __builtin_shufflevector(*(const LAS u32x4*)(p), *(const LAS u32x4*)((p) + 1024), 0, 1, 2, 3, 4, 5, 6, 7)
#define PG8_LDA(dst, b, h) do { if constexpr (FP8) { _Pragma("unroll") for (int m = 0; m < 4; ++m) dst##8[m] = PG8_LD8(lds + PG8_SA(b, h) + aoff + m * 2048); } \
        else { _Pragma("unroll") for (int m = 0; m < 4; ++m) _Pragma("unroll") for (int k = 0; k < 2; ++k) dst[m][k] = *(const LAS bf16x8*)(lds + PG8_SA(b, h) + aoff + m * 2048 + k * 1024); } } while (0)
#define PG8_LDB(dst, b, h) do { if constexpr (FP8) { _Pragma("unroll") for (int n = 0; n < 2; ++n) dst##8[n] = PG8_LD8(lds + PG8_SB(b, h) + boff + n * 2048); } \
        else { _Pragma("unroll") for (int n = 0; n < 2; ++n) _Pragma("unroll") for (int k = 0; k < 2; ++k) dst[n][k] = *(const LAS bf16x8*)(lds + PG8_SB(b, h) + boff + n * 2048 + k * 1024); } } while (0)
#define PG8_MMA(ai, bj, At, Bt) do { __builtin_amdgcn_s_setprio(1); \
        if constexpr (FP8) { _Pragma("unroll") for (int m = 0; m < 4; ++m) _Pragma("unroll") for (int n = 0; n < 2; ++n) \
            asm volatile("v_mfma_scale_f32_16x16x128_f8f6f4 %0, %1, %2, %0, %3, %3 op_sel_hi:[0,0,0]" : "+v"(acc[ai][bj][m][n]) : "v"(Bt##8[n]), "v"(At##8[m]), "v"(one_scale)); } \
        else { _Pragma("unroll") for (int m = 0; m < 4; ++m) _Pragma("unroll") for (int n = 0; n < 2; ++n) _Pragma("unroll") for (int k = 0; k < 2; ++k) \
            acc[ai][bj][m][n] = __builtin_amdgcn_mfma_f32_16x16x32_bf16(Bt[n][k], At[m][k], acc[ai][bj][m][n], 0, 0, 0); } \
        __builtin_amdgcn_s_setprio(0); } while (0)
#define PG8_WAIT_V(n) asm volatile("s_waitcnt vmcnt(" #n ")" ::: "memory")
#define PG8_WAIT_L(n) asm volatile("s_waitcnt lgkmcnt(" #n ")" ::: "memory")
#define PG8_BAR __builtin_amdgcn_s_barrier()
#define PG8_SCHED __builtin_amdgcn_sched_barrier(0)
    Unit cur, nxt; int ui = 0;
    if (!S.next(0, cur)) return;
    f32x4 acc[2][2][4][2];
#pragma unroll
    for (int a = 0; a < 2; ++a)
#pragma unroll
        for (int b = 0; b < 2; ++b)
#pragma unroll
            for (int m = 0; m < 4; ++m)
#pragma unroll
                for (int n = 0; n < 2; ++n) acc[a][b][m][n] = (f32x4){0.f, 0.f, 0.f, 0.f};
    bf16x8 At[4][2], B0[2][2], B1[2][2];
    typedef unsigned u32x8 __attribute__((ext_vector_type(8))); typedef int i32x8 __attribute__((ext_vector_type(8)));
    u32x8 At8[4], B08[2], B18[2];
    const unsigned one_scale = 0x7f7f7f7fu;
    const char* cA = (const char*)g.A + (size_t)cur.pm * tA; const char* cB = (const char*)g.Bt + (size_t)cur.pn * tB;
    PG8_STAGE(PG8_SB(0, 0), cB, voffB); PG8_STAGE(PG8_SA(0, 0), cA, voffA); PG8_STAGE(PG8_SB(0, 1), cB + hB, voffB); PG8_STAGE(PG8_SA(0, 1), cA + hA, voffA);
    if (wr == 1) PG8_BAR;
    PG8_WAIT_V(4); PG8_BAR;
    PG8_STAGE(PG8_SB(1, 0), cB + kstep, voffB); PG8_STAGE(PG8_SA(1, 0), cA + kstep, voffA); PG8_STAGE(PG8_SB(1, 1), cB + hB + kstep, voffB);
    PG8_WAIT_V(6); PG8_BAR;
    for (;;) {
        const bool has_next = S.next(ui + 1, nxt);
        const char* nA = has_next ? (const char*)g.A + (size_t)nxt.pm * tA : cA; const char* nB = has_next ? (const char*)g.Bt + (size_t)nxt.pn * tB : cB;
        for (int t = 0; t < nt; t += 2) {
            const bool last = (t == nt - 2);
            const char* a1 = cA + (size_t)(t + 1) * kstep;
            const char* a2 = last ? nA : cA + (size_t)(t + 2) * kstep; const char* b2 = last ? nB : cB + (size_t)(t + 2) * kstep;
            const char* a3 = a2 + kstep; const char* b3 = b2 + kstep;
            PG8_LDB(B0, 0, 0); PG8_SCHED; PG8_LDA(At, 0, 0); PG8_STAGE(PG8_SA(1, 1), a1 + hA, voffA);
            PG8_WAIT_L(8); PG8_BAR; PG8_WAIT_L(0); PG8_MMA(0, 0, At, B0); PG8_BAR; PG8_SCHED;
            PG8_LDB(B1, 0, 1); PG8_STAGE(PG8_SB(0, 0), b2, voffB);
            PG8_BAR; PG8_WAIT_L(0); PG8_MMA(0, 1, At, B1); PG8_BAR;
            PG8_LDA(At, 0, 1); PG8_STAGE(PG8_SA(0, 0), a2, voffA);
            PG8_BAR; PG8_WAIT_L(0); PG8_MMA(1, 0, At, B0); PG8_BAR; PG8_SCHED;
            PG8_STAGE(PG8_SB(0, 1), b2 + hB, voffB);
            PG8_WAIT_V(6); PG8_BAR; PG8_MMA(1, 1, At, B1); PG8_BAR;
            PG8_LDB(B0, 1, 0); PG8_SCHED; PG8_LDA(At, 1, 0); PG8_STAGE(PG8_SA(0, 1), a2 + hA, voffA);
            PG8_WAIT_L(8); PG8_BAR; PG8_WAIT_L(0); PG8_MMA(0, 0, At, B0); PG8_BAR; PG8_SCHED;
            PG8_LDB(B1, 1, 1); PG8_STAGE(PG8_SB(1, 0), b3, voffB);
            PG8_BAR; PG8_WAIT_L(0); PG8_MMA(0, 1, At, B1); PG8_BAR;
            PG8_LDA(At, 1, 1); PG8_STAGE(PG8_SA(1, 0), a3, voffA);
            PG8_BAR; PG8_WAIT_L(0); PG8_MMA(1, 0, At, B0); PG8_BAR; PG8_SCHED;
            PG8_STAGE(PG8_SB(1, 1), b3 + hB, voffB);
            PG8_WAIT_V(6); PG8_BAR; PG8_MMA(1, 1, At, B1); PG8_BAR;
        }
        E(acc, cur, wr, wc, fr, fq);
        if (!has_next) break;
#pragma unroll
        for (int a = 0; a < 2; ++a)
#pragma unroll
            for (int b = 0; b < 2; ++b)
#pragma unroll
                for (int m = 0; m < 4; ++m)
#pragma unroll
                    for (int n = 0; n < 2; ++n) acc[a][b][m][n] = (f32x4){0.f, 0.f, 0.f, 0.f};
        cur = nxt; cA = nA; cB = nB; ++ui;
    }
    PG8_WAIT_V(0);
    if (wr == 0) PG8_BAR;
    PG8_BAR;
#undef PG8_SA
#undef PG8_SB
#undef PG8_STAGE
#undef PG8_LDA
#undef PG8_LDB
#undef PG8_MMA
#undef PG8_LD8
#undef PG8_WAIT_V
#undef PG8_WAIT_L
#undef PG8_BAR
#undef PG8_SCHED
}
}

enum { I_X = 0, I_C, I_CTX, I_CCTX, I_WMOD, I_BMOD, I_N1W, I_N2W, I_EVIN, I_EVOUT, I_GQN, I_GKN, I_HLB, I_HON, I_ODIN, I_ODOUT, I_RPB,
       I_MQN, I_MQUP, I_MKVN, I_MKVUP, I_PWQ, I_PKEYS, I_PU, I_PV, I_FNW, N_IN };
struct Args { const float* in[N_IN]; float* out; unsigned char* ws; int ph_lo, ph_hi; };
struct Frame {
    LAS unsigned char* lds;
    int tid, lane, wave, gw, ngw, G, wg;
};

constexpr float FP8_WSC = 2048.f, FP8_WSC2 = 1024.f, FP8_ASC = 16.f;
DI void transpose_item_fp8(const float* W, int K, int N, unsigned char* WT, LAS float* scr, int item, int lane, float wsc = FP8_WSC) {
    const int nblk = N / 32, kb = item / nblk, nb = item % nblk, k0 = 64 * kb, n0 = 32 * nb;
#pragma unroll 8
    for (int i = 0; i < 32; ++i) { const int kk = 2 * i + (lane >> 5); scr[kk * 33 + (lane & 31)] = W[(size_t)(k0 + kk) * N + n0 + (lane & 31)] * wsc; }
    asm volatile("s_waitcnt lgkmcnt(0)" ::: "memory");
    const int c = lane & 7;
#pragma unroll
    for (int j = 0; j < 4; ++j) { const int n = (lane >> 3) + 8 * j; const LAS float* sp = scr + (8 * c) * 33 + n;
        u32x2 o; o.x = (unsigned)pk4_fp8(sp[0 * 33], sp[1 * 33], sp[2 * 33], sp[3 * 33]); o.y = (unsigned)pk4_fp8(sp[4 * 33], sp[5 * 33], sp[6 * 33], sp[7 * 33]);
        *(u32x2*)(WT + (size_t)(n0 + n) * K + k0 + 8 * c) = o; }
    asm volatile("s_waitcnt lgkmcnt(0)" ::: "memory");
}
DI void transpose_item(const float* W, int K, int N, bf16_t* WT, LAS float* scr, int item, int lane) {
    const int nblk = N / 32, kb = item / nblk, nb = item % nblk, k0 = 64 * kb, n0 = 32 * nb;
#pragma unroll 8
    for (int i = 0; i < 32; ++i) { const int kk = 2 * i + (lane >> 5); scr[kk * 33 + (lane & 31)] = W[(size_t)(k0 + kk) * N + n0 + (lane & 31)]; }
    asm volatile("s_waitcnt lgkmcnt(0)" ::: "memory");
    const int c = lane & 7;
#pragma unroll
    for (int j = 0; j < 4; ++j) { const int n = (lane >> 3) + 8 * j; const LAS float* s = scr + (8 * c) * 33 + n;
        u32x4 o; o.x = pk2(s[0 * 33], s[1 * 33]); o.y = pk2(s[2 * 33], s[3 * 33]); o.z = pk2(s[4 * 33], s[5 * 33]); o.w = pk2(s[6 * 33], s[7 * 33]);
        *(u32x4*)(WT + (size_t)(n0 + n) * K + k0 + 8 * c) = o; }
    asm volatile("s_waitcnt lgkmcnt(0)" ::: "memory");
}
DI void cvt_bf16_stream(const Frame& F, const float* src, bf16_t* dst, size_t n) {
    const size_t nth = (size_t)F.G * 512, t0 = (size_t)F.wg * 512 + F.tid;
    for (size_t i = t0; i < n / 8; i += nth) {
        const f32x4 a = *(const f32x4*)(src + i * 8), b = *(const f32x4*)(src + i * 8 + 4);
        u32x4 o; o.x = pk2(a[0], a[1]); o.y = pk2(a[2], a[3]); o.z = pk2(b[0], b[1]); o.w = pk2(b[2], b[3]);
        *(u32x4*)(dst + i * 8) = o;
    }
}
typedef float f32x16v __attribute__((ext_vector_type(16)));
typedef float f32x32v __attribute__((ext_vector_type(32)));
typedef __bf16 bf16x32v __attribute__((ext_vector_type(32)));
typedef unsigned u32x6 __attribute__((ext_vector_type(6)));
constexpr int ROWB = 1536, SLB = 192;
DI void cvt_fp6_rows(const Frame& F, const float* src, unsigned char* dst, float* inv_scale, int nrows) {
    LAS float* stage = (LAS float*)(F.lds + F.wave * 8192);
    for (int row = F.gw; row < nrows; row += F.ngw) {
        const float* sp = src + (size_t)row * DM;
        f32x4 v[8]; float mx = 0.f;
#pragma unroll
        for (int j = 0; j < 8; ++j) { v[j] = *(const f32x4*)(sp + 4 * (F.lane + 64 * j));
            mx = fmaxf(mx, fmaxf(fmaxf(fabsf(v[j][0]), fabsf(v[j][1])), fmaxf(fabsf(v[j][2]), fabsf(v[j][3])))); }
#pragma unroll
        for (int o = 1; o < 64; o <<= 1) mx = fmaxf(mx, __shfl_xor(mx, o));
        mx = fmaxf(mx, 1e-30f);
        const float sc = exp2f(floorf(log2f(7.0f / mx)));
#pragma unroll
        for (int j = 0; j < 8; ++j) *(LAS f32x4*)(stage + 4 * (F.lane + 64 * j)) = v[j] * sc;
        asm volatile("s_waitcnt lgkmcnt(0)" ::: "memory");
        f32x16v a, b;
#pragma unroll
        for (int j = 0; j < 8; ++j) { const f32x4 t0 = *(const LAS f32x4*)(stage + 32 * F.lane + 4 * j);
            a[2 * j] = t0[0]; b[2 * j] = t0[1]; a[2 * j + 1] = t0[2]; b[2 * j + 1] = t0[3]; }
        const u32x6 p = __builtin_amdgcn_cvt_scalef32_2xpk16_fp6_f32(a, b, 1.0f);
        unsigned char* dp = dst + ((size_t)(F.lane >> 3) * 16384 + row) * SLB + 24 * (F.lane & 7);
        *(u32x2*)dp = (u32x2){p[0], p[1]}; *(u32x2*)(dp + 8) = (u32x2){p[2], p[3]}; *(u32x2*)(dp + 16) = (u32x2){p[4], p[5]};
        if (F.lane == 0) inv_scale[row] = 1.f / sc;
        asm volatile("s_waitcnt lgkmcnt(0)" ::: "memory");
    }
}
DI void mod_gemv(const Frame& F, const Args& a) {
    const float* c = a.in[I_C]; const float* cctx = a.in[I_CCTX]; const float* wmod = a.in[I_WMOD]; const float* bmod = a.in[I_BMOD];
    float* modx = (float*)(a.ws + WS_MODX); float* modc = (float*)(a.ws + WS_MODC);
    LAS float* red = (LAS float*)F.lds;
    const int r = F.lane & 31, hh = F.lane >> 5;
    for (int blk = F.wg; blk < 768; blk += F.G) {
        const int l = blk / 384, j0 = (blk % 384) * 32;
        const float* W = wmod + (size_t)l * DM * 12288 + j0;
        f32x16 acc; for (int i = 0; i < 16; ++i) acc[i] = 0.f;
        const int kbeg = F.wave * 256;
        for (int ks = 0; ks < 16; ++ks) {
            const int k0 = kbeg + ks * 16 + 8 * hh;
            float av[8];
            if (r < 17) { const float* src = (r < 16) ? c + (size_t)r * DM + k0 : cctx + k0;
                const f32x4 x0 = *(const f32x4*)src, x1 = *(const f32x4*)(src + 4);
                av[0] = silu_f(x0[0]); av[1] = silu_f(x0[1]); av[2] = silu_f(x0[2]); av[3] = silu_f(x0[3]);
                av[4] = silu_f(x1[0]); av[5] = silu_f(x1[1]); av[6] = silu_f(x1[2]); av[7] = silu_f(x1[3]);
            } else { for (int i = 0; i < 8; ++i) av[i] = 0.f; }
            u32x4 ap; ap.x = pk2(av[0], av[1]); ap.y = pk2(av[2], av[3]); ap.z = pk2(av[4], av[5]); ap.w = pk2(av[6], av[7]);
            float bv[8];
#pragma unroll
            for (int i = 0; i < 8; ++i) bv[i] = W[(size_t)(k0 + i) * 12288 + r];
            u32x4 bp; bp.x = pk2(bv[0], bv[1]); bp.y = pk2(bv[2], bv[3]); bp.z = pk2(bv[4], bv[5]); bp.w = pk2(bv[6], bv[7]);
            acc = __builtin_amdgcn_mfma_f32_32x32x16_bf16(__builtin_bit_cast(bf16x8, ap), __builtin_bit_cast(bf16x8, bp), acc, 0, 0, 0);
        }
        __syncthreads();
#pragma unroll
        for (int i = 0; i < 16; ++i) { const int row = (i & 3) + 8 * (i >> 2) + 4 * hh; red[(F.wave * 32 + row) * 32 + r] = acc[i]; }
        __syncthreads();
        for (int o = F.tid; o < 17 * 32; o += 512) { const int row = o >> 5, col = o & 31; float s = 0.f;
#pragma unroll
            for (int w = 0; w < 8; ++w) s += red[(w * 32 + row) * 32 + col];
            s += bmod[(size_t)l * 12288 + j0 + col];
            if (row < 16) modx[((size_t)l * 16 + row) * 12288 + j0 + col] = s; else modc[(size_t)l * 12288 + j0 + col] = s; }
    }
    __syncthreads();
}
DI void prologue(const Frame& F, const Args& a) {
    LAS float* scr = (LAS float*)(F.lds + 32768 + F.wave * 8704);
    unsigned char* ws = a.ws;
    constexpr int I0 = 32 * 208, I1 = 32 * 64, I2 = 32 * 130, I3 = 32 * 64, I4 = 8 * 48, I5 = 8 * 64, I6 = 32 * 64, I7 = 32 * 64;
    constexpr int NIT = I0 + I1 + I2 + I3 + I4 + I5 + I6 + I7;
    for (int it = F.gw; it < NIT; it += F.ngw) {
        int r = it;
        if (r < I0) { transpose_item_fp8(a.in[I_EVIN], 2048, 6656, ws + WS_WIN0, scr, r, F.lane); continue; } r -= I0;
        if (r < I1) { transpose_item_fp8(a.in[I_EVOUT], 2048, 2048, ws + WS_WOUT0, scr, r, F.lane); continue; } r -= I1;
        if (r < I2) { transpose_item_fp8(a.in[I_ODIN], 2048, 4160, ws + WS_WIN1, scr, r, F.lane); continue; } r -= I2;
        if (r < I3) { transpose_item_fp8(a.in[I_ODOUT], 2048, 2048, ws + WS_WOUT1, scr, r, F.lane); continue; } r -= I3;
        if (r < I4) { transpose_item_fp8(a.in[I_MQUP], 512, 1536, ws + WS_WQUP, scr, r, F.lane, FP8_WSC2); continue; } r -= I4;
        if (r < I5) { transpose_item_fp8(a.in[I_MKVUP], 512, 2048, ws + WS_WKVUP, scr, r, F.lane, FP8_WSC2); continue; } r -= I5;
        if (r < I6) { transpose_item(a.in[I_PWQ], 2048, 2048, (bf16_t*)(ws + WS_WPQ), scr, r, F.lane); continue; } r -= I6;
        transpose_item(a.in[I_PWQ] + (size_t)2048 * 2048, 2048, 2048, (bf16_t*)(ws + WS_WPQ) + (size_t)2048 * 2048, scr, r, F.lane);
    }
    { u32x4* z = (u32x4*)(ws + WS_WIN1 + (size_t)4160 * 2048); const size_t n16 = (size_t)192 * 2048 / 16;
      for (size_t i = (size_t)F.wg * 512 + F.tid; i < n16; i += (size_t)F.G * 512) z[i] = (u32x4){0u, 0u, 0u, 0u}; }
    cvt_bf16_stream(F, a.in[I_PKEYS], (bf16_t*)(ws + WS_KEYS), (size_t)2 * 8 * 2 * 128 * 128);
    __syncthreads();
    cvt_fp6_rows(F, a.in[I_PU], ws + WS_U, (float*)(ws + WS_SU), 16384);
    cvt_fp6_rows(F, a.in[I_PV], ws + WS_V, (float*)(ws + WS_SV), 16384);
    mod_gemv(F, a);
}

template <bool SRC_BF16, bool DST_FP8>
DI void norm_mod_row(const Frame& F, const char* src, const f32x4 (&w)[8], const f32x4 (&sh)[8], const f32x4 (&sc)[8], bf16_t* dst, size_t row) {
    f32x4 v[8]; float ss = 0.f;
#pragma unroll
    for (int j = 0; j < 4; ++j) { const int c = 8 * (F.lane + 64 * j);
        if (SRC_BF16) { const u32x4 rr = *(const u32x4*)(src + (size_t)c * 2); v[2 * j] = (f32x4){bflo(rr.x), bfhi(rr.x), bflo(rr.y), bfhi(rr.y)}; v[2 * j + 1] = (f32x4){bflo(rr.z), bfhi(rr.z), bflo(rr.w), bfhi(rr.w)}; }
        else { v[2 * j] = *(const f32x4*)(src + (size_t)c * 4); v[2 * j + 1] = *(const f32x4*)(src + (size_t)c * 4 + 16); }
#pragma unroll
        for (int q = 0; q < 2; ++q) ss += v[2 * j + q][0] * v[2 * j + q][0] + v[2 * j + q][1] * v[2 * j + q][1] + v[2 * j + q][2] * v[2 * j + q][2] + v[2 * j + q][3] * v[2 * j + q][3]; }
    const float rstd = __frsqrt_rn(wave_sum(ss) * (1.f / DM) + EPS);
    bf16_t* o = dst + row * DM;
#pragma unroll
    for (int j = 0; j < 4; ++j) { const int c = 8 * (F.lane + 64 * j); unsigned pk[4];
#pragma unroll
        for (int q = 0; q < 2; ++q) { f32x4 y;
#pragma unroll
            for (int e = 0; e < 4; ++e) y[e] = (v[2 * j + q][e] * rstd * w[2 * j + q][e]) * (1.f + sc[2 * j + q][e]) + sh[2 * j + q][e];
            if (DST_FP8) pk[q] = (unsigned)pk4_fp8(y[0] * FP8_ASC, y[1] * FP8_ASC, y[2] * FP8_ASC, y[3] * FP8_ASC);
            else { pk[2 * q] = pk2(y[0], y[1]); pk[2 * q + 1] = pk2(y[2], y[3]); } }
        if (DST_FP8) *(u32x2*)((unsigned char*)dst + row * DM + c) = (u32x2){pk[0], pk[1]};
        else *(u32x4*)(o + c) = (u32x4){pk[0], pk[1], pk[2], pk[3]}; }
}
template <bool SRC_BF16, bool DST_FP8 = false>
DI void norm_mod_phase(const Frame& F, const void* srcX, const void* srcC, const float* nw, const float* modx_l, const float* modc_l, int sidx, bf16_t* dst, int nrows) {
    constexpr int SB = SRC_BF16 ? 2 : 4;
    f32x4 w[8], sh[8], sc[8];
#pragma unroll
    for (int j = 0; j < 4; ++j) { const int c = 8 * (F.lane + 64 * j); w[2 * j] = *(const f32x4*)(nw + c); w[2 * j + 1] = *(const f32x4*)(nw + c + 4); }
    for (int blk = F.gw; blk < MXR / 16; blk += F.ngw) {
        const int row0 = 16 * blk; const float* shift = modx_l + (size_t)(row0 >> 11) * 12288 + sidx * DM; const float* scale = shift + DM;
#pragma unroll
        for (int j = 0; j < 4; ++j) { const int c = 8 * (F.lane + 64 * j); sh[2 * j] = *(const f32x4*)(shift + c); sh[2 * j + 1] = *(const f32x4*)(shift + c + 4); sc[2 * j] = *(const f32x4*)(scale + c); sc[2 * j + 1] = *(const f32x4*)(scale + c + 4); }
#pragma unroll 1
        for (int i = 0; i < 16; ++i) norm_mod_row<SRC_BF16, DST_FP8>(F, (const char*)srcX + (size_t)(row0 + i) * DM * SB, w, sh, sc, dst, (size_t)(row0 + i));
    }
    if (nrows > MXR) {
        const float* shift = modc_l + sidx * DM; const float* scale = shift + DM;
#pragma unroll
        for (int j = 0; j < 4; ++j) { const int c = 8 * (F.lane + 64 * j); sh[2 * j] = *(const f32x4*)(shift + c); sh[2 * j + 1] = *(const f32x4*)(shift + c + 4); sc[2 * j] = *(const f32x4*)(scale + c); sc[2 * j + 1] = *(const f32x4*)(scale + c + 4); }
        for (int row = MXR + F.gw; row < nrows; row += F.ngw) norm_mod_row<SRC_BF16, DST_FP8>(F, (const char*)srcC + (size_t)(row - MXR) * DM * SB, w, sh, sc, dst, (size_t)row);
    }
}

DI void rope_pair(float& a, float& bsub, int lane, int posA, int posB, float inv) {
    const float pa = __shfl_xor(a, 32), pb = __shfl_xor(bsub, 32);
    const float angA = (float)posA * inv, angB = (float)posB * inv;
    const float sA = __sinf(angA), cA = __cosf(angA), sB = __sinf(angB), cB = __cosf(angB);
    const float sg = (lane < 32) ? -1.f : 1.f;
    a = a * cA + sg * pa * sA; bsub = bsub * cB + sg * pb * sB;
}
DI void gqa_prep_phase(const Frame& F, const Args& a) {
    const bf16_t* Z = (const bf16_t*)(a.ws + WS_Z);
    const float* qn = a.in[I_GQN]; const float* kn = a.in[I_GKN];
    const float inv = exp2f(-(float)(F.lane & 31) * (13.287712379549449f / 32.f));
    const float wq0 = qn[F.lane], wq1 = qn[64 + F.lane], wk0 = kn[F.lane], wk1 = kn[64 + F.lane];
    LAS unsigned char* Lin = F.lds + F.wave * 4608; LAS unsigned char* Lout = Lin + 3072;
    u32x4 nx[3];
    if (F.gw < MT) { const unsigned char* zr = (const unsigned char*)(Z + (size_t)F.gw * EV_IN);
#pragma unroll
        for (int i = 0; i < 3; ++i) nx[i] = *(const u32x4*)(zr + 1024 * i + 16 * F.lane); }
    for (int row = F.gw; row < MT; row += F.ngw) {
        const bool isx = row < MXR; const int t = row & 2047;
#pragma unroll
        for (int i = 0; i < 3; ++i) *(LAS u32x4*)(Lin + 1024 * i + 16 * F.lane) = nx[i];
        { const int nrow = (row + F.ngw < MT) ? row + F.ngw : row; const unsigned char* zn = (const unsigned char*)(Z + (size_t)nrow * EV_IN);
#pragma unroll
          for (int i = 0; i < 3; ++i) nx[i] = *(const u32x4*)(zn + 1024 * i + 16 * F.lane); }
        const LAS unsigned short* Li = (const LAS unsigned short*)Lin;
#pragma unroll
        for (int hv = 0; hv < 10; ++hv) {
            float v0 = __uint_as_float((unsigned)Li[hv * 128 + F.lane] << 16), v1 = __uint_as_float((unsigned)Li[hv * 128 + 64 + F.lane] << 16);
            const float ms = wave_sum(v0 * v0 + v1 * v1) * (1.f / 128.f);
            const float rs = __frsqrt_rn(ms + EPS);
            v0 = v0 * rs * (hv < 8 ? wq0 : wk0); v1 = v1 * rs * (hv < 8 ? wq1 : wk1);
            if (isx) rope_pair(v0, v1, F.lane, t >> 6, t & 63, inv);
            const float q8s = (hv < 8) ? QK8_SC * 1.020139447f : QK8_SC;
            Lout[hv * 128 + F.lane] = (unsigned char)(pk4_fp8(v0 * q8s, 0.f, 0.f, 0.f) & 0xff); Lout[hv * 128 + 64 + F.lane] = (unsigned char)(pk4_fp8(v1 * q8s, 0.f, 0.f, 0.f) & 0xff);
        }
#pragma unroll
        for (int q = 0; q < 4; ++q) Lout[1280 + 64 * q + F.lane] = (unsigned char)(pk4_fp8(__uint_as_float((unsigned)Li[1280 + 64 * q + F.lane] << 16), 0.f, 0.f, 0.f) & 0xff);
        *(u32x4*)(a.ws + WS_Q8 + (size_t)row * 1024 + 16 * F.lane) = *(const LAS u32x4*)(Lout + 16 * F.lane);
        if (F.lane < 32) { const u32x4 w1 = *(const LAS u32x4*)(Lout + 1024 + 16 * F.lane);
            unsigned char* dp = (F.lane < 16) ? (a.ws + WS_K8 + (size_t)row * 256 + 16 * F.lane) : (a.ws + WS_V8G + (size_t)row * 256 + 16 * (F.lane - 16));
            *(u32x4*)dp = w1; }
    }
}

struct AttnP {
    const bf16_t* Q; int ldq;
    const bf16_t* K1; int ldk1;
    const bf16_t* K2; int ldk2;
    const bf16_t* V; int ldv;
    unsigned char* O; int ldo;
    int qrow0;
    int orow0;
    int b;
    int nctx_tiles;
    int xtile0, nx_tiles;
    float sc_log2e;
    const float* rpb; int qgrow0;
};
template <int DK, bool NA, bool FAST>
DI void attn_unit(const Frame& F, const AttnP& p) {
    constexpr int KST = DK * 2 + 16;
    constexpr int VST = 320;
    constexpr int KBYTES = 64 * KST, VBYTES = 64 * VST;
    constexpr int NKS = DK / 16;
    constexpr int KCH = DK / 8;
    constexpr int KLD = (64 * KCH) / 512;
    LAS unsigned char* Ks = F.lds; LAS unsigned char* Vs = F.lds + KBYTES; LAS float* rp = (LAS float*)(F.lds + KBYTES + VBYTES);
    const int lane = F.lane, w = F.wave, r = lane & 31, hh = lane >> 5;
    const int ntiles = p.nctx_tiles + p.nx_tiles;
    if (NA) { for (int i = F.tid; i < 15 * 31; i += 512) rp[i] = p.rpb[i]; }
    bf16x8 qf[NKS];
    { const bf16_t* qp = p.Q + (size_t)(p.qrow0 + 32 * w + r) * p.ldq + 8 * hh;
#pragma unroll
      for (int ks = 0; ks < NKS; ++ks) qf[ks] = *(const bf16x8*)(qp + 16 * ks); }
    f32x16 oacc[4];
#pragma unroll
    for (int d = 0; d < 4; ++d) for (int i = 0; i < 16; ++i) oacc[d][i] = 0.f;
    float m_run = -1e30f, l_run = 0.f;
    u32x4 kreg[KLD], vreg[2];
#define ATT_TILE_ROW(j) (((j) < p.nctx_tiles) ? (MXR + p.b * CTXL + 64 * (j)) : (p.b * SEQ + 64 * (p.xtile0 + (j) - p.nctx_tiles)))
#define ATT_ISSUE(j) do { const int row0_ = ATT_TILE_ROW(j); \
        _Pragma("unroll") for (int i_ = 0; i_ < KLD; ++i_) { const int c_ = F.tid + 512 * i_, kr_ = c_ / KCH, kc_ = c_ % KCH; \
            if (DK == 128 || kc_ < 16) kreg[i_] = *(const u32x4*)(p.K1 + (size_t)(row0_ + kr_) * p.ldk1 + 8 * kc_); \
            else kreg[i_] = *(const u32x4*)(p.K2 + (size_t)(row0_ + kr_) * p.ldk2 + 8 * (kc_ - 16)); } \
        _Pragma("unroll") for (int i_ = 0; i_ < 2; ++i_) { const int c_ = F.tid + 512 * i_, vr_ = c_ >> 4, vc_ = c_ & 15; \
            vreg[i_] = *(const u32x4*)(p.V + (size_t)(row0_ + vr_) * p.ldv + 8 * vc_); } } while (0)
#define ATT_WRITE() do { \
        _Pragma("unroll") for (int i_ = 0; i_ < KLD; ++i_) { const int c_ = F.tid + 512 * i_, kr_ = c_ / KCH, kc_ = c_ % KCH; *(LAS u32x4*)(Ks + kr_ * KST + 16 * kc_) = kreg[i_]; } \
        _Pragma("unroll") for (int i_ = 0; i_ < 2; ++i_) { const int c_ = F.tid + 512 * i_, vr_ = c_ >> 4, vc_ = c_ & 15; *(LAS u32x4*)(Vs + vr_ * VST + 16 * vc_) = vreg[i_]; } } while (0)
    const int qgr = NA ? (p.qgrow0 + (w >> 1)) : 0;
    const int qc = 32 * (w & 1) + r;
    const int r0w = NA ? min(max(qgr - 4, 0), 24) : 0;
    const int csq = min(max(qc - 8, 0), 48);
    const int tq = (lane & 15) >> 2, tp = lane & 3, dsub = (lane >> 4) & 1;
    const unsigned vtr_base = (unsigned)(size_t)(Vs) + (unsigned)((4 * hh + tq) * VST + (16 * dsub + 4 * tp) * 2);
    const unsigned kfr_base = (unsigned)(size_t)(Ks) + (unsigned)(r * KST + 16 * hh);
    ATT_ISSUE(0);
    for (int j = 0; j < ntiles; ++j) {
        __syncthreads();
        ATT_WRITE();
        if (j + 1 < ntiles) ATT_ISSUE(j + 1);
        __syncthreads();
        bool active = true; int dr = 0;
        if (NA && j >= p.nctx_tiles) { const int kr = p.xtile0 + (j - p.nctx_tiles); active = (kr >= r0w) && (kr < r0w + 8); dr = kr - qgr + 7; }
        if (!active) continue;
        f32x16 st[2];
#pragma unroll
        for (int kb = 0; kb < 2; ++kb) for (int i = 0; i < 16; ++i) st[kb][i] = 0.f;
        {
            constexpr int NT = 2 * NKS;
            bf16x8 kr[4];
#define K_READ(R, T) asm volatile("ds_read_b128 %0, %1 offset:%2" : "=v"(R) : "v"(kfr_base), "n"(32 * ((T) / NKS) * KST + 32 * ((T) % NKS)) : "memory")
#define K_WAIT(R, N) asm volatile("s_waitcnt lgkmcnt(%1)" : "+v"(R) : "n"(N) : "memory")
            K_READ(kr[0], 0); K_READ(kr[1], 1); K_READ(kr[2], 2); K_READ(kr[3], 3);
#pragma unroll
            for (int t = 0; t < NT; ++t) {
                K_WAIT(kr[t & 3], (NT - 1 - t) < 3 ? (NT - 1 - t) : 3);
                st[t / NKS] = __builtin_amdgcn_mfma_f32_32x32x16_bf16(kr[t & 3], qf[t % NKS], st[t / NKS], 0, 0, 0);
                if (t + 4 < NT) K_READ(kr[t & 3], t + 4);
            }
#undef K_READ
#undef K_WAIT
        }
        s16x4 vlo[4], vhi[4];
#define V_READ(I, T) asm volatile("ds_read_b64_tr_b16 %0, %2 offset:%3\n\tds_read_b64_tr_b16 %1, %2 offset:%4" : "=&v"(vlo[I]), "=&v"(vhi[I]) : "v"(vtr_base), "n"(16 * ((T) >> 2) * VST + 64 * ((T) & 3)), "n"(16 * ((T) >> 2) * VST + 64 * ((T) & 3) + 8 * VST) : "memory")
#define V_WAIT(I, N) asm volatile("s_waitcnt lgkmcnt(%2)" : "+v"(vlo[I]), "+v"(vhi[I]) : "n"(N) : "memory")
        V_READ(0, 0); V_READ(1, 1); V_READ(2, 2); V_READ(3, 3);
        if constexpr (FAST) {
        float tmax = -1e30f;
        if (NA && j >= p.nctx_tiles) {
#pragma unroll
            for (int kb = 0; kb < 2; ++kb)
#pragma unroll
                for (int i = 0; i < 16; ++i) {
                    const int kc = 32 * kb + (i & 3) + 8 * (i >> 2) + 4 * hh; const bool inw = (kc >= csq) && (kc < csq + 16);
                    const int dc = min(max(kc - qc + 15, 0), 30); const float bias = rp[dr * 31 + dc];
                    const float sv = inw ? __builtin_fmaf(st[kb][i], p.sc_log2e, bias * 1.4426950408889634f) : -1e30f;
                    st[kb][i] = sv; tmax = fmaxf(tmax, sv); }
        } else {
#pragma unroll
            for (int kb = 0; kb < 2; ++kb)
#pragma unroll
                for (int i = 0; i < 16; ++i) tmax = fmaxf(tmax, st[kb][i]);
            tmax *= p.sc_log2e;
        }
        tmax = fmaxf(tmax, __shfl_xor(tmax, 32));
        if (__any(tmax > m_run + 11.5f)) {
            const float m_new = fmaxf(m_run, tmax);
            const float alpha = __builtin_amdgcn_exp2f(m_run - m_new);
            m_run = m_new; l_run *= alpha;
#pragma unroll
            for (int d = 0; d < 4; ++d)
#pragma unroll
                for (int i = 0; i < 16; ++i) oacc[d][i] *= alpha;
        }
        float psum = 0.f;
        if (NA && j >= p.nctx_tiles) {
#pragma unroll
            for (int kb = 0; kb < 2; ++kb)
#pragma unroll
                for (int i = 0; i < 16; ++i) { const float e = __builtin_amdgcn_exp2f(st[kb][i] - m_run); st[kb][i] = e; psum += e; }
        } else {
#pragma unroll
            for (int kb = 0; kb < 2; ++kb)
#pragma unroll
                for (int i = 0; i < 16; ++i) { const float e = __builtin_amdgcn_exp2f(__builtin_fmaf(st[kb][i], p.sc_log2e, -m_run)); st[kb][i] = e; psum += e; }
        }
        l_run += psum;
        } else {
        float tmax = -1e30f;
#pragma unroll
        for (int kb = 0; kb < 2; ++kb)
#pragma unroll
            for (int i = 0; i < 16; ++i) {
                float s = st[kb][i] * p.sc_log2e;
                if (NA && j >= p.nctx_tiles) { const int kc = 32 * kb + (i & 3) + 8 * (i >> 2) + 4 * hh; const bool inw = (kc >= csq) && (kc < csq + 16);
                    const int dc = min(max(kc - qc + 15, 0), 30); const float bias = rp[dr * 31 + dc];
                    s = inw ? (s + bias * 1.4426950408889634f) : -1e30f; }
                st[kb][i] = s; tmax = fmaxf(tmax, s); }
        tmax = fmaxf(tmax, __shfl_xor(tmax, 32));
        const float m_new = fmaxf(m_run, tmax);
        const float alpha = exp2f(m_run - m_new);
        m_run = m_new;
        float psum = 0.f;
#pragma unroll
        for (int kb = 0; kb < 2; ++kb)
#pragma unroll
            for (int i = 0; i < 16; ++i) { const float e = exp2f(st[kb][i] - m_new); st[kb][i] = e; psum += e; }
        l_run = l_run * alpha + psum;
#pragma unroll
        for (int d = 0; d < 4; ++d)
#pragma unroll
            for (int i = 0; i < 16; ++i) oacc[d][i] *= alpha;
        }
#pragma unroll
        for (int t = 0; t < 16; ++t) {
            const int T = t >> 2, KB = T >> 1, S = T & 1, d = t & 3;
            u32x4 pp; pp.x = pk2(st[KB][8 * S + 0], st[KB][8 * S + 1]); pp.y = pk2(st[KB][8 * S + 2], st[KB][8 * S + 3]);
            pp.z = pk2(st[KB][8 * S + 4], st[KB][8 * S + 5]); pp.w = pk2(st[KB][8 * S + 6], st[KB][8 * S + 7]);
            const bf16x8 pf = __builtin_bit_cast(bf16x8, pp);
            if (t < 13) V_WAIT(t & 3, 6); else if (t == 13) V_WAIT(t & 3, 4); else if (t == 14) V_WAIT(t & 3, 2); else V_WAIT(t & 3, 0);
            oacc[d] = __builtin_amdgcn_mfma_f32_32x32x16_bf16(__builtin_shufflevector(vlo[t & 3], vhi[t & 3], 0, 1, 2, 3, 4, 5, 6, 7), pf, oacc[d], 0, 0, 0);
            if (t + 4 < 16) {
                if ((t & 3) == 0) V_READ(0, t + 4); else if ((t & 3) == 1) V_READ(1, t + 4); else if ((t & 3) == 2) V_READ(2, t + 4); else V_READ(3, t + 4);
            }
        }
#undef V_READ
#undef V_WAIT
    }
    const float lt = l_run + __shfl_xor(l_run, 32);
    const float il = 1.f / lt;
    unsigned char* op = p.O + (size_t)(p.orow0 + 32 * w + r) * p.ldo;
    const float ils = il * FP8_ASC;
#pragma unroll
    for (int d = 0; d < 4; ++d)
#pragma unroll
        for (int g = 0; g < 4; ++g) *(int*)(op + 32 * d + 8 * g + 4 * hh) = pk4_fp8(oacc[d][4 * g + 0] * ils, oacc[d][4 * g + 1] * ils, oacc[d][4 * g + 2] * ils, oacc[d][4 * g + 3] * ils);
    __syncthreads();
#undef ATT_TILE_ROW
#undef ATT_ISSUE
#undef ATT_WRITE
}

typedef int i32x8 __attribute__((ext_vector_type(8)));
struct AttnQK8 { const unsigned char* Q8; int ldq8; const unsigned char* K8a; int ldk8a; const unsigned char* K8b; int ldk8b; const unsigned char* V8; int ldv8; };
template <int DK, bool QBF16, bool NA = false, bool QROPE = false>
DI void attn_unit_f8(const Frame& F, const AttnP& p, const AttnQK8& e) {
    constexpr int KST = DK + 16, VS8 = 144, KBYTES = 64 * KST, VBYTES = 64 * VS8;
    constexpr float QC = (DK == 192) ? 1.665880740f : 1.020139447f; constexpr int KSCALE = ((DK == 192) ? 115 : 116) * 0x01010101;
    constexpr float PTHR = 4.f;
    constexpr int NC = DK / 64, KCH = DK / 16, NCHUNK = 64 * KCH, KLD = (NCHUNK + 511) / 512, NT = 2 * NC;
    LAS unsigned char* Ks = F.lds; LAS unsigned char* Vs = F.lds + KBYTES; LAS float* rp = (LAS float*)(F.lds + KBYTES + VBYTES);
    const int lane = F.lane, w = F.wave, r = lane & 31, hh = lane >> 5;
    const int ntiles = p.nctx_tiles + p.nx_tiles;
    if (NA) { for (int i = F.tid; i < 15 * 31; i += 512) rp[i] = p.rpb[i]; }
    i32x8 qf[NC];
    if constexpr (QBF16) {
        const bf16_t* qp = p.Q + (size_t)(p.qrow0 + 32 * w + r) * p.ldq + 32 * hh;
#pragma unroll
        for (int c = 0; c < NC; ++c) {
#pragma unroll
            for (int g = 0; g < 4; ++g) { const u32x4 q4 = *(const u32x4*)(qp + 64 * c + 8 * g);
                qf[c][2 * g] = pk4_fp8(bflo(q4.x) * (QK8_SC * QC), bfhi(q4.x) * (QK8_SC * QC), bflo(q4.y) * (QK8_SC * QC), bfhi(q4.y) * (QK8_SC * QC));
                qf[c][2 * g + 1] = pk4_fp8(bflo(q4.z) * (QK8_SC * QC), bfhi(q4.z) * (QK8_SC * QC), bflo(q4.w) * (QK8_SC * QC), bfhi(q4.w) * (QK8_SC * QC)); } }
        if constexpr (QROPE) {
            float v[32];
#pragma unroll
            for (int g = 0; g < 4; ++g) { const u32x4 q4 = *(const u32x4*)(qp + 64 * (NC - 1) + 8 * g);
                v[8 * g + 0] = bflo(q4.x); v[8 * g + 1] = bfhi(q4.x); v[8 * g + 2] = bflo(q4.y); v[8 * g + 3] = bfhi(q4.y);
                v[8 * g + 4] = bflo(q4.z); v[8 * g + 5] = bfhi(q4.z); v[8 * g + 6] = bflo(q4.w); v[8 * g + 7] = bfhi(q4.w); }
            const int tpos = (p.qrow0 + 32 * w + r) & 2047; const float pos = (float)(hh ? (tpos & 63) : (tpos >> 6));
#pragma unroll
            for (int i = 0; i < 16; ++i) { const float ang = pos * exp2f(-(float)i * (13.287712379549449f / 16.f)); const float sn = __sinf(ang), cs = __cosf(ang);
                const float x0 = v[i], x1 = v[i + 16]; v[i] = x0 * cs - x1 * sn; v[i + 16] = x1 * cs + x0 * sn; }
#pragma unroll
            for (int g = 0; g < 8; ++g) qf[NC - 1][g] = pk4_fp8(v[4 * g] * (QK8_SC * QC), v[4 * g + 1] * (QK8_SC * QC), v[4 * g + 2] * (QK8_SC * QC), v[4 * g + 3] * (QK8_SC * QC));
        }
    } else {
      const unsigned char* qp = e.Q8 + (size_t)(p.qrow0 + 32 * w + r) * e.ldq8 + 32 * hh;
#pragma unroll
      for (int c = 0; c < NC; ++c) { const u32x4 qa = *(const u32x4*)(qp + 64 * c), qb = *(const u32x4*)(qp + 64 * c + 16); qf[c] = __builtin_bit_cast(i32x8, __builtin_shufflevector(qa, qb, 0, 1, 2, 3, 4, 5, 6, 7)); } }
    f32x16 oacc[4];
#pragma unroll
    for (int d = 0; d < 4; ++d) for (int i = 0; i < 16; ++i) oacc[d][i] = 0.f;
    constexpr bool LSUM = (DK == 128 && !NA);
    float l_run = 0.f;
    f32x16 lacc;
#pragma unroll
    for (int i = 0; i < 16; ++i) lacc[i] = 0.f;
    f32x16 cinit;
#pragma unroll
    for (int i = 0; i < 16; ++i) cinit[i] = 0.f;
    u32x4 kreg[KLD], vreg;
#define A8_TILE_ROW(j) (((j) < p.nctx_tiles) ? (MXR + p.b * CTXL + 64 * (j)) : (p.b * SEQ + 64 * (p.xtile0 + (j) - p.nctx_tiles)))
#define A8_ISSUE(j) do { const int row0_ = A8_TILE_ROW(j); \
        _Pragma("unroll") for (int i_ = 0; i_ < KLD; ++i_) { const int c_ = F.tid + 512 * i_, kr_ = c_ / KCH, kc_ = c_ % KCH; \
            if (c_ < NCHUNK) { if (DK == 128 || kc_ < 8) kreg[i_] = *(const u32x4*)(e.K8a + (size_t)(row0_ + kr_) * e.ldk8a + 16 * kc_); \
                               else kreg[i_] = *(const u32x4*)(e.K8b + (size_t)(row0_ + kr_) * e.ldk8b + 16 * (kc_ - 8)); } } \
        vreg = *(const u32x4*)(e.V8 + (size_t)(row0_ + (F.tid >> 3)) * e.ldv8 + 16 * (F.tid & 7)); } while (0)
#define A8_WRITE() do { \
        _Pragma("unroll") for (int i_ = 0; i_ < KLD; ++i_) { const int c_ = F.tid + 512 * i_, kr_ = c_ / KCH, kc_ = c_ % KCH; if (c_ < NCHUNK) *(LAS u32x4*)(Ks + kr_ * KST + 16 * kc_) = kreg[i_]; } \
        *(LAS u32x4*)(Vs + (F.tid >> 3) * VS8 + 16 * (F.tid & 7)) = vreg; } while (0)
    const int qgr = NA ? (p.qgrow0 + (w >> 1)) : 0;
    const int qc = 32 * (w & 1) + r;
    const int r0w = NA ? min(max(qgr - 4, 0), 24) : 0;
    const int csq = min(max(qc - 8, 0), 48);
    const unsigned vt_base = (unsigned)(size_t)(Vs) + (unsigned)((8 * (((lane & 15) >> 1) >> 2) + 4 * hh + (((lane & 15) >> 1) & 3)) * VS8 + 16 * ((lane >> 4) & 1) + 8 * (lane & 1));
    const unsigned kfr_base = (unsigned)(size_t)(Ks) + (unsigned)(r * KST + 32 * hh);
    A8_ISSUE(0);
    for (int j = 0; j < ntiles; ++j) {
        __syncthreads();
        A8_WRITE();
        if (j + 1 < ntiles) A8_ISSUE(j + 1);
        __syncthreads();
        bool active = true; int dr = 0;
        if (NA && j >= p.nctx_tiles) { const int krow = p.xtile0 + (j - p.nctx_tiles); active = (krow >= r0w) && (krow < r0w + 8); dr = krow - qgr + 7; }
        if (!active) continue;
        f32x16 st[2];
        {
            u32x4 klo[4], khi[4];
#define K8_READ(I, T) asm volatile("ds_read_b128 %0, %2 offset:%3\n\tds_read_b128 %1, %2 offset:%4" : "=&v"(klo[I]), "=&v"(khi[I]) : "v"(kfr_base), "n"(32 * ((T) / NC) * KST + 64 * ((T) % NC)), "n"(32 * ((T) / NC) * KST + 64 * ((T) % NC) + 16) : "memory")
#define K8_WAIT(I, N) asm volatile("s_waitcnt lgkmcnt(%2)" : "+v"(klo[I]), "+v"(khi[I]) : "n"(N) : "memory")
            K8_READ(0, 0); K8_READ(1, 1); K8_READ(2, 2); K8_READ(3, 3);
#pragma unroll
            for (int t = 0; t < NT; ++t) {
                const int last = (t + 3 < NT - 1) ? t + 3 : NT - 1;
                if ((t & 3) == 0) K8_WAIT(0, 2 * (last - t)); else if ((t & 3) == 1) K8_WAIT(1, 2 * (last - t)); else if ((t & 3) == 2) K8_WAIT(2, 2 * (last - t)); else K8_WAIT(3, 2 * (last - t));
                const i32x8 kf = __builtin_bit_cast(i32x8, __builtin_shufflevector(klo[t & 3], khi[t & 3], 0, 1, 2, 3, 4, 5, 6, 7));
                st[t / NC] = __builtin_amdgcn_mfma_scale_f32_32x32x64_f8f6f4(kf, qf[t % NC], (t % NC == 0) ? cinit : st[t / NC], 0, 0, 0, KSCALE, 0, 0x7f7f7f7f);
                if (t + 4 < NT) { if ((t & 3) == 0) K8_READ(0, t + 4); else if ((t & 3) == 1) K8_READ(1, t + 4); else if ((t & 3) == 2) K8_READ(2, t + 4); else K8_READ(3, t + 4); }
            }
#undef K8_READ
#undef K8_WAIT
        }
        u32x2 va[2][4];
#define V_READ(I, D) asm volatile("ds_read_b64_tr_b8 %0, %4 offset:%5\n\tds_read_b64_tr_b8 %1, %4 offset:%6\n\tds_read_b64_tr_b8 %2, %4 offset:%7\n\tds_read_b64_tr_b8 %3, %4 offset:%8" \
            : "=&v"(va[I][0]), "=&v"(va[I][1]), "=&v"(va[I][2]), "=&v"(va[I][3]) : "v"(vt_base), "n"(32 * (D)), "n"(16 * VS8 + 32 * (D)), "n"(32 * VS8 + 32 * (D)), "n"(48 * VS8 + 32 * (D)) : "memory")
#define V_WAIT(I, N) asm volatile("s_waitcnt lgkmcnt(%4)" : "+v"(va[I][0]), "+v"(va[I][1]), "+v"(va[I][2]), "+v"(va[I][3]) : "n"(N) : "memory")
        V_READ(0, 0); V_READ(1, 1);
        float tmax = -1e30f;
        const bool masked = NA && j >= p.nctx_tiles;
        if (masked) {
#pragma unroll
            for (int kb = 0; kb < 2; ++kb)
#pragma unroll
                for (int i = 0; i < 16; ++i) {
                    const int kc = 32 * kb + (i & 3) + 8 * (i >> 2) + 4 * hh; const bool inw = (kc >= csq) && (kc < csq + 16);
                    const int dc = min(max(kc - qc + 15, 0), 30); const float bias = rp[dr * 31 + dc];
                    const float sv = inw ? __builtin_fmaf(bias, 1.4426950408889634f, st[kb][i]) : -1e30f;
                    st[kb][i] = sv; tmax = fmaxf(tmax, sv); }
        } else {
#pragma unroll
            for (int kb = 0; kb < 2; ++kb)
#pragma unroll
                for (int i = 0; i < 16; ++i) tmax = fmaxf(tmax, st[kb][i]);
        }
        tmax = fmaxf(tmax, __shfl_xor(tmax, 32));
        if (j == 0 || __any(tmax > 4.f + PTHR)) {
            const float dm = (j == 0) ? (tmax - 4.f) : fmaxf(tmax - 4.f, 0.f);
            const float alpha = __builtin_amdgcn_exp2f(-dm);
            l_run *= alpha;
            if constexpr (LSUM) {
#pragma unroll
                for (int i = 0; i < 16; ++i) lacc[i] *= alpha; }
#pragma unroll
            for (int d = 0; d < 4; ++d)
#pragma unroll
                for (int i = 0; i < 16; ++i) oacc[d][i] *= alpha;
#pragma unroll
            for (int kb = 0; kb < 2; ++kb)
#pragma unroll
                for (int i = 0; i < 16; ++i) st[kb][i] -= dm;
            const float cn = cinit[0] - dm;
#pragma unroll
            for (int i = 0; i < 16; ++i) cinit[i] = cn;
        }
        float psum = 0.f;
#pragma unroll
        for (int kb = 0; kb < 2; ++kb)
#pragma unroll
            for (int i = 0; i < 16; ++i) { const float ex = __builtin_amdgcn_exp2f(st[kb][i]); st[kb][i] = ex; if constexpr (!LSUM) psum += ex; }
        l_run += psum;
        i32x8 pf;
#pragma unroll
        for (int v = 0; v < 8; ++v) { const int kb = v >> 2, m = v & 3;
            int t = __builtin_amdgcn_cvt_pk_fp8_f32(st[kb][4 * m], st[kb][4 * m + 1], 0, false); pf[v] = __builtin_amdgcn_cvt_pk_fp8_f32(st[kb][4 * m + 2], st[kb][4 * m + 3], t, true); }
        if constexpr (LSUM) { i32x8 ones; for (int v = 0; v < 8; ++v) ones[v] = 0x38383838;
            lacc = __builtin_amdgcn_mfma_scale_f32_32x32x64_f8f6f4(ones, pf, lacc, 0, 0, 0, 0x7f7f7f7f, 0, 0x7f7f7f7f); }
#pragma unroll
        for (int d = 0; d < 4; ++d) {
            if (d == 0) V_WAIT(0, 4); else if (d == 1) V_WAIT(1, 4); else if (d == 2) V_WAIT(0, 4); else V_WAIT(1, 0);
            const i32x8 vf = __builtin_bit_cast(i32x8, __builtin_shufflevector(__builtin_shufflevector(va[d & 1][0], va[d & 1][1], 0, 1, 2, 3), __builtin_shufflevector(va[d & 1][2], va[d & 1][3], 0, 1, 2, 3), 0, 1, 2, 3, 4, 5, 6, 7));
            oacc[d] = __builtin_amdgcn_mfma_scale_f32_32x32x64_f8f6f4(vf, pf, oacc[d], 0, 0, 0, 0x7f7f7f7f, 0, 0x7f7f7f7f);
            if (d == 0) V_READ(0, 2); else if (d == 1) V_READ(1, 3);
        }
#undef V_READ
#undef V_WAIT
    }
    const float lt = LSUM ? lacc[0] : (l_run + __shfl_xor(l_run, 32));
    const float il = 1.f / lt;
    unsigned char* op = p.O + (size_t)(p.orow0 + 32 * w + r) * p.ldo;
    const float ils = il * FP8_ASC;
#pragma unroll
    for (int d = 0; d < 4; ++d) {
        unsigned wq[4];
#pragma unroll
        for (int g = 0; g < 4; ++g) wq[g] = (unsigned)pk4_fp8(oacc[d][4 * g + 0] * ils, oacc[d][4 * g + 1] * ils, oacc[d][4 * g + 2] * ils, oacc[d][4 * g + 3] * ils);
        const auto s02 = __builtin_amdgcn_permlane32_swap(wq[0], wq[2], false, false), s13 = __builtin_amdgcn_permlane32_swap(wq[1], wq[3], false, false);
        *(u32x4*)(op + 32 * d + 16 * hh) = (u32x4){s02[0], s02[1], s13[0], s13[1]};
    }
    __syncthreads();
#undef A8_TILE_ROW
#undef A8_ISSUE
#undef A8_WRITE
}

DI int hg_tok_row(int b, int dir, int c, int t) {
    if (c < 8) { const int pos = 32 * c + t; return MXR + b * CTXL + (dir ? (CTXL - 1 - pos) : pos); }
    const int pos = 32 * (c - 8) + t; return b * SEQ + (dir ? (SEQ - 1 - pos) : pos);
}
DI void hgrn_pair(const Frame& F, const Args& a, int pair) {
    const int b = pair >> 3, h = pair & 7, dir = F.tid >> 8;
    const bf16_t* Z = (const bf16_t*)(a.ws + WS_Z);
    bf16_t* OUT = (bf16_t*)(a.ws + (dir ? WS_OB : WS_OF));
    LAS unsigned char* base = F.lds + dir * 65536;
    LAS float* G = (LAS float*)base;
    LAS unsigned char* QE1 = base + 16384;
    LAS unsigned char* KE = base + 25088;
    LAS unsigned char* QE2 = base + 33792;
    LAS unsigned char* KDr = base + 42496;
    LAS unsigned char* VVr = base + 51712;
    LAS float* DL = (LAS float*)(base + 60928);
    const int t256 = F.tid & 255, lane = F.lane, wl = F.wave & 3;
    const int tau = t256 >> 3, dq = (t256 & 7) * 16;
    LAS float* LB = (LAS float*)(base + 61440);
    if (t256 < 128) { const float* hl = a.in[I_HLB] + (size_t)dir * 3 * 1024 + h * 128 + t256; const float v0 = hl[0], v1 = hl[1024], v2 = hl[2048]; const float mx = fmaxf(v0, fmaxf(v1, v2));
        const float e0 = __expf(v0 - mx), e1 = __expf(v1 - mx), e2 = __expf(v2 - mx); LB[t256] = e0 / (e0 + e1 + e2); }
    __syncthreads();
    const int qcol = 1536 + h * 128 + dq, fcol = (dir ? 3584 : 2560) + h * 128 + dq, vcol = 4608 + h * 128 + dq;
    u32x4 rq[2], rf[2], rv[2];
#pragma unroll
    for (int g = 0; g < 2; ++g) {
        { const bf16_t* zr = Z + (size_t)hg_tok_row(b, dir, 0, tau) * EV_IN + 8 * g; rq[g] = *(const u32x4*)(zr + qcol); rf[g] = *(const u32x4*)(zr + fcol); rv[g] = *(const u32x4*)(zr + vcol); }
    }
    f32x4 S[2][8];
#pragma unroll
    for (int nb = 0; nb < 2; ++nb)
#pragma unroll
        for (int i = 0; i < 8; ++i) S[nb][i] = (f32x4){0.f, 0.f, 0.f, 0.f};
    const int fr = lane & 15, fg = lane >> 4;
    for (int c = 0; c < 72; ++c) {
        float kv[2][8], gv[2][8];
#pragma unroll
        for (int g = 0; g < 2; ++g) {
            const unsigned uf[4] = {rf[g].x, rf[g].y, rf[g].z, rf[g].w};
            const f32x4 lb0 = *(const LAS f32x4*)(LB + dq + 8 * g), lb1 = *(const LAS f32x4*)(LB + dq + 8 * g + 4); const float lbv[8] = {lb0[0], lb0[1], lb0[2], lb0[3], lb1[0], lb1[1], lb1[2], lb1[3]};
#pragma unroll
            for (int i = 0; i < 4; ++i) {
                const float f0 = bflo(uf[i]), f1 = bfhi(uf[i]);
                const float s0 = 1.f / (1.f + __expf(-f0)), s1 = 1.f / (1.f + __expf(-f1));
                const float l0 = lbv[2 * i], l1 = lbv[2 * i + 1];
                kv[g][2 * i] = (1.f - l0) * (1.f - s0); kv[g][2 * i + 1] = (1.f - l1) * (1.f - s1);
                gv[g][2 * i] = __logf(l0 + (1.f - l0) * s0); gv[g][2 * i + 1] = __logf(l1 + (1.f - l1) * s1); }
            *(LAS f32x4*)(G + tau * 128 + dq + 8 * g) = (f32x4){gv[g][0], gv[g][1], gv[g][2], gv[g][3]};
            *(LAS f32x4*)(G + tau * 128 + dq + 8 * g + 4) = (f32x4){gv[g][4], gv[g][5], gv[g][6], gv[g][7]}; }
        __syncthreads();
        if (t256 < 128) { float run = 0.f;
#pragma unroll
            for (int t = 0; t < 32; ++t) { run += G[t * 128 + t256]; G[t * 128 + t256] = run; } }
        __syncthreads();
#pragma unroll
        for (int g = 0; g < 2; ++g) { const int d0 = dq + 8 * g;
          const f32x4 c0 = *(const LAS f32x4*)(G + tau * 128 + d0), c1 = *(const LAS f32x4*)(G + tau * 128 + d0 + 4);
          const f32x4 m0 = *(const LAS f32x4*)(G + 15 * 128 + d0), m1 = *(const LAS f32x4*)(G + 15 * 128 + d0 + 4);
          const f32x4 e0 = *(const LAS f32x4*)(G + 31 * 128 + d0), e1 = *(const LAS f32x4*)(G + 31 * 128 + d0 + 4);
          float cu[8] = {c0[0], c0[1], c0[2], c0[3], c1[0], c1[1], c1[2], c1[3]};
          float mm[8] = {m0[0], m0[1], m0[2], m0[3], m1[0], m1[1], m1[2], m1[3]};
          float la[8] = {e0[0], e0[1], e0[2], e0[3], e1[0], e1[1], e1[2], e1[3]};
          const unsigned uq[4] = {rq[g].x, rq[g].y, rq[g].z, rq[g].w};
          float qv[8], q1[8], k1[8], q2[8], kd[8];
#pragma unroll
          for (int i = 0; i < 4; ++i) { qv[2 * i] = bflo(uq[i]); qv[2 * i + 1] = bfhi(uq[i]); }
#pragma unroll
          for (int i = 0; i < 8; ++i) { q1[i] = qv[i] * __expf(cu[i] - mm[i]); k1[i] = kv[g][i] * __expf(mm[i] - cu[i]); q2[i] = qv[i] * __expf(cu[i]); kd[i] = kv[g][i] * __expf(la[i] - cu[i]); }
          u32x4 o;
          o.x = pk2(q1[0], q1[1]); o.y = pk2(q1[2], q1[3]); o.z = pk2(q1[4], q1[5]); o.w = pk2(q1[6], q1[7]); *(LAS u32x4*)(QE1 + tau * 272 + d0 * 2) = o;
          o.x = pk2(k1[0], k1[1]); o.y = pk2(k1[2], k1[3]); o.z = pk2(k1[4], k1[5]); o.w = pk2(k1[6], k1[7]); *(LAS u32x4*)(KE + tau * 272 + d0 * 2) = o;
          o.x = pk2(q2[0], q2[1]); o.y = pk2(q2[2], q2[3]); o.z = pk2(q2[4], q2[5]); o.w = pk2(q2[6], q2[7]); *(LAS u32x4*)(QE2 + tau * 272 + d0 * 2) = o;
          o.x = pk2(kd[0], kd[1]); o.y = pk2(kd[2], kd[3]); o.z = pk2(kd[4], kd[5]); o.w = pk2(kd[6], kd[7]); *(LAS u32x4*)(KDr + tau * 288 + d0 * 2) = o;
          *(LAS u32x4*)(VVr + tau * 288 + d0 * 2) = rv[g];
          if (tau == 31) {
#pragma unroll
              for (int i = 0; i < 8; ++i) DL[d0 + i] = __expf(la[i]); } }
#pragma unroll
        for (int g = 0; g < 2; ++g) { const int cn = (c + 1 < 72) ? c + 1 : 71; const bf16_t* zr = Z + (size_t)hg_tok_row(b, dir, cn, tau) * EV_IN + 8 * g; rq[g] = *(const u32x4*)(zr + qcol); rf[g] = *(const u32x4*)(zr + fcol); rv[g] = *(const u32x4*)(zr + vcol); }
        __syncthreads();
        f32x4 X00 = {0.f, 0.f, 0.f, 0.f}, X01 = X00, X11 = X00;
#pragma unroll
        for (int ks = 0; ks < 4; ++ks) {
            const bf16x8 ke0 = *(const LAS bf16x8*)(KE + fr * 272 + (32 * ks + 8 * fg) * 2), ke1 = *(const LAS bf16x8*)(KE + (16 + fr) * 272 + (32 * ks + 8 * fg) * 2);
            const bf16x8 qe0 = *(const LAS bf16x8*)(QE1 + fr * 272 + (32 * ks + 8 * fg) * 2), qe1 = *(const LAS bf16x8*)(QE1 + (16 + fr) * 272 + (32 * ks + 8 * fg) * 2);
            X00 = __builtin_amdgcn_mfma_f32_16x16x32_bf16(ke0, qe0, X00, 0, 0, 0);
            X01 = __builtin_amdgcn_mfma_f32_16x16x32_bf16(ke0, qe1, X01, 0, 0, 0);
            X11 = __builtin_amdgcn_mfma_f32_16x16x32_bf16(ke1, qe1, X11, 0, 0, 0);
        }
#pragma unroll
        for (int i = 0; i < 4; ++i) { const bool keep = (4 * fg + i) <= fr; X00[i] = keep ? X00[i] : 0.f; X11[i] = keep ? X11[i] : 0.f; }
        u32x4 p0; p0.x = pk2(X00[0], X00[1]); p0.y = pk2(X00[2], X00[3]); p0.z = 0u; p0.w = 0u;
        u32x4 p1; p1.x = pk2(X01[0], X01[1]); p1.y = pk2(X01[2], X01[3]); p1.z = pk2(X11[0], X11[1]); p1.w = pk2(X11[2], X11[3]);
#pragma unroll
        for (int nb = 0; nb < 2; ++nb) {
            const int dvc = 32 * wl + 16 * nb;
            bf16x8 vf;
            { s16x4 v0, v1; const unsigned va = (unsigned)(size_t)VVr + (unsigned)((4 * fg + ((lane & 15) >> 2)) * 288 + (dvc + 4 * (lane & 3)) * 2);
              asm volatile("ds_read_b64_tr_b16 %0, %2\n\tds_read_b64_tr_b16 %1, %2 offset:4608\n\ts_waitcnt lgkmcnt(0)" : "=&v"(v0), "=&v"(v1) : "v"(va) : "memory");
              vf = __builtin_shufflevector(v0, v1, 0, 1, 2, 3, 4, 5, 6, 7); }
            f32x4 o0 = {0.f, 0.f, 0.f, 0.f}, o1 = o0;
            o0 = __builtin_amdgcn_mfma_f32_16x16x32_bf16(__builtin_bit_cast(bf16x8, p0), vf, o0, 0, 0, 0);
            o1 = __builtin_amdgcn_mfma_f32_16x16x32_bf16(__builtin_bit_cast(bf16x8, p1), vf, o1, 0, 0, 0);
#pragma unroll
            for (int ks = 0; ks < 4; ++ks) {
                u32x4 sp; sp.x = pk2(S[nb][2 * ks][0], S[nb][2 * ks][1]); sp.y = pk2(S[nb][2 * ks][2], S[nb][2 * ks][3]); sp.z = pk2(S[nb][2 * ks + 1][0], S[nb][2 * ks + 1][1]); sp.w = pk2(S[nb][2 * ks + 1][2], S[nb][2 * ks + 1][3]);
                const bf16x8 sf = __builtin_bit_cast(bf16x8, sp);
                const s16x4 a00 = *(const LAS s16x4*)(QE2 + fr * 272 + (32 * ks + 4 * fg) * 2), a01 = *(const LAS s16x4*)(QE2 + fr * 272 + (32 * ks + 16 + 4 * fg) * 2);
                const s16x4 a10 = *(const LAS s16x4*)(QE2 + (16 + fr) * 272 + (32 * ks + 4 * fg) * 2), a11 = *(const LAS s16x4*)(QE2 + (16 + fr) * 272 + (32 * ks + 16 + 4 * fg) * 2);
                o0 = __builtin_amdgcn_mfma_f32_16x16x32_bf16(__builtin_shufflevector(a00, a01, 0, 1, 2, 3, 4, 5, 6, 7), sf, o0, 0, 0, 0);
                o1 = __builtin_amdgcn_mfma_f32_16x16x32_bf16(__builtin_shufflevector(a10, a11, 0, 1, 2, 3, 4, 5, 6, 7), sf, o1, 0, 0, 0);
            }
#pragma unroll
            for (int db = 0; db < 8; ++db) {
                const f32x4 dl = *(const LAS f32x4*)(DL + 16 * db + 4 * fg);
                s16x4 k0, k1; { const unsigned ka = (unsigned)(size_t)KDr + (unsigned)((4 * fg + ((lane & 15) >> 2)) * 288 + (16 * db + 4 * (lane & 3)) * 2);
                  asm volatile("ds_read_b64_tr_b16 %0, %2\n\tds_read_b64_tr_b16 %1, %2 offset:4608\n\ts_waitcnt lgkmcnt(0)" : "=&v"(k0), "=&v"(k1) : "v"(ka) : "memory"); }
                f32x4 sc = S[nb][db] * dl;
                S[nb][db] = __builtin_amdgcn_mfma_f32_16x16x32_bf16(__builtin_shufflevector(k0, k1, 0, 1, 2, 3, 4, 5, 6, 7), vf, sc, 0, 0, 0);
            }
#pragma unroll
            for (int i = 0; i < 4; ++i) {
                OUT[(size_t)hg_tok_row(b, dir, c, 4 * fg + i) * 1024 + h * 128 + dvc + fr] = (bf16_t)(pk2(o0[i], 0.f) & 0xffffu);
                OUT[(size_t)hg_tok_row(b, dir, c, 16 + 4 * fg + i) * 1024 + h * 128 + dvc + fr] = (bf16_t)(pk2(o1[i], 0.f) & 0xffffu);
            }
        }
    }
    __syncthreads();
}

DI void hgrn_readout_phase(const Frame& F, const Args& a) {
    const bf16_t* OFp = (const bf16_t*)(a.ws + WS_OF); const bf16_t* OBp = (const bf16_t*)(a.ws + WS_OB);
    const bf16_t* Z = (const bf16_t*)(a.ws + WS_Z); unsigned char* Y = a.ws + WS_ACT;
    const float* wn = a.in[I_HON] + 16 * F.lane;
    float wv[16];
#pragma unroll
    for (int i = 0; i < 16; ++i) wv[i] = wn[i];
    for (int row = F.gw; row < MT; row += F.ngw) {
        const u32x4 f0 = *(const u32x4*)(OFp + (size_t)row * 1024 + 16 * F.lane), f1 = *(const u32x4*)(OFp + (size_t)row * 1024 + 16 * F.lane + 8);
        const u32x4 b0 = *(const u32x4*)(OBp + (size_t)row * 1024 + 16 * F.lane), b1 = *(const u32x4*)(OBp + (size_t)row * 1024 + 16 * F.lane + 8);
        const u32x4 g0 = *(const u32x4*)(Z + (size_t)row * EV_IN + 5632 + 16 * F.lane), g1 = *(const u32x4*)(Z + (size_t)row * EV_IN + 5632 + 16 * F.lane + 8);
        const unsigned uf[8] = {f0.x, f0.y, f0.z, f0.w, f1.x, f1.y, f1.z, f1.w}, ub[8] = {b0.x, b0.y, b0.z, b0.w, b1.x, b1.y, b1.z, b1.w}, ug[8] = {g0.x, g0.y, g0.z, g0.w, g1.x, g1.y, g1.z, g1.w};
        float o[16], gt[16]; float ss = 0.f;
#pragma unroll
        for (int i = 0; i < 8; ++i) { o[2 * i] = bflo(uf[i]) + bflo(ub[i]); o[2 * i + 1] = bfhi(uf[i]) + bfhi(ub[i]); gt[2 * i] = bflo(ug[i]); gt[2 * i + 1] = bfhi(ug[i]);
            ss += o[2 * i] * o[2 * i] + o[2 * i + 1] * o[2 * i + 1]; }
        ss += __shfl_xor(ss, 1); ss += __shfl_xor(ss, 2); ss += __shfl_xor(ss, 4);
        const float rs = __frsqrt_rn(ss * (1.f / 128.f) + EPS);
        unsigned pk[4];
#pragma unroll
        for (int i = 0; i < 4; ++i) { float y4[4];
#pragma unroll
            for (int e = 0; e < 4; ++e) y4[e] = o[4 * i + e] * rs * wv[4 * i + e] * silu_f(gt[4 * i + e]) * FP8_ASC;
            pk[i] = (unsigned)pk4_fp8(y4[0], y4[1], y4[2], y4[3]); }
        *(u32x4*)(Y + (size_t)row * DM + 1024 + 16 * F.lane) = (u32x4){pk[0], pk[1], pk[2], pk[3]};
    }
}

DI void mixer0_phase(const Frame& F, const Args& a) {
    for (int pair = F.wg; pair < 128; pair += F.G) hgrn_pair(F, a, pair);
    const bf16_t* Z = (const bf16_t*)(a.ws + WS_Z); unsigned char* Y = a.ws + WS_ACT;
    unsigned* qctr = (unsigned*)(a.ws + WS_CTL) + CW_QUEUE;
    volatile LAS unsigned* qslot = (volatile LAS unsigned*)(F.lds + LDS_MISC + 64);
    if (F.tid == 0) *qslot = __hip_atomic_fetch_add(qctr, 1u, __ATOMIC_RELAXED, __HIP_MEMORY_SCOPE_AGENT);
    __syncthreads();
    int u = (int)*qslot;
    while (u < 1024 + 128) {
        unsigned nxt = 0u;
        if (F.tid == 0) nxt = __hip_atomic_fetch_add(qctr, 1u, __ATOMIC_RELAXED, __HIP_MEMORY_SCOPE_AGENT);
        AttnP p{};
        p.ldq = EV_IN; p.ldk1 = EV_IN; p.K2 = nullptr; p.ldk2 = 0; p.ldv = EV_IN; p.ldo = DM; p.nctx_tiles = 4; p.xtile0 = 0;
        p.sc_log2e = 0.08838834764831845f * 1.4426950408889634f; p.rpb = nullptr; p.qgrow0 = 0;
        int b, head;
        if (u < 1024) { const int qb = u & 7; head = (u >> 3) & 7; b = u >> 6; p.qrow0 = b * SEQ + 256 * qb; p.nx_tiles = 32; }
        else { const int v = u - 1024; head = v & 7; b = v >> 3; p.qrow0 = MXR + b * CTXL; p.nx_tiles = 0; }
        const int kvh = head >> 2;
        p.b = b; p.orow0 = p.qrow0;
        p.Q = Z + head * 128; p.K1 = Z + 1024 + kvh * 128; p.V = Z + 1280 + kvh * 128; p.O = Y + head * 128;
        const AttnQK8 e{a.ws + WS_Q8 + head * 128, 1024, a.ws + WS_K8 + kvh * 128, 256, nullptr, 0, a.ws + WS_V8G + kvh * 128, 256};
        attn_unit_f8<128, false>(F, p, e);
        if (F.tid == 0) *qslot = nxt;
        __syncthreads();
        u = (int)*qslot;
    }
}

DI void rope64(float& v, int lane, int t, float inv16) {
    const float pv = __shfl_xor(v, 16);
    const int pos = (lane < 32) ? (t >> 6) : (t & 63);
    const float ang = (float)pos * inv16;
    const float sn = __sinf(ang), cs = __cosf(ang);
    const float sg = ((lane & 16) == 0) ? -1.f : 1.f;
    v = v * cs + sg * pv * sn;
}
DI void mla_prep_phase(const Frame& F, const Args& a) {
    bf16_t* Z = (bf16_t*)(a.ws + WS_Z);
    const float inv16 = exp2f(-(float)(F.lane & 15) * (13.287712379549449f / 16.f));
    f32x4 wq0 = *(const f32x4*)(a.in[I_MQN] + 8 * F.lane), wq1 = *(const f32x4*)(a.in[I_MQN] + 8 * F.lane + 4);
    f32x4 wk0 = *(const f32x4*)(a.in[I_MKVN] + 8 * F.lane), wk1 = *(const f32x4*)(a.in[I_MKVN] + 8 * F.lane + 4);
    for (int row = F.gw; row < MT; row += F.ngw) {
        bf16_t* zr = Z + (size_t)row * OD_INP;
#pragma unroll
        for (int part = 0; part < 2; ++part) {
            bf16_t* p = zr + 3072 + part * 512 + 8 * F.lane;
            const u32x4 u = *(const u32x4*)p; const unsigned uu[4] = {u.x, u.y, u.z, u.w};
            float v[8]; float ss = 0.f;
#pragma unroll
            for (int i = 0; i < 4; ++i) { v[2 * i] = bflo(uu[i]); v[2 * i + 1] = bfhi(uu[i]); ss += v[2 * i] * v[2 * i] + v[2 * i + 1] * v[2 * i + 1]; }
            const float rs = __frsqrt_rn(wave_sum(ss) * (1.f / 512.f) + EPS);
            const f32x4 w0 = part ? wk0 : wq0, w1 = part ? wk1 : wq1;
            u32x2 o; o.x = (unsigned)pk4_fp8(v[0] * rs * w0[0] * FP8_ASC, v[1] * rs * w0[1] * FP8_ASC, v[2] * rs * w0[2] * FP8_ASC, v[3] * rs * w0[3] * FP8_ASC);
            o.y = (unsigned)pk4_fp8(v[4] * rs * w1[0] * FP8_ASC, v[5] * rs * w1[1] * FP8_ASC, v[6] * rs * w1[2] * FP8_ASC, v[7] * rs * w1[3] * FP8_ASC);
            *(u32x2*)(a.ws + WS_ACT + (size_t)part * MT * 512 + (size_t)row * 512 + 8 * F.lane) = o;
        }
        { float v = __uint_as_float((unsigned)zr[4096 + F.lane] << 16); if (row < MXR) rope64(v, F.lane, row & 2047, inv16);
          (a.ws + WS_K8R)[(size_t)row * 64 + F.lane] = (unsigned char)(pk4_fp8(v * QK8_SC, 0.f, 0.f, 0.f) & 0xff); }
    }
}
DI void mla_qrope_phase(const Frame& F, const Args& a) {
    bf16_t* Q = (bf16_t*)(a.ws + WS_QUP);
    const float inv16 = exp2f(-(float)(F.lane & 15) * (13.287712379549449f / 16.f));
    unsigned short nx[8];
    if (F.gw < MXR) {
#pragma unroll
        for (int h = 0; h < 8; ++h) nx[h] = Q[(size_t)F.gw * 1536 + h * 192 + 128 + F.lane]; }
    for (int row = F.gw; row < MXR; row += F.ngw) {
        bf16_t* qr = Q + (size_t)row * 1536;
        unsigned short cu[8];
#pragma unroll
        for (int h = 0; h < 8; ++h) cu[h] = nx[h];
        { const int nrow = (row + F.ngw < MXR) ? row + F.ngw : row;
#pragma unroll
          for (int h = 0; h < 8; ++h) nx[h] = Q[(size_t)nrow * 1536 + h * 192 + 128 + F.lane]; }
#pragma unroll
        for (int h = 0; h < 8; ++h) { float v = __uint_as_float((unsigned)cu[h] << 16); rope64(v, F.lane, row & 2047, inv16); qr[h * 192 + 128 + F.lane] = (bf16_t)(pk2(v, 0.f) & 0xffffu); }
    }
}

DI void mixer1_phase(const Frame& F, const Args& a) {
    const bf16_t* Z = (const bf16_t*)(a.ws + WS_Z); unsigned char* Y = a.ws + WS_ACT;
    const bf16_t* QUP = (const bf16_t*)(a.ws + WS_QUP); const bf16_t* KVUP = (const bf16_t*)(a.ws + WS_KVUP);
    unsigned* qctr = (unsigned*)(a.ws + WS_CTL) + CW_QUEUE2;
    volatile LAS unsigned* qslot = (volatile LAS unsigned*)(F.lds + LDS_MISC + 64);
    if (F.tid == 0) *qslot = __hip_atomic_fetch_add(qctr, 1u, __ATOMIC_RELAXED, __HIP_MEMORY_SCOPE_AGENT);
    __syncthreads();
    int u = (int)*qslot;
    while (u < 1024) {
        unsigned nxt = 0u;
        if (F.tid == 0) nxt = __hip_atomic_fetch_add(qctr, 1u, __ATOMIC_RELAXED, __HIP_MEMORY_SCOPE_AGENT);
        AttnP p{};
        const int qb = u & 7, head = (u >> 3) & 7, b = u >> 6;
        p.b = b; p.qrow0 = b * SEQ + 256 * qb; p.orow0 = p.qrow0; p.ldo = DM; p.nctx_tiles = 4;
        p.Q = QUP + head * 192; p.ldq = 1536; p.K1 = KVUP + head * 256; p.ldk1 = 2048; p.K2 = Z + 4096; p.ldk2 = OD_INP; p.V = KVUP + head * 256 + 128; p.ldv = 2048;
        p.O = Y + 1024 + head * 128; p.xtile0 = 0; p.nx_tiles = 32; p.sc_log2e = 0.07216878364870323f * 1.4426950408889634f; p.rpb = nullptr; p.qgrow0 = 0;
        const AttnQK8 e{nullptr, 0, a.ws + WS_K8N + head * 128, 1024, a.ws + WS_K8R, 64, a.ws + WS_V8M + head * 128, 1024};
        attn_unit_f8<192, true, false, true>(F, p, e);
        if (F.tid == 0) *qslot = nxt;
        __syncthreads();
        u = (int)*qslot;
    }
    while (u < 2048) {
        unsigned nxt = 0u;
        if (F.tid == 0) nxt = __hip_atomic_fetch_add(qctr, 1u, __ATOMIC_RELAXED, __HIP_MEMORY_SCOPE_AGENT);
        AttnP p{};
        const int v = u - 1024, qb = v & 7, head = (v >> 3) & 7, b = v >> 6;
        p.b = b; p.qrow0 = b * SEQ + 256 * qb; p.orow0 = p.qrow0; p.ldo = DM; p.nctx_tiles = 4;
        p.Q = Z + head * 128; p.ldq = OD_INP; p.K1 = Z + 1024 + head * 128; p.ldk1 = OD_INP; p.K2 = nullptr; p.ldk2 = 0; p.V = Z + 2048 + head * 128; p.ldv = OD_INP;
        p.O = Y + head * 128; p.sc_log2e = 0.08838834764831845f * 1.4426950408889634f; p.rpb = a.in[I_RPB] + head * 15 * 31; p.qgrow0 = 4 * qb;
        const int rlo = min(max(4 * qb - 4, 0), 24), rhi = min(max(4 * qb + 3 - 4, 0), 24) + 8;
        p.xtile0 = rlo; p.nx_tiles = rhi - rlo;
        const AttnQK8 e{nullptr, 0, a.ws + WS_K8NA + head * 128, 1024, nullptr, 0, a.ws + WS_V8NA + head * 128, 1024};
        attn_unit_f8<128, true, true>(F, p, e);
        if (F.tid == 0) *qslot = nxt;
        __syncthreads();
        u = (int)*qslot;
    }
}

#define CEX(a, b) do { const float _hi = fmaxf(a, b), _lo = fminf(a, b); a = _hi; b = _lo; } while (0)
DI void bitonic_merge16(float (&c)[16]) {
#pragma unroll
    for (int st = 8; st >= 1; st >>= 1)
#pragma unroll
        for (int i = 0; i < 16; ++i) if ((i & st) == 0) CEX(c[i], c[i + st]);
}
DI void sort16_desc(float (&a)[16]) {
#pragma unroll
    for (int k = 2; k <= 16; k <<= 1)
#pragma unroll
        for (int j = k >> 1; j >= 1; j >>= 1)
#pragma unroll
            for (int i = 0; i < 16; ++i) { const int l = i ^ j; if (l > i) { const bool desc = (i & k) == 0;
                const float hi = fmaxf(a[i], a[l]), lo = fminf(a[i], a[l]); a[i] = desc ? hi : lo; a[l] = desc ? lo : hi; } }
}
DI void insert16(float (&a)[16], float x) {
#pragma unroll
    for (int i = 0; i < 16; ++i) { const float hi = fmaxf(a[i], x); x = fminf(a[i], x); a[i] = hi; }
}
struct CandTab { int ci[50], cj[50];
    constexpr CandTab() : ci{}, cj{} { int n = 0; for (int i = 0; i < 16; ++i) for (int j = 0; j < 16; ++j) if ((i + 1) * (j + 1) <= 16) { ci[n] = i; cj[n] = j; ++n; } } };
DI void peer_topk_wave(const Frame& F, const bf16_t* PQ, const LAS unsigned char* keysL  , int tok0, int head, int* eidx, float* gate, LAS unsigned char* scr  ) {
    const int lane = F.lane, r = lane & 31, hh = lane >> 5;
    float top[2][16];
#pragma unroll
    for (int p = 0; p < 2; ++p) {
        f32x16 st[4];
#pragma unroll
        for (int kb = 0; kb < 4; ++kb) for (int i = 0; i < 16; ++i) st[kb][i] = 0.f;
        const bf16_t* qp = PQ + (size_t)(tok0 + r) * DM + head * 256 + p * 128 + 8 * hh;
        const LAS unsigned char* kp = keysL + p * (128 * 272) + r * 272 + 16 * hh;
#pragma unroll 2
        for (int ks = 0; ks < 8; ++ks) {
            const bf16x8 qf = *(const bf16x8*)(qp + 16 * ks);
#pragma unroll
            for (int kb = 0; kb < 4; ++kb) { const bf16x8 kf = *(const LAS bf16x8*)(kp + kb * (32 * 272) + 32 * ks);
                st[kb] = __builtin_amdgcn_mfma_f32_32x32x16_bf16(kf, qf, st[kb], 0, 0, 0); }
        }
        float blk[4][16];
#pragma unroll
        for (int kb = 0; kb < 4; ++kb) {
#pragma unroll
            for (int i = 0; i < 16; ++i) { const unsigned key = 32 * kb + (i & 3) + 8 * (i >> 2) + 4 * hh; blk[kb][i] = __uint_as_float((__float_as_uint(st[kb][i]) & 0xffffff80u) | key); }
            sort16_desc(blk[kb]);
        }
        float m01[16], m23[16], aa[16];
#pragma unroll
        for (int i = 0; i < 16; ++i) { m01[i] = fmaxf(blk[0][i], blk[1][15 - i]); m23[i] = fmaxf(blk[2][i], blk[3][15 - i]); }
        bitonic_merge16(m01); bitonic_merge16(m23);
#pragma unroll
        for (int i = 0; i < 16; ++i) aa[i] = fmaxf(m01[i], m23[15 - i]);
        bitonic_merge16(aa);
        float cc[16];
#pragma unroll
        for (int i = 0; i < 16; ++i) cc[i] = fmaxf(aa[i], __shfl_xor(aa[15 - i], 32));
        bitonic_merge16(cc);
#pragma unroll
        for (int i = 0; i < 16; ++i) top[p][i] = cc[i];
    }
    LAS unsigned char* my = scr + r * 32;
#pragma unroll
    for (int p = 0; p < 2; ++p)
#pragma unroll
        for (int q4 = 0; q4 < 4; ++q4) { unsigned wv = 0;
#pragma unroll
            for (int e = 0; e < 4; ++e) wv |= (__float_as_uint(top[p][4 * q4 + e]) & 0x7fu) << (8 * e);
            *(LAS unsigned*)(my + p * 16 + 4 * q4) = wv; }
    float va[16], vb[16];
#pragma unroll
    for (int i = 0; i < 16; ++i) { va[i] = __uint_as_float(__float_as_uint(top[0][i]) & 0xffffff80u); vb[i] = __uint_as_float(__float_as_uint(top[1][i]) & 0xffffff80u); }
    float cd[16];
#pragma unroll
    for (int i = 0; i < 16; ++i) cd[i] = -3.0e38f;
#pragma unroll
    for (int k = 0; k < 25; ++k) {
        constexpr CandTab T{};
        const int i0 = T.ci[2 * k], j0 = T.cj[2 * k], i1 = T.ci[2 * k + 1], j1 = T.cj[2 * k + 1];
        const float s0 = va[i0] + vb[j0], s1 = va[i1] + vb[j1];
        const float x0 = __uint_as_float((__float_as_uint(s0) & 0xffffff00u) | (unsigned)(i0 * 16 + j0));
        const float x1 = __uint_as_float((__float_as_uint(s1) & 0xffffff00u) | (unsigned)(i1 * 16 + j1));
        insert16(cd, hh ? x1 : x0);
    }
    float cc[16];
#pragma unroll
    for (int i = 0; i < 16; ++i) cc[i] = fmaxf(cd[i], __shfl_xor(cd[15 - i], 32));
    bitonic_merge16(cc);
    float sv[16]; float den = 0.f;
    const float mx = __uint_as_float(__float_as_uint(cc[0]) & 0xffffff00u);
#pragma unroll
    for (int i = 0; i < 16; ++i) { sv[i] = __expf(__uint_as_float(__float_as_uint(cc[i]) & 0xffffff00u) - mx); den += sv[i]; }
    const float iden = 1.f / den;
    asm volatile("s_waitcnt lgkmcnt(0)" ::: "memory");
    if (hh == 0) {
        int* ep = eidx + (size_t)(tok0 + r) * 128 + head * 16; float* gp = gate + (size_t)(tok0 + r) * 128 + head * 16;
#pragma unroll
        for (int q4 = 0; q4 < 4; ++q4) { int ev[4]; float gv[4];
#pragma unroll
            for (int e = 0; e < 4; ++e) { const unsigned code = __float_as_uint(cc[4 * q4 + e]) & 0xffu; const unsigned ia = my[code >> 4], ib = my[16 + (code & 15u)];
                ev[e] = (int)(ia * 128u + ib); gv[e] = sv[4 * q4 + e] * iden; }
            *(int4*)(ep + 4 * q4) = make_int4(ev[0], ev[1], ev[2], ev[3]); *(f32x4*)(gp + 4 * q4) = (f32x4){gv[0], gv[1], gv[2], gv[3]}; }
    }
}
DI void peer_topk_phase(const Frame& F, const Args& a, int layer, int ntok) {
    const bf16_t* PQ = (const bf16_t*)(a.ws + WS_PQ); const int head = F.wg & 7;
    const bf16_t* keys = (const bf16_t*)(a.ws + WS_KEYS) + ((size_t)layer * 8 + head) * 2 * 128 * 128;
    int* eidx = (int*)(a.ws + WS_EIDX); float* gate = (float*)(a.ws + WS_GATE);
    LAS unsigned char* keysL = F.lds; LAS unsigned char* scr = F.lds + 2 * 128 * 272 + F.wave * 2048;
    for (int c = F.tid; c < 2 * 128 * 16; c += 512) { const int row = c >> 4, ch = c & 15; *(LAS u32x4*)(keysL + row * 272 + 16 * ch) = *(const u32x4*)(keys + (size_t)row * 128 + 8 * ch); }
    __syncthreads();
    const int nblk = ntok / 256;
    for (int blk = F.wg >> 3; blk < nblk; blk += F.G >> 3) peer_topk_wave(F, PQ, keysL, 256 * blk + 32 * F.wave, head, eidx, gate, scr);
    __syncthreads();
}

typedef __bf16 bf16p __attribute__((ext_vector_type(2)));
DI float fp6_dot32(const u32x6 r, const unsigned (&xw)[16]) {
    const bf16x32v d = __builtin_amdgcn_cvt_scalef32_pk32_bf16_fp6(r, 1.0f);
    float d0 = 0.f, d1 = 0.f;
#pragma unroll
    for (int i = 0; i < 8; ++i) {
        const bf16p lo = {d[4 * i], d[4 * i + 1]}, hi = {d[4 * i + 2], d[4 * i + 3]};
        d0 = __builtin_amdgcn_fdot2_f32_bf16(lo, __builtin_bit_cast(bf16p, xw[2 * i]), d0, false);
        d1 = __builtin_amdgcn_fdot2_f32_bf16(hi, __builtin_bit_cast(bf16p, xw[2 * i + 1]), d1, false);
    }
    return d0 + d1;
}
DI void fp6_axpy32(const u32x6 r, float w, f32x2 (&acc)[16]) {
    const f32x32v d = __builtin_amdgcn_cvt_scalef32_pk32_f32_fp6(r, 1.0f);
    const f32x2 w2 = {w, w};
#pragma unroll
    for (int i = 0; i < 16; ++i) { const f32x2 v2 = {d[2 * i], d[2 * i + 1]}; acc[i] = __builtin_elementwise_fma(w2, v2, acc[i]); }
}
typedef _Float16 h16x2 __attribute__((ext_vector_type(2)));
typedef _Float16 h16x32 __attribute__((ext_vector_type(32)));
constexpr float VW_SC = 64.f;
DI void fp6_axpy32_h(const u32x6 r, float w, h16x2 (&acc)[16]) {
    const h16x32 d = __builtin_amdgcn_cvt_scalef32_pk32_f16_fp6(r, 1.0f);
    const _Float16 wh = (_Float16)w; const h16x2 w2 = {wh, wh};
#pragma unroll
    for (int i = 0; i < 16; ++i) { const h16x2 v2 = {d[2 * i], d[2 * i + 1]}; acc[i] = __builtin_elementwise_fma(w2, v2, acc[i]); }
}
DI unsigned h2add(unsigned a, unsigned b) { const h16x2 r = __builtin_bit_cast(h16x2, a) + __builtin_bit_cast(h16x2, b); return __builtin_bit_cast(unsigned, r); }
DI u32x6 ld_row24(const unsigned char* p) { const u32x4 a = *(const u32x4*)p; const u32x2 b = *(const u32x2*)(p + 16); return (u32x6){a.x, a.y, a.z, a.w, b.x, b.y}; }
template <bool FINAL>
DI void peer_gather_phase(const Frame& F, const Args& a, int layer, int ntok) {
    const bf16_t* Fa = (const bf16_t*)(a.ws + WS_ACT); const unsigned char* U = a.ws + WS_U; const unsigned char* V = a.ws + WS_V;
    const float* SU = (const float*)(a.ws + WS_SU); const float* SV = (const float*)(a.ws + WS_SV);
    const int* eidx = (const int*)(a.ws + WS_EIDX); const float* gate = (const float*)(a.ws + WS_GATE);
    bf16_t* H = (bf16_t*)(a.ws + WS_H); float* HP = (float*)(a.ws + WS_HP);
    const float* modx = (const float*)(a.ws + WS_MODX) + (size_t)layer * 16 * 12288; const float* modc = (const float*)(a.ws + WS_MODC) + (size_t)layer * 12288;
    const int lane = F.lane, g8 = lane >> 3, p8 = lane & 7;
    LAS float* hpL = (LAS float*)(F.lds + F.wave * 13824); LAS unsigned short* eiL = (LAS unsigned short*)(F.lds + F.wave * 13824 + 18 * 512);
#pragma unroll 1
    for (int s = 0; s < 8; ++s) {
        const unsigned char* Us = U + (size_t)s * 16384 * SLB; const unsigned lo8 = 24u * (unsigned)p8;
#pragma unroll 1
        for (int tok = F.gw, kt = 0; tok < ntok; tok += F.ngw, ++kt) {
            unsigned xw[16];
            { const bf16_t* xp = Fa + (size_t)tok * DM + 256 * s + 32 * p8;
              const u32x4 x0 = *(const u32x4*)xp, x1 = *(const u32x4*)(xp + 8), x2 = *(const u32x4*)(xp + 16), x3 = *(const u32x4*)(xp + 24);
              xw[0] = x0.x; xw[1] = x0.y; xw[2] = x0.z; xw[3] = x0.w; xw[4] = x1.x; xw[5] = x1.y; xw[6] = x1.z; xw[7] = x1.w;
              xw[8] = x2.x; xw[9] = x2.y; xw[10] = x2.z; xw[11] = x2.w; xw[12] = x3.x; xw[13] = x3.y; xw[14] = x3.z; xw[15] = x3.w; }
            if (s == 0) { const int tp = 8 * (lane & 7) + (lane >> 3);
                eiL[kt * 128 + tp] = (unsigned short)eidx[(size_t)tok * 128 + lane]; eiL[kt * 128 + 64 + tp] = (unsigned short)eidx[(size_t)tok * 128 + 64 + lane]; }
            float hs[2] = {0.f, 0.f};
#pragma unroll
            for (int half = 0; half < 2; ++half) {
                u32x6 ra[8];
                const u32x4 ew = *(const LAS u32x4*)(eiL + kt * 128 + 64 * half + 8 * g8);
#pragma unroll
                for (int i = 0; i < 8; ++i) { const unsigned e = (i & 1) ? (ew[i >> 1] >> 16) : (ew[i >> 1] & 0xffffu); ra[i] = ld_row24(Us + (e * (unsigned)SLB + lo8)); }
                float d8[8];
#pragma unroll
                for (int i = 0; i < 8; ++i) d8[i] = fp6_dot32(ra[i], xw);
                float b4[4], c2[2];
                { const bool bit = (lane & 4) != 0;
#pragma unroll
                  for (int k = 0; k < 4; ++k) { const float kp = bit ? d8[4 + k] : d8[k], snd = bit ? d8[k] : d8[4 + k]; b4[k] = kp + __shfl_xor(snd, 4); } }
                { const bool bit = (lane & 2) != 0;
#pragma unroll
                  for (int k = 0; k < 2; ++k) { const float kp = bit ? b4[2 + k] : b4[k], snd = bit ? b4[k] : b4[2 + k]; c2[k] = kp + __shfl_xor(snd, 2); } }
                { const bool bit = (lane & 1) != 0; const float kp = bit ? c2[1] : c2[0], snd = bit ? c2[0] : c2[1]; hs[half] = kp + __shfl_xor(snd, 1); }
            }
            LAS float* hp = hpL + kt * 128 + lane;
            if (s > 0) { hs[0] += hp[0]; hs[1] += hp[64]; }
            hp[0] = hs[0]; hp[64] = hs[1];
        }
    }
#pragma unroll 1
    for (int s = 0; s < 8; ++s) {
        const unsigned char* Vs = V + (size_t)s * 16384 * SLB; const unsigned lo8 = 24u * (unsigned)p8;
#pragma unroll 1
        for (int tok = F.gw, kt = 0; tok < ntok; tok += F.ngw, ++kt) {
            LAS float* hp = hpL + kt * 128;
            if (s == 0) { const int e0 = eiL[kt * 128 + lane], e1 = eiL[kt * 128 + 64 + lane]; const int pp = 8 * (lane & 7) + (lane >> 3);
                hp[lane] = gate[(size_t)tok * 128 + pp] * gelu_tanh(hp[lane] * SU[e0]) * (SV[e0] * VW_SC); hp[64 + lane] = gate[(size_t)tok * 128 + 64 + pp] * gelu_tanh(hp[64 + lane] * SU[e1]) * (SV[e1] * VW_SC); }
            h16x2 acc[16];
#pragma unroll
            for (int i = 0; i < 16; ++i) acc[i] = (h16x2){(_Float16)0.f, (_Float16)0.f};
#pragma unroll
            for (int half = 0; half < 2; ++half) {
                u32x6 ra[8]; float wj[8];
                const u32x4 ew = *(const LAS u32x4*)(eiL + kt * 128 + 64 * half + 8 * g8);
                const f32x4 wa = *(const LAS f32x4*)(hp + 64 * half + 8 * g8), wb = *(const LAS f32x4*)(hp + 64 * half + 8 * g8 + 4);
#pragma unroll
                for (int i = 0; i < 8; ++i) { const unsigned e = (i & 1) ? (ew[i >> 1] >> 16) : (ew[i >> 1] & 0xffffu); wj[i] = (i < 4) ? wa[i & 3] : wb[i & 3]; ra[i] = ld_row24(Vs + (e * (unsigned)SLB + lo8)); }
#pragma unroll
                for (int i = 0; i < 8; ++i) fp6_axpy32_h(ra[i], wj[i], acc);
            }
            unsigned P[16], Q[8], R[4], T[2]; f32x4 r4;
#pragma unroll
            for (int k = 0; k < 16; ++k) P[k] = __builtin_bit_cast(unsigned, acc[k]);
            { const bool bit = (lane & 32) != 0;
#pragma unroll
              for (int k = 0; k < 8; ++k) { const unsigned snd = bit ? P[k] : P[8 + k], kp = bit ? P[8 + k] : P[k]; Q[k] = h2add(kp, (unsigned)__shfl_xor((int)snd, 32)); } }
            { const bool bit = (lane & 16) != 0;
#pragma unroll
              for (int k = 0; k < 4; ++k) { const unsigned snd = bit ? Q[k] : Q[4 + k], kp = bit ? Q[4 + k] : Q[k]; R[k] = h2add(kp, (unsigned)__shfl_xor((int)snd, 16)); } }
            { const bool bit = (lane & 8) != 0;
#pragma unroll
              for (int k = 0; k < 2; ++k) { const unsigned snd = bit ? R[k] : R[2 + k], kp = bit ? R[2 + k] : R[k]; T[k] = h2add(kp, (unsigned)__shfl_xor((int)snd, 8)); } }
            { const h16x2 t0 = __builtin_bit_cast(h16x2, T[0]), t1 = __builtin_bit_cast(h16x2, T[1]);
              r4 = (f32x4){(float)t0[0], (float)t0[1], (float)t1[0], (float)t1[1]} * (1.f / VW_SC); }
            const float* g5 = ((tok < MXR) ? (modx + (size_t)(tok >> 11) * 12288) : modc) + 5 * DM;
            const int col = 256 * s + 32 * p8 + 4 * g8;
            bf16_t* hrow = H + (size_t)tok * DM;
            const u32x2 hb = *(const u32x2*)(hrow + col); const f32x4 h4 = {bflo(hb.x), bfhi(hb.x), bflo(hb.y), bfhi(hb.y)}, gg = *(const f32x4*)(g5 + col);
            { const f32x4 y4 = h4 + gg * r4; u32x2 ob; ob.x = pk2(y4[0], y4[1]); ob.y = pk2(y4[2], y4[3]); *(u32x2*)(hrow + col) = ob; }
            if (!FINAL && s == 7) {
                asm volatile("s_waitcnt vmcnt(0)" ::: "memory");
                f32x4 v[8]; float ss = 0.f;
#pragma unroll
                for (int j = 0; j < 8; ++j) { const u32x2 hb2 = *(const u32x2*)(hrow + 4 * (lane + 64 * j)); v[j] = (f32x4){bflo(hb2.x), bfhi(hb2.x), bflo(hb2.y), bfhi(hb2.y)}; ss += v[j][0] * v[j][0] + v[j][1] * v[j][1] + v[j][2] * v[j][2] + v[j][3] * v[j][3]; }
                const float rs = __frsqrt_rn(wave_sum(ss) * (1.f / DM) + EPS);
                const float* nw = a.in[I_N1W] + (size_t)(layer + 1) * DM;
                const float* mod1 = (tok < MXR) ? ((const float*)(a.ws + WS_MODX) + ((size_t)(layer + 1) * 16 + (tok >> 11)) * 12288) : ((const float*)(a.ws + WS_MODC) + (size_t)(layer + 1) * 12288);
                bf16_t* ao = (bf16_t*)(a.ws + WS_ACT) + (size_t)tok * DM;
#pragma unroll
                for (int j = 0; j < 8; ++j) { const int cc = 4 * (lane + 64 * j); const f32x4 w4 = *(const f32x4*)(nw + cc), sh = *(const f32x4*)(mod1 + cc), sc4 = *(const f32x4*)(mod1 + DM + cc);
                    f32x4 y;
#pragma unroll
                    for (int e = 0; e < 4; ++e) y[e] = (v[j][e] * rs * w4[e]) * (1.f + sc4[e]) + sh[e];
                    *(int*)((unsigned char*)(a.ws + WS_A8) + (size_t)tok * DM + cc) = pk4_fp8(y[0] * FP8_ASC, y[1] * FP8_ASC, y[2] * FP8_ASC, y[3] * FP8_ASC); }
            }
            if (FINAL && s == 7) {
                asm volatile("s_waitcnt vmcnt(0)" ::: "memory");
                f32x4 v[8]; float ss = 0.f;
#pragma unroll
                for (int j = 0; j < 8; ++j) { const u32x2 hb2 = *(const u32x2*)(hrow + 4 * (lane + 64 * j)); v[j] = (f32x4){bflo(hb2.x), bfhi(hb2.x), bflo(hb2.y), bfhi(hb2.y)}; ss += v[j][0] * v[j][0] + v[j][1] * v[j][1] + v[j][2] * v[j][2] + v[j][3] * v[j][3]; }
                const float rs = __frsqrt_rn(wave_sum(ss) * (1.f / DM) + EPS);
                const float* fw = a.in[I_FNW]; float* op = a.out + (size_t)tok * DM;
#pragma unroll
                for (int j = 0; j < 8; ++j) { const int cc = 4 * (lane + 64 * j); const f32x4 w4 = *(const f32x4*)(fw + cc);
                    f32x4 ov = v[j] * rs * w4;
#if DBG_SANITIZE
                    for (int e = 0; e < 4; ++e) if (!(fabsf(ov[e]) < 1e30f)) ov[e] = 1.0e4f;
#endif
                    *(f32x4*)(op + cc) = ov; }
            }
        }
    }
}

__global__ void __launch_bounds__(512, 2) fwd_kernel(Args args) {
    extern __shared__ __attribute__((aligned(16))) unsigned char lds_raw[];
    Frame F;
    F.lds = (LAS unsigned char*)lds_raw;
    F.tid = threadIdx.x; F.lane = F.tid & 63; F.wave = __builtin_amdgcn_readfirstlane(F.tid >> 6);
    F.G = gridDim.x; F.wg = blockIdx.x; F.gw = F.wg * 8 + F.wave; F.ngw = F.G * 8;
    volatile LAS unsigned* MISC = (volatile LAS unsigned*)(F.lds + LDS_MISC);
    if (F.tid < 4) MISC[F.tid] = 0u;
    __syncthreads();
    unsigned char* ws = args.ws;
    const int lo = args.ph_lo, hi = args.ph_hi;
    XcdBarrier bar; bar.bar = (unsigned*)(ws + WS_CTL) + CW_BAR; bar.x = 0; bar.st = nullptr;
    if (hi - lo > 1) bar = xcd_barrier_post((unsigned*)(ws + WS_CTL) + CW_BAR, MISC);
#ifndef PH_MASK
#define PH_MASK 0xffffffffu
#endif
#define IN(k) ((((PH_MASK) >> (k)) & 1u) && lo <= (k) && (k) < hi)
#define SEAM(k) do { if (IN(k) && IN((k) + 1)) xcd_barrier(bar); } while (0)
    const float* modx = (const float*)(ws + WS_MODX); const float* modc = (const float*)(ws + WS_MODC);
    bf16_t* ACT = (bf16_t*)(ws + WS_ACT); bf16_t* H = (bf16_t*)(ws + WS_H); bf16_t* Z = (bf16_t*)(ws + WS_Z);

#define REP2(k) if (((DBG_REPMASK) >> (k)) & 1u)
#define P0_BODY  { prologue(F, args); }
#define P1_BODY  { norm_mod_phase<false, true>(F, args.in[I_X], args.in[I_CTX], args.in[I_N1W], modx, modc, 0, ACT, MT); }
#define P2_BODY  { pg8::Gemm g{ACT, (const bf16_t*)(ws + WS_WIN0), MT, EV_IN, DM / 2, DM / 2, DM / 2}; pg8::StaticOrder S; S.init(MT, EV_IN, F.G, F.wg); \
        pg8::EpiBf16 E{Z, EV_IN, 1.f / (FP8_WSC * FP8_ASC)}; pg8::gemm_phase<pg8::EpiBf16, true>(F.lds, g, S, E); }
#define P3_BODY  { gqa_prep_phase(F, args); }
#define P4_BODY  { mixer0_phase(F, args); }
#define P5_BODY  { hgrn_readout_phase(F, args); }
#define P6_BODY  { pg8::Gemm g{ACT, (const bf16_t*)(ws + WS_WOUT0), MT, DM, DM / 2, DM / 2, DM / 2}; pg8::StaticOrder S; S.init(MT, DM, F.G, F.wg); \
        pg8::EpiResid<false> E{H, args.in[I_X], args.in[I_CTX], modx + 2 * DM, modc + 2 * DM, 12288, 1.f / (FP8_WSC * FP8_ASC)}; pg8::gemm_phase<pg8::EpiResid<false>, true>(F.lds, g, S, E); }
#define P7_BODY  { norm_mod_phase<true>(F, H, H + (size_t)MXR * DM, args.in[I_N2W], modx, modc, 3, ACT, MT); }
#define P8_BODY  { pg8::Gemm g{ACT, (const bf16_t*)(ws + WS_WPQ), MT, DM, DM, DM, DM}; pg8::StaticOrder S; S.init(MT, DM, F.G, F.wg); \
        pg8::EpiBf16 E{(bf16_t*)(ws + WS_PQ), DM}; pg8::gemm_phase(F.lds, g, S, E); }
#define P9_BODY  { peer_topk_phase(F, args, 0, MT); }
#define P10_BODY { peer_gather_phase<false>(F, args, 0, MT); }
#define P11_BODY { }
#define P12_BODY { pg8::Gemm g{(const bf16_t*)(ws + WS_A8), (const bf16_t*)(ws + WS_WIN1), MT, OD_INP, DM / 2, DM / 2, DM / 2}; pg8::StaticOrder S; S.init(MT, OD_INP, F.G, F.wg); \
        pg8::EpiZ1 E{Z, OD_INP, 1.f / (FP8_WSC * FP8_ASC), ws + WS_K8NA, QK8_SC / (FP8_WSC * FP8_ASC), ws + WS_V8NA}; pg8::gemm_phase<pg8::EpiZ1, true>(F.lds, g, S, E); }
#define P13_BODY { mla_prep_phase(F, args); }
#define P14_BODY { \
        { pg8::Gemm g{ACT, (const bf16_t*)(ws + WS_WQUP), MXR, 1536, 256, 256, 256}; pg8::StaticOrder S; S.init(MXR, 1536, F.G, F.wg); \
          pg8::EpiBf16 E{(bf16_t*)(ws + WS_QUP), 1536, 1.f / (FP8_WSC2 * FP8_ASC)}; pg8::gemm_phase<pg8::EpiBf16, true>(F.lds, g, S, E); } \
        { pg8::Gemm g{(const bf16_t*)(ws + WS_ACT + (size_t)MT * 512), (const bf16_t*)(ws + WS_WKVUP), MT, 2048, 256, 256, 256}; pg8::StaticOrder S; S.init(MT, 2048, F.G, F.wg); \
          pg8::EpiKV8 E{ws + WS_V8M, 1.f / (FP8_WSC2 * FP8_ASC), ws + WS_K8N, QK8_SC / (FP8_WSC2 * FP8_ASC)}; pg8::gemm_phase<pg8::EpiKV8, true>(F.lds, g, S, E); } }
#define P15_BODY { }
#define P16_BODY { mixer1_phase(F, args); }
#define P17_BODY { pg8::Gemm g{ACT, (const bf16_t*)(ws + WS_WOUT1), MXR, DM, DM / 2, DM / 2, DM / 2}; pg8::StaticOrder S; S.init(MXR, DM, F.G, F.wg); \
        pg8::EpiResid<true> E{H, H, H, modx + (size_t)16 * 12288 + 2 * DM, modc + 12288 + 2 * DM, 12288, 1.f / (FP8_WSC * FP8_ASC)}; pg8::gemm_phase<pg8::EpiResid<true>, true>(F.lds, g, S, E); }
#define P18_BODY { norm_mod_phase<true>(F, H, H, args.in[I_N2W] + DM, modx + (size_t)16 * 12288, modc + 12288, 3, ACT, MXR); \
        cvt_fp6_rows(F, args.in[I_PU] + (size_t)16384 * 2048, ws + WS_U, (float*)(ws + WS_SU), 16384); \
        cvt_fp6_rows(F, args.in[I_PV] + (size_t)16384 * 2048, ws + WS_V, (float*)(ws + WS_SV), 16384); }
#define P19_BODY { pg8::Gemm g{ACT, (const bf16_t*)(ws + WS_WPQ) + (size_t)2048 * 2048, MXR, DM, DM, DM, DM}; pg8::StaticOrder S; S.init(MXR, DM, F.G, F.wg); \
        pg8::EpiBf16 E{(bf16_t*)(ws + WS_PQ), DM}; pg8::gemm_phase(F.lds, g, S, E); }
#define P20_BODY { peer_topk_phase(F, args, 1, MXR); }
#define P21_BODY { peer_gather_phase<true>(F, args, 1, MXR); }
#define PHASE(k, BODY) if (IN(k)) { BODY REP2(k) BODY }
    PHASE(0, P0_BODY) SEAM(0);
    PHASE(1, P1_BODY) SEAM(1);
    PHASE(2, P2_BODY) SEAM(2);
    PHASE(3, P3_BODY) SEAM(3);
    PHASE(4, P4_BODY) SEAM(4);
    PHASE(5, P5_BODY) SEAM(5);
    PHASE(6, P6_BODY) SEAM(6);
    PHASE(7, P7_BODY) SEAM(7);
    PHASE(8, P8_BODY) SEAM(8);
    PHASE(9, P9_BODY) SEAM(9);
    PHASE(10, P10_BODY)
    PHASE(11, P11_BODY) SEAM(11);
    PHASE(12, P12_BODY) SEAM(12);
    PHASE(13, P13_BODY) SEAM(13);
    PHASE(14, P14_BODY)
    PHASE(15, P15_BODY) SEAM(15);
    PHASE(16, P16_BODY) SEAM(16);
    PHASE(17, P17_BODY) SEAM(17);
    PHASE(18, P18_BODY) SEAM(18);
    PHASE(19, P19_BODY) SEAM(19);
    PHASE(20, P20_BODY) SEAM(20);
    PHASE(21, P21_BODY)
#undef IN
#undef SEAM
}

extern "C" void kernel_launch(void* const* d_in, const int* in_sizes, int n_in, void* d_out, int out_size, void* d_ws, size_t ws_size, hipStream_t stream) {
    static int grid = 0;
    if (grid == 0) {
        if (n_in != N_IN || ws_size < WS_END) { fprintf(stderr, "kernel_launch: unexpected n_in %d or ws_size %zu (< %zu)\n", n_in, ws_size, (size_t)WS_END); grid = -1; return; }
        int dev = 0, cus = 0, per_cu = 0;
        if (hipGetDevice(&dev) != hipSuccess || hipDeviceGetAttribute(&cus, hipDeviceAttributeMultiprocessorCount, dev) != hipSuccess) { grid = -1; return; }
        if (hipFuncSetAttribute((const void*)fwd_kernel, hipFuncAttributeMaxDynamicSharedMemorySize, LDS_BYTES) != hipSuccess) { fprintf(stderr, "kernel_launch: hipFuncSetAttribute failed\n"); grid = -1; return; }
        if (hipOccupancyMaxActiveBlocksPerMultiprocessor(&per_cu, (const void*)fwd_kernel, 512, LDS_BYTES) != hipSuccess || per_cu < 1) { fprintf(stderr, "kernel_launch: occupancy query says %d\n", per_cu); }
        (void)hipGetLastError();
        if (cus < 256) { fprintf(stderr, "kernel_launch: this build is laid out for 256 CUs (MI355X); found %d\n", cus); grid = -1; return; }
        grid = 256;
    }
    if (grid < 0) return;
    (void)hipMemsetAsync((char*)d_ws + WS_CTL, 0, CTL_ZERO_BYTES, stream);
    Args a{};
    for (int i = 0; i < N_IN; ++i) a.in[i] = (const float*)d_in[i];
    a.out = (float*)d_out; a.ws = (unsigned char*)d_ws;
#if MK_N_LAUNCHES == 1
    a.ph_lo = 0; a.ph_hi = NPHASE;
    hipLaunchKernelGGL(fwd_kernel, dim3(grid), dim3(512), LDS_BYTES, stream, a);
#else
    for (int ph = 0; ph < NPHASE; ++ph) { a.ph_lo = ph; a.ph_hi = ph + 1; hipLaunchKernelGGL(fwd_kernel, dim3(grid), dim3(512), LDS_BYTES, stream, a); }
#endif
}
```

```cpp
#include <hip/hip_runtime.h>
#include <cstdio>
#include <cstdint>

#define DBG_SANITIZE 0
#ifndef DBG_REPMASK
#define DBG_REPMASK 0u
#endif
#ifndef MK_N_LAUNCHES
#define MK_N_LAUNCHES 1
#endif

#define DI __device__ __forceinline__
#define LAS __attribute__((address_space(3)))
typedef unsigned short bf16_t;
typedef short bf16x8 __attribute__((ext_vector_type(8)));
typedef short s16x4 __attribute__((ext_vector_type(4)));
typedef float f32x4 __attribute__((ext_vector_type(4)));
typedef float f32x16 __attribute__((ext_vector_type(16)));
typedef unsigned u32x4 __attribute__((ext_vector_type(4)));
typedef unsigned u32x2 __attribute__((ext_vector_type(2)));

constexpr int DM = 2048, NBATCH = 16, SEQ = 2048, CTXL = 256;
constexpr int MXR = NBATCH * SEQ;
constexpr int MCR = NBATCH * CTXL;
constexpr int MT = MXR + MCR;
constexpr int EV_IN = 6656, OD_IN = 4160, OD_INP = 4352;
constexpr float EPS = 1e-6f;
constexpr int NPHASE = 22;

constexpr size_t MiB = 1u << 20;
constexpr size_t WS_CTL = 0, CTL_ZERO_BYTES = 1 * MiB;
constexpr size_t WS_MODX = 1 * MiB;
constexpr size_t WS_MODC = WS_MODX + (size_t)2 * 16 * 12288 * 4;
constexpr size_t WS_WIN0 = 4 * MiB;
constexpr size_t WS_WOUT0 = 30 * MiB;
constexpr size_t WS_WIN1 = 38 * MiB;
constexpr size_t WS_WOUT1 = 55 * MiB;
constexpr size_t WS_WQUP = 63 * MiB;
constexpr size_t WS_WKVUP = 65 * MiB;
constexpr size_t WS_WPQ = 67 * MiB;
constexpr size_t WS_KEYS = 83 * MiB;
constexpr size_t WS_U = 84 * MiB, WS_V = 148 * MiB;
constexpr size_t WS_SU = 3 * MiB, WS_SV = 3 * MiB + 65536;
constexpr size_t WS_QUP = 84 * MiB;
constexpr size_t WS_ACT = 212 * MiB;
constexpr size_t WS_H = 356 * MiB;
constexpr size_t WS_OF = 356 * MiB, WS_OB = 428 * MiB;
constexpr size_t WS_A8 = 500 * MiB;
constexpr size_t WS_Q8 = 500 * MiB, WS_K8 = 540 * MiB;
constexpr size_t WS_K8N = 500 * MiB, WS_K8R = 540 * MiB;
constexpr size_t WS_K8NA = 572 * MiB;
constexpr size_t WS_V8G = 552 * MiB, WS_V8NA = 608 * MiB, WS_V8M = 950 * MiB;
constexpr float QK8_SC = 16.f;
constexpr size_t WS_Z = 644 * MiB;
constexpr size_t WS_PQ = 644 * MiB;
constexpr size_t WS_EIDX = 788 * MiB, WS_GATE = 806 * MiB;
constexpr size_t WS_HP = 824 * MiB;
constexpr size_t WS_KVUP = 950 * MiB;
constexpr size_t WS_END = 1112 * MiB;
constexpr int CW_BAR = 4096;
constexpr int CW_QUEUE2 = 8192 + 64;
constexpr int CW_QUEUE = 8192;

constexpr int LDS_BYTES = 147456;
constexpr int LDS_MISC = 131072 + 1024;

typedef __bf16 bf16v2 __attribute__((ext_vector_type(2)));
typedef float f32x2 __attribute__((ext_vector_type(2)));
DI unsigned pk2(float lo, float hi) { const f32x2 v = {lo, hi}; return __builtin_bit_cast(unsigned, __builtin_convertvector(v, bf16v2)); }
DI float bflo(unsigned u) { return __uint_as_float(u << 16); }
DI float bfhi(unsigned u) { return __uint_as_float(u & 0xffff0000u); }
DI int pk4_fp8(float a, float b, float c, float d) { int p = __builtin_amdgcn_cvt_pk_fp8_f32(fminf(fmaxf(a, -448.f), 448.f), fminf(fmaxf(b, -448.f), 448.f), 0, false);
    return __builtin_amdgcn_cvt_pk_fp8_f32(fminf(fmaxf(c, -448.f), 448.f), fminf(fmaxf(d, -448.f), 448.f), p, true); }
DI float wave_sum(float v) {
#pragma unroll
    for (int o = 1; o < 64; o <<= 1) v += __shfl_xor(v, o);
    return v;
}
DI float silu_f(float x) { return x / (1.f + __expf(-x)); }
DI float gelu_tanh(float x) { const float u = 0.7978845608028654f * (x + 0.044715f * x * x * x); const float e = __expf(2.f * u); const float t = 1.f - 2.f / (e + 1.f); return 0.5f * x * (1.f + t); }

#define XB_TMO      128
#define XB_XCNT(j)  (256  + 64 * (j))
#define XB_XSUB(j)  (1280 + 64 * (j))
#define XB_XGEN(j)  (2304 + 64 * (j))
#define XB_TOP      3328
#define XB_TOPGEN   3392
#define XCD_BAR_WORDS 3456
#define XB_SPIN_CAP (1u << 20)
DI unsigned xb_ld(unsigned* p)              { return __hip_atomic_load(p, __ATOMIC_RELAXED, __HIP_MEMORY_SCOPE_AGENT); }
DI unsigned xb_add(unsigned* p, unsigned v) { return __hip_atomic_fetch_add(p, v, __ATOMIC_RELAXED, __HIP_MEMORY_SCOPE_AGENT); }
DI unsigned xb_xcc_id() { return (unsigned)__builtin_amdgcn_s_getreg((3 << 11) | 20) & 0xFu; }
#define XB_SPIN(cond, bar) do { unsigned _sp = 0; while (cond) { __builtin_amdgcn_s_sleep(1); \
    if ((++_sp & 255u) == 0u) { if (xb_ld(&(bar)[XB_TMO])) break; if (_sp > XB_SPIN_CAP) { atomicAdd(&(bar)[XB_TMO], 1u); break; } } } } while (0)
struct XcdBarrier { unsigned* bar; unsigned x; volatile LAS unsigned* st; };
DI XcdBarrier xcd_barrier_post(unsigned* bar, volatile LAS unsigned* st) {
    XcdBarrier b; b.bar = bar; b.x = xb_xcc_id(); b.st = st;
    if (threadIdx.x == 0) (void)xb_add(&bar[XB_XCNT(b.x)], 1u);
    return b;
}
DI void xcd_barrier_complete(unsigned* bar, unsigned x, unsigned& nloc, unsigned& nx) {
    const unsigned G = gridDim.x * gridDim.y * gridDim.z;
    unsigned sum, cnt, mine, sp = 0u;
    for (;;) {
        sum = 0u; cnt = 0u; mine = 0u;
#pragma unroll
        for (unsigned j = 0; j < 16; ++j) { const unsigned c = xb_ld(&bar[XB_XCNT(j)]); sum += c; cnt += (c > 0u) ? 1u : 0u; mine = (j == x) ? c : mine; }
        if (sum == G) break;
        __builtin_amdgcn_s_sleep(1);
        if ((++sp & 255u) == 0u) { if (xb_ld(&bar[XB_TMO])) break; if (sp > XB_SPIN_CAP) { atomicAdd(&bar[XB_TMO], 1u); break; } }
    }
    nloc = mine > 0u ? mine : 1u; nx = cnt > 0u ? cnt : 1u;
}
DI void xcd_barrier(const XcdBarrier& b) {
    asm volatile("s_waitcnt vmcnt(0)" ::: "memory");
    __syncthreads();
    if (threadIdx.x == 0) {
        unsigned* bar = b.bar;
        __builtin_amdgcn_s_waitcnt(0);
        unsigned nloc = b.st[0], nx = b.st[1];
        if (nloc == 0u) { xcd_barrier_complete(bar, b.x, nloc, nx); b.st[0] = nloc; b.st[1] = nx; }
        const unsigned old = xb_add(&bar[XB_XSUB(b.x)], 1u);
        const unsigned gen = old / nloc;
        if (old + 1u == (gen + 1u) * nloc) {
            __builtin_amdgcn_fence(__ATOMIC_RELEASE, "agent");
            asm volatile("s_waitcnt vmcnt(0)" ::: "memory");
            const unsigned og = xb_add(&bar[XB_TOP], 1u);
            const unsigned tg = og / nx;
            if (og + 1u == (tg + 1u) * nx) xb_add(&bar[XB_TOPGEN], 1u);
            else XB_SPIN(xb_ld(&bar[XB_TOPGEN]) == tg, bar);
            __builtin_amdgcn_fence(__ATOMIC_ACQUIRE, "agent");
            xb_add(&bar[XB_XGEN(b.x)], 1u);
            asm volatile("s_waitcnt vmcnt(0)" ::: "memory");
        } else {
            XB_SPIN(xb_ld(&bar[XB_XGEN(b.x)]) == gen, bar);
            __builtin_amdgcn_fence(__ATOMIC_ACQUIRE, "agent");
            asm volatile("s_waitcnt vmcnt(0)" ::: "memory");
        }
    }
    __syncthreads();
}

namespace pg8 {
constexpr int BM = 256, BK = 64, HALF = 128, HTB = HALF * BK * 2, STAGE_BYTES = 8 * HTB, NXCD = 8, WGM = 8;
__host__ __device__ __forceinline__ int lds_byte(int r, int c) { const int st = (r >> 4) * 2 + (c >> 5), rr = r & 15, cc = c & 31, ob = rr * 64 + cc * 2; return st * 1024 + (ob ^ (((ob >> 9) & 1) << 5)); }
__host__ __device__ __forceinline__ void stage_rc(int b, int& R, int& C) { const int st = b / 1024, sb = b % 1024, swz = sb ^ (((sb >> 9) & 1) << 5); R = (st >> 1) * 16 + swz / 64; C = (st & 1) * 32 + (swz % 64) / 2; }
__host__ __device__ __forceinline__ int perm32(int rho) { const int n = rho >> 4, i = rho & 15; return 8 * (i >> 2) + 4 * n + (i & 3); }
struct Unit { int pm, pn; };
struct Gemm { const bf16_t* A; const bf16_t* Bt; int M, N, K, lda, ldb; };
struct StaticOrder {
    int nM, nN, nwg, G, c;
    __device__ void init(int M, int N, int G_, int c_) { nM = M / BM; nN = N / BM; nwg = nM * nN; G = G_; c = c_; }
    __device__ bool next(int i, Unit& u) const {
        const long L = (long)i * G + c; if (L >= nwg) return false;
        int wgid = (int)L; { const int q = nwg / NXCD, r = nwg % NXCD, xcd = wgid % NXCD, off = wgid / NXCD; wgid = (xcd < r ? xcd * (q + 1) : r * (q + 1) + (xcd - r) * q) + off; }
        const int nig = WGM * nN, gid = wgid / nig, fm = gid * WGM, gsz = (nM - fm) < WGM ? (nM - fm) : WGM;
        u.pm = fm + ((wgid % nig) % gsz); u.pn = (wgid % nig) / gsz; return true;
    }
};
struct EpiBf16 {
    static constexpr bool PERM = true;
    bf16_t* O; int ldc; float osc = 1.f;
    DI void operator()(const f32x4 (&acc)[2][2][4][2], const Unit& u, int wr, int wc, int fr, int fq) const {
        const int row0 = u.pm * BM + wr * 64 + fr, col0 = u.pn * BM + wc * 32 + 8 * fq;
#pragma unroll
        for (int ai = 0; ai < 2; ++ai)
#pragma unroll
            for (int m = 0; m < 4; ++m) { bf16_t* rowp = O + (size_t)(row0 + ai * HALF + m * 16) * ldc + col0;
#pragma unroll
                for (int bj = 0; bj < 2; ++bj) { const f32x4 v0 = acc[ai][bj][m][0] * osc, v1 = acc[ai][bj][m][1] * osc;
                    u32x4 w; w.x = pk2(v0[0], v0[1]); w.y = pk2(v0[2], v0[3]); w.z = pk2(v1[0], v1[1]); w.w = pk2(v1[2], v1[3]);
                    *(u32x4*)(rowp + bj * HALF) = w; } }
    }
};
struct EpiKV8 {
    static constexpr bool PERM = true;
    unsigned char* V8; float osc; unsigned char* K8; float ksc;
    DI void operator()(const f32x4 (&acc)[2][2][4][2], const Unit& u, int wr, int wc, int fr, int fq) const {
        const int row0 = u.pm * BM + wr * 64 + fr, cin = wc * 32 + 8 * fq;
#pragma unroll
        for (int ai = 0; ai < 2; ++ai)
#pragma unroll
            for (int m = 0; m < 4; ++m) { const size_t row = (size_t)(row0 + ai * HALF + m * 16);
                { const f32x4 v0 = acc[ai][0][m][0] * ksc, v1 = acc[ai][0][m][1] * ksc;
                  u32x2 w; w.x = (unsigned)pk4_fp8(v0[0], v0[1], v0[2], v0[3]); w.y = (unsigned)pk4_fp8(v1[0], v1[1], v1[2], v1[3]);
                  *(u32x2*)(K8 + row * 1024 + u.pn * 128 + cin) = w; }
                { const f32x4 v0 = acc[ai][1][m][0] * osc, v1 = acc[ai][1][m][1] * osc;
                  u32x2 w; w.x = (unsigned)pk4_fp8(v0[0], v0[1], v0[2], v0[3]); w.y = (unsigned)pk4_fp8(v1[0], v1[1], v1[2], v1[3]);
                  *(u32x2*)(V8 + row * 1024 + u.pn * 128 + cin) = w; } }
    }
};
struct EpiZ1 {
    static constexpr bool PERM = true;
    bf16_t* O; int ldc; float osc; unsigned char* K8; float ksc; unsigned char* V8;
    DI void operator()(const f32x4 (&acc)[2][2][4][2], const Unit& u, int wr, int wc, int fr, int fq) const {
        const int row0 = u.pm * BM + wr * 64 + fr, cin = wc * 32 + 8 * fq;
        if (u.pn >= 4 && u.pn < 12) {
            const bool isk = u.pn < 8; const float fs = isk ? ksc : osc; unsigned char* dst8 = isk ? (K8 + (u.pn - 4) * BM) : (V8 + (u.pn - 8) * BM);
#pragma unroll
            for (int ai = 0; ai < 2; ++ai)
#pragma unroll
                for (int m = 0; m < 4; ++m) { unsigned char* rowp = dst8 + (size_t)(row0 + ai * HALF + m * 16) * 1024 + cin;
#pragma unroll
                    for (int bj = 0; bj < 2; ++bj) { const f32x4 v0 = acc[ai][bj][m][0] * fs, v1 = acc[ai][bj][m][1] * fs;
                        u32x2 w; w.x = (unsigned)pk4_fp8(v0[0], v0[1], v0[2], v0[3]); w.y = (unsigned)pk4_fp8(v1[0], v1[1], v1[2], v1[3]);
                        *(u32x2*)(rowp + bj * HALF) = w; } }
        } else {
#pragma unroll
            for (int ai = 0; ai < 2; ++ai)
#pragma unroll
                for (int m = 0; m < 4; ++m) { bf16_t* rowp = O + (size_t)(row0 + ai * HALF + m * 16) * ldc + u.pn * BM + cin;
#pragma unroll
                    for (int bj = 0; bj < 2; ++bj) { const f32x4 v0 = acc[ai][bj][m][0] * osc, v1 = acc[ai][bj][m][1] * osc;
                        u32x4 w; w.x = pk2(v0[0], v0[1]); w.y = pk2(v0[2], v0[3]); w.z = pk2(v1[0], v1[1]); w.w = pk2(v1[2], v1[3]);
                        *(u32x4*)(rowp + bj * HALF) = w; } }
        }
    }
};
template <bool RBF16>
struct EpiResid {
    static constexpr bool PERM = true;
    bf16_t* H; const void* Rx; const void* Rc; const float* gx; const float* gc; int gstride; float osc = 1.f;
    DI void operator()(const f32x4 (&acc)[2][2][4][2], const Unit& u, int wr, int wc, int fr, int fq) const {
        const int rowt = u.pm * BM;
        const char* R; const float* g;
        constexpr int RB = RBF16 ? 2 : 4;
        if (rowt < MXR) { R = (const char*)Rx + (size_t)rowt * DM * RB; g = gx + (size_t)(rowt >> 11) * gstride; } else { R = (const char*)Rc + (size_t)(rowt - MXR) * DM * RB; g = gc; }
        bf16_t* Ho = H + (size_t)rowt * DM;
        const int rl0 = wr * 64 + fr, col0 = u.pn * BM + wc * 32 + 8 * fq;
        f32x4 gv[2][2];
#pragma unroll
        for (int bj = 0; bj < 2; ++bj)
#pragma unroll
            for (int n = 0; n < 2; ++n) gv[bj][n] = *(const f32x4*)(g + col0 + bj * HALF + 4 * n) * osc;
#pragma unroll
        for (int ai = 0; ai < 2; ++ai)
#pragma unroll
            for (int m = 0; m < 4; ++m) { const size_t ro = (size_t)(rl0 + ai * HALF + m * 16) * DM + col0;
#pragma unroll
                for (int bj = 0; bj < 2; ++bj) { f32x4 r0, r1;
                    if (RBF16) { const u32x4 rr = *(const u32x4*)(R + (ro + bj * HALF) * 2); r0 = (f32x4){bflo(rr.x), bfhi(rr.x), bflo(rr.y), bfhi(rr.y)}; r1 = (f32x4){bflo(rr.z), bfhi(rr.z), bflo(rr.w), bfhi(rr.w)}; }
                    else { r0 = *(const f32x4*)(R + (ro + bj * HALF) * 4); r1 = *(const f32x4*)(R + (ro + bj * HALF + 4) * 4); }
                    const f32x4 v0 = r0 + gv[bj][0] * acc[ai][bj][m][0], v1 = r1 + gv[bj][1] * acc[ai][bj][m][1];
                    u32x4 w; w.x = pk2(v0[0], v0[1]); w.y = pk2(v0[2], v0[3]); w.z = pk2(v1[0], v1[1]); w.w = pk2(v1[2], v1[3]);
                    *(u32x4*)(Ho + ro + bj * HALF) = w; } }
    }
};

template <class Epi, bool FP8 = false>
DI void gemm_phase(LAS unsigned char* lds, const Gemm g, const StaticOrder& S, const Epi& E) {
    const int tid = threadIdx.x, wid = __builtin_amdgcn_readfirstlane(tid >> 6), lane = tid & 63, wr = wid >> 2, wc = wid & 3, fr = lane & 15, fq = lane >> 4;
    const int K = g.K, nt = K / BK;
    unsigned voffA[2], voffB[2];
#pragma unroll
    for (int i = 0; i < 2; ++i) { int R, C; stage_rc(tid * 16 + i * 8192, R, C); const int Rb = Epi::PERM ? ((R & ~31) + perm32(R & 31)) : R;
        voffA[i] = (unsigned)(R * g.lda + C) * 2u; voffB[i] = (unsigned)(Rb * g.ldb + C) * 2u; }
    const size_t kstep = (size_t)(BK * 2);
    const size_t hA = (size_t)HALF * g.lda * 2, hB = (size_t)HALF * g.ldb * 2;
    const size_t tA = 2 * hA, tB = 2 * hB;
    const unsigned ldsw = (unsigned)wid * 1024u;
    const int aoff = lds_byte(wr * 64 + fr, fq * 8), boff = lds_byte(wc * 32 + fr, fq * 8);
#define PG8_SA(b, h) (((b) * 2 + (h)) * HTB)
#define PG8_SB(b, h) ((4 + (b) * 2 + (h)) * HTB)
#define PG8_STAGE(bufoff, gbase, voff) do { _Pragma("unroll") for (int _i = 0; _i < 2; ++_i) \
        __builtin_amdgcn_global_load_lds((const unsigned*)((const char*)(gbase) + (voff)[_i]), (LAS unsigned*)(lds + (bufoff) + ldsw + _i * 8192), 16, 0, 0); } while (0)
#define PG8_LD8(p) __builtin_shufflevector(*(const LAS u32x4*)(p), *(const LAS u32x4*)((p) + 1024), 0, 1, 2, 3, 4, 5, 6, 7)
#define PG8_LDA(dst, b, h) do { if constexpr (FP8) { _Pragma("unroll") for (int m = 0; m < 4; ++m) dst##8[m] = PG8_LD8(lds + PG8_SA(b, h) + aoff + m * 2048); } \
        else { _Pragma("unroll") for (int m = 0; m < 4; ++m) _Pragma("unroll") for (int k = 0; k < 2; ++k) dst[m][k] = *(const LAS bf16x8*)(lds + PG8_SA(b, h) + aoff + m * 2048 + k * 1024); } } while (0)
#define PG8_LDB(dst, b, h) do { if constexpr (FP8) { _Pragma("unroll") for (int n = 0; n < 2; ++n) dst##8[n] = PG8_LD8(lds + PG8_SB(b, h) + boff + n * 2048); } \
        else { _Pragma("unroll") for (int n = 0; n < 2; ++n) _Pragma("unroll") for (int k = 0; k < 2; ++k) dst[n][k] = *(const LAS bf16x8*)(lds + PG8_SB(b, h) + boff + n * 2048 + k * 1024); } } while (0)
#define PG8_MMA(ai, bj, At, Bt) do { __builtin_amdgcn_s_setprio(1); \
        if constexpr (FP8) { _Pragma("unroll") for (int m = 0; m < 4; ++m) _Pragma("unroll") for (int n = 0; n < 2; ++n) \
            asm volatile("v_mfma_scale_f32_16x16x128_f8f6f4 %0, %1, %2, %0, %3, %3 op_sel_hi:[0,0,0]" : "+v"(acc[ai][bj][m][n]) : "v"(Bt##8[n]), "v"(At##8[m]), "v"(one_scale)); } \
        else { _Pragma("unroll") for (int m = 0; m < 4; ++m) _Pragma("unroll") for (int n = 0; n < 2; ++n) _Pragma("unroll") for (int k = 0; k < 2; ++k) \
            acc[ai][bj][m][n] = __builtin_amdgcn_mfma_f32_16x16x32_bf16(Bt[n][k], At[m][k], acc[ai][bj][m][n], 0, 0, 0); } \
        __builtin_amdgcn_s_setprio(0); } while (0)
#define PG8_WAIT_V(n) asm volatile("s_waitcnt vmcnt(" #n ")" ::: "memory")
#define PG8_WAIT_L(n) asm volatile("s_waitcnt lgkmcnt(" #n ")" ::: "memory")
#define PG8_BAR __builtin_amdgcn_s_barrier()
#define PG8_SCHED __builtin_amdgcn_sched_barrier(0)
    Unit cur, nxt; int ui = 0;
    if (!S.next(0, cur)) return;
    f32x4 acc[2][2][4][2];
#pragma unroll
    for (int a = 0; a < 2; ++a)
#pragma unroll
        for (int b = 0; b < 2; ++b)
#pragma unroll
            for (int m = 0; m < 4; ++m)
#pragma unroll
                for (int n = 0; n < 2; ++n) acc[a][b][m][n] = (f32x4){0.f, 0.f, 0.f, 0.f};
    bf16x8 At[4][2], B0[2][2], B1[2][2];
    typedef unsigned u32x8 __attribute__((ext_vector_type(8))); typedef int i32x8 __attribute__((ext_vector_type(8)));
    u32x8 At8[4], B08[2], B18[2];
    const unsigned one_scale = 0x7f7f7f7fu;
    const char* cA = (const char*)g.A + (size_t)cur.pm * tA; const char* cB = (const char*)g.Bt + (size_t)cur.pn * tB;
    PG8_STAGE(PG8_SB(0, 0), cB, voffB); PG8_STAGE(PG8_SA(0, 0), cA, voffA); PG8_STAGE(PG8_SB(0, 1), cB + hB, voffB); PG8_STAGE(PG8_SA(0, 1), cA + hA, voffA);
    if (wr == 1) PG8_BAR;
    PG8_WAIT_V(4); PG8_BAR;
    PG8_STAGE(PG8_SB(1, 0), cB + kstep, voffB); PG8_STAGE(PG8_SA(1, 0), cA + kstep, voffA); PG8_STAGE(PG8_SB(1, 1), cB + hB + kstep, voffB);
    PG8_WAIT_V(6); PG8_BAR;
    for (;;) {
        const bool has_next = S.next(ui + 1, nxt);
        const char* nA = has_next ? (const char*)g.A + (size_t)nxt.pm * tA : cA; const char* nB = has_next ? (const char*)g.Bt + (size_t)nxt.pn * tB : cB;
        for (int t = 0; t < nt; t += 2) {
            const bool last = (t == nt - 2);
            const char* a1 = cA + (size_t)(t + 1) * kstep;
            const char* a2 = last ? nA : cA + (size_t)(t + 2) * kstep; const char* b2 = last ? nB : cB + (size_t)(t + 2) * kstep;
            const char* a3 = a2 + kstep; const char* b3 = b2 + kstep;
            PG8_LDB(B0, 0, 0); PG8_SCHED; PG8_LDA(At, 0, 0); PG8_STAGE(PG8_SA(1, 1), a1 + hA, voffA);
            PG8_WAIT_L(8); PG8_BAR; PG8_WAIT_L(0); PG8_MMA(0, 0, At, B0); PG8_BAR; PG8_SCHED;
            PG8_LDB(B1, 0, 1); PG8_STAGE(PG8_SB(0, 0), b2, voffB);
            PG8_BAR; PG8_WAIT_L(0); PG8_MMA(0, 1, At, B1); PG8_BAR;
            PG8_LDA(At, 0, 1); PG8_STAGE(PG8_SA(0, 0), a2, voffA);
            PG8_BAR; PG8_WAIT_L(0); PG8_MMA(1, 0, At, B0); PG8_BAR; PG8_SCHED;
            PG8_STAGE(PG8_SB(0, 1), b2 + hB, voffB);
            PG8_WAIT_V(6); PG8_BAR; PG8_MMA(1, 1, At, B1); PG8_BAR;
            PG8_LDB(B0, 1, 0); PG8_SCHED; PG8_LDA(At, 1, 0); PG8_STAGE(PG8_SA(0, 1), a2 + hA, voffA);
            PG8_WAIT_L(8); PG8_BAR; PG8_WAIT_L(0); PG8_MMA(0, 0, At, B0); PG8_BAR; PG8_SCHED;
            PG8_LDB(B1, 1, 1); PG8_STAGE(PG8_SB(1, 0), b3, voffB);
            PG8_BAR; PG8_WAIT_L(0); PG8_MMA(0, 1, At, B1); PG8_BAR;
            PG8_LDA(At, 1, 1); PG8_STAGE(PG8_SA(1, 0), a3, voffA);
            PG8_BAR; PG8_WAIT_L(0); PG8_MMA(1, 0, At, B0); PG8_BAR; PG8_SCHED;
            PG8_STAGE(PG8_SB(1, 1), b3 + hB, voffB);
            PG8_WAIT_V(6); PG8_BAR; PG8_MMA(1, 1, At, B1); PG8_BAR;
        }
        E(acc, cur, wr, wc, fr, fq);
        if (!has_next) break;
#pragma unroll
        for (int a = 0; a < 2; ++a)
#pragma unroll
            for (int b = 0; b < 2; ++b)
#pragma unroll
                for (int m = 0; m < 4; ++m)
#pragma unroll
                    for (int n = 0; n < 2; ++n) acc[a][b][m][n] = (f32x4){0.f, 0.f, 0.f, 0.f};
        cur = nxt; cA = nA; cB = nB; ++ui;
    }
    PG8_WAIT_V(0);
    if (wr == 0) PG8_BAR;
    PG8_BAR;
#undef PG8_SA
#undef PG8_SB
#undef PG8_STAGE
#undef PG8_LDA
#undef PG8_LDB
#undef PG8_MMA
#undef PG8_LD8
#undef PG8_WAIT_V
#undef PG8_WAIT_L
#undef PG8_BAR
#undef PG8_SCHED
}
}

enum { I_X = 0, I_C, I_CTX, I_CCTX, I_WMOD, I_BMOD, I_N1W, I_N2W, I_EVIN, I_EVOUT, I_GQN, I_GKN, I_HLB, I_HON, I_ODIN, I_ODOUT, I_RPB,
       I_MQN, I_MQUP, I_MKVN, I_MKVUP, I_PWQ, I_PKEYS, I_PU, I_PV, I_FNW, N_IN };
struct Args { const float* in[N_IN]; float* out; unsigned char* ws; int ph_lo, ph_hi; };
struct Frame {
    LAS unsigned char* lds;
    int tid, lane, wave, gw, ngw, G, wg;
};

constexpr float FP8_WSC = 2048.f, FP8_WSC2 = 1024.f, FP8_ASC = 16.f;
DI void transpose_item_fp8(const float* W, int K, int N, unsigned char* WT, LAS float* scr, int item, int lane, float wsc = FP8_WSC) {
    const int nblk = N / 32, kb = item / nblk, nb = item % nblk, k0 = 64 * kb, n0 = 32 * nb;
#pragma unroll 8
    for (int i = 0; i < 32; ++i) { const int kk = 2 * i + (lane >> 5); scr[kk * 33 + (lane & 31)] = W[(size_t)(k0 + kk) * N + n0 + (lane & 31)] * wsc; }
    asm volatile("s_waitcnt lgkmcnt(0)" ::: "memory");
    const int c = lane & 7;
#pragma unroll
    for (int j = 0; j < 4; ++j) { const int n = (lane >> 3) + 8 * j; const LAS float* sp = scr + (8 * c) * 33 + n;
        u32x2 o; o.x = (unsigned)pk4_fp8(sp[0 * 33], sp[1 * 33], sp[2 * 33], sp[3 * 33]); o.y = (unsigned)pk4_fp8(sp[4 * 33], sp[5 * 33], sp[6 * 33], sp[7 * 33]);
        *(u32x2*)(WT + (size_t)(n0 + n) * K + k0 + 8 * c) = o; }
    asm volatile("s_waitcnt lgkmcnt(0)" ::: "memory");
}
DI void transpose_item(const float* W, int K, int N, bf16_t* WT, LAS float* scr, int item, int lane) {
    const int nblk = N / 32, kb = item / nblk, nb = item % nblk, k0 = 64 * kb, n0 = 32 * nb;
#pragma unroll 8
    for (int i = 0; i < 32; ++i) { const int kk = 2 * i + (lane >> 5); scr[kk * 33 + (lane & 31)] = W[(size_t)(k0 + kk) * N + n0 + (lane & 31)]; }
    asm volatile("s_waitcnt lgkmcnt(0)" ::: "memory");
    const int c = lane & 7;
#pragma unroll
    for (int j = 0; j < 4; ++j) { const int n = (lane >> 3) + 8 * j; const LAS float* s = scr + (8 * c) * 33 + n;
        u32x4 o; o.x = pk2(s[0 * 33], s[1 * 33]); o.y = pk2(s[2 * 33], s[3 * 33]); o.z = pk2(s[4 * 33], s[5 * 33]); o.w = pk2(s[6 * 33], s[7 * 33]);
        *(u32x4*)(WT + (size_t)(n0 + n) * K + k0 + 8 * c) = o; }
    asm volatile("s_waitcnt lgkmcnt(0)" ::: "memory");
}
DI void cvt_bf16_stream(const Frame& F, const float* src, bf16_t* dst, size_t n) {
    const size_t nth = (size_t)F.G * 512, t0 = (size_t)F.wg * 512 + F.tid;
    for (size_t i = t0; i < n / 8; i += nth) {
        const f32x4 a = *(const f32x4*)(src + i * 8), b = *(const f32x4*)(src + i * 8 + 4);
        u32x4 o; o.x = pk2(a[0], a[1]); o.y = pk2(a[2], a[3]); o.z = pk2(b[0], b[1]); o.w = pk2(b[2], b[3]);
        *(u32x4*)(dst + i * 8) = o;
    }
}
typedef float f32x16v __attribute__((ext_vector_type(16)));
typedef float f32x32v __attribute__((ext_vector_type(32)));
typedef __bf16 bf16x32v __attribute__((ext_vector_type(32)));
typedef unsigned u32x6 __attribute__((ext_vector_type(6)));
constexpr int ROWB = 1536, SLB = 192;
DI void cvt_fp6_rows(const Frame& F, const float* src, unsigned char* dst, float* inv_scale, int nrows) {
    LAS float* stage = (LAS float*)(F.lds + F.wave * 8192);
    for (int row = F.gw; row < nrows; row += F.ngw) {
        const float* sp = src + (size_t)row * DM;
        f32x4 v[8]; float mx = 0.f;
#pragma unroll
        for (int j = 0; j < 8; ++j) { v[j] = *(const f32x4*)(sp + 4 * (F.lane + 64 * j));
            mx = fmaxf(mx, fmaxf(fmaxf(fabsf(v[j][0]), fabsf(v[j][1])), fmaxf(fabsf(v[j][2]), fabsf(v[j][3])))); }
#pragma unroll
        for (int o = 1; o < 64; o <<= 1) mx = fmaxf(mx, __shfl_xor(mx, o));
        mx = fmaxf(mx, 1e-30f);
        const float sc = exp2f(floorf(log2f(7.0f / mx)));
#pragma unroll
        for (int j = 0; j < 8; ++j) *(LAS f32x4*)(stage + 4 * (F.lane + 64 * j)) = v[j] * sc;
        asm volatile("s_waitcnt lgkmcnt(0)" ::: "memory");
        f32x16v a, b;
#pragma unroll
        for (int j = 0; j < 8; ++j) { const f32x4 t0 = *(const LAS f32x4*)(stage + 32 * F.lane + 4 * j);
            a[2 * j] = t0[0]; b[2 * j] = t0[1]; a[2 * j + 1] = t0[2]; b[2 * j + 1] = t0[3]; }
        const u32x6 p = __builtin_amdgcn_cvt_scalef32_2xpk16_fp6_f32(a, b, 1.0f);
        unsigned char* dp = dst + ((size_t)(F.lane >> 3) * 16384 + row) * SLB + 24 * (F.lane & 7);
        *(u32x2*)dp = (u32x2){p[0], p[1]}; *(u32x2*)(dp + 8) = (u32x2){p[2], p[3]}; *(u32x2*)(dp + 16) = (u32x2){p[4], p[5]};
        if (F.lane == 0) inv_scale[row] = 1.f / sc;
        asm volatile("s_waitcnt lgkmcnt(0)" ::: "memory");
    }
}
DI void mod_gemv(const Frame& F, const Args& a) {
    const float* c = a.in[I_C]; const float* cctx = a.in[I_CCTX]; const float* wmod = a.in[I_WMOD]; const float* bmod = a.in[I_BMOD];
    float* modx = (float*)(a.ws + WS_MODX); float* modc = (float*)(a.ws + WS_MODC);
    LAS float* red = (LAS float*)F.lds;
    const int r = F.lane & 31, hh = F.lane >> 5;
    for (int blk = F.wg; blk < 768; blk += F.G) {
        const int l = blk / 384, j0 = (blk % 384) * 32;
        const float* W = wmod + (size_t)l * DM * 12288 + j0;
        f32x16 acc; for (int i = 0; i < 16; ++i) acc[i] = 0.f;
        const int kbeg = F.wave * 256;
        for (int ks = 0; ks < 16; ++ks) {
            const int k0 = kbeg + ks * 16 + 8 * hh;
            float av[8];
            if (r < 17) { const float* src = (r < 16) ? c + (size_t)r * DM + k0 : cctx + k0;
                const f32x4 x0 = *(const f32x4*)src, x1 = *(const f32x4*)(src + 4);
                av[0] = silu_f(x0[0]); av[1] = silu_f(x0[1]); av[2] = silu_f(x0[2]); av[3] = silu_f(x0[3]);
                av[4] = silu_f(x1[0]); av[5] = silu_f(x1[1]); av[6] = silu_f(x1[2]); av[7] = silu_f(x1[3]);
            } else { for (int i = 0; i < 8; ++i) av[i] = 0.f; }
            u32x4 ap; ap.x = pk2(av[0], av[1]); ap.y = pk2(av[2], av[3]); ap.z = pk2(av[4], av[5]); ap.w = pk2(av[6], av[7]);
            float bv[8];
#pragma unroll
            for (int i = 0; i < 8; ++i) bv[i] = W[(size_t)(k0 + i) * 12288 + r];
            u32x4 bp; bp.x = pk2(bv[0], bv[1]); bp.y = pk2(bv[2], bv[3]); bp.z = pk2(bv[4], bv[5]); bp.w = pk2(bv[6], bv[7]);
            acc = __builtin_amdgcn_mfma_f32_32x32x16_bf16(__builtin_bit_cast(bf16x8, ap), __builtin_bit_cast(bf16x8, bp), acc, 0, 0, 0);
        }
        __syncthreads();
#pragma unroll
        for (int i = 0; i < 16; ++i) { const int row = (i & 3) + 8 * (i >> 2) + 4 * hh; red[(F.wave * 32 + row) * 32 + r] = acc[i]; }
        __syncthreads();
        for (int o = F.tid; o < 17 * 32; o += 512) { const int row = o >> 5, col = o & 31; float s = 0.f;
#pragma unroll
            for (int w = 0; w < 8; ++w) s += red[(w * 32 + row) * 32 + col];
            s += bmod[(size_t)l * 12288 + j0 + col];
            if (row < 16) modx[((size_t)l * 16 + row) * 12288 + j0 + col] = s; else modc[(size_t)l * 12288 + j0 + col] = s; }
    }
    __syncthreads();
}
DI void prologue(const Frame& F, const Args& a) {
    LAS float* scr = (LAS float*)(F.lds + 32768 + F.wave * 8704);
    unsigned char* ws = a.ws;
    constexpr int I0 = 32 * 208, I1 = 32 * 64, I2 = 32 * 130, I3 = 32 * 64, I4 = 8 * 48, I5 = 8 * 64, I6 = 32 * 64, I7 = 32 * 64;
    constexpr int NIT = I0 + I1 + I2 + I3 + I4 + I5 + I6 + I7;
    for (int it = F.gw; it < NIT; it += F.ngw) {
        int r = it;
        if (r < I0) { transpose_item_fp8(a.in[I_EVIN], 2048, 6656, ws + WS_WIN0, scr, r, F.lane); continue; } r -= I0;
        if (r < I1) { transpose_item_fp8(a.in[I_EVOUT], 2048, 2048, ws + WS_WOUT0, scr, r, F.lane); continue; } r -= I1;
        if (r < I2) { transpose_item_fp8(a.in[I_ODIN], 2048, 4160, ws + WS_WIN1, scr, r, F.lane); continue; } r -= I2;
        if (r < I3) { transpose_item_fp8(a.in[I_ODOUT], 2048, 2048, ws + WS_WOUT1, scr, r, F.lane); continue; } r -= I3;
        if (r < I4) { transpose_item_fp8(a.in[I_MQUP], 512, 1536, ws + WS_WQUP, scr, r, F.lane, FP8_WSC2); continue; } r -= I4;
        if (r < I5) { transpose_item_fp8(a.in[I_MKVUP], 512, 2048, ws + WS_WKVUP, scr, r, F.lane, FP8_WSC2); continue; } r -= I5;
        if (r < I6) { transpose_item(a.in[I_PWQ], 2048, 2048, (bf16_t*)(ws + WS_WPQ), scr, r, F.lane); continue; } r -= I6;
        transpose_item(a.in[I_PWQ] + (size_t)2048 * 2048, 2048, 2048, (bf16_t*)(ws + WS_WPQ) + (size_t)2048 * 2048, scr, r, F.lane);
    }
    { u32x4* z = (u32x4*)(ws + WS_WIN1 + (size_t)4160 * 2048); const size_t n16 = (size_t)192 * 2048 / 16;
      for (size_t i = (size_t)F.wg * 512 + F.tid; i < n16; i += (size_t)F.G * 512) z[i] = (u32x4){0u, 0u, 0u, 0u}; }
    cvt_bf16_stream(F, a.in[I_PKEYS], (bf16_t*)(ws + WS_KEYS), (size_t)2 * 8 * 2 * 128 * 128);
    __syncthreads();
    cvt_fp6_rows(F, a.in[I_PU], ws + WS_U, (float*)(ws + WS_SU), 16384);
    cvt_fp6_rows(F, a.in[I_PV], ws + WS_V, (float*)(ws + WS_SV), 16384);
    mod_gemv(F, a);
}

template <bool SRC_BF16, bool DST_FP8>
DI void norm_mod_row(const Frame& F, const char* src, const f32x4 (&w)[8], const f32x4 (&sh)[8], const f32x4 (&sc)[8], bf16_t* dst, size_t row) {
    f32x4 v[8]; float ss = 0.f;
#pragma unroll
    for (int j = 0; j < 4; ++j) { const int c = 8 * (F.lane + 64 * j);
        if (SRC_BF16) { const u32x4 rr = *(const u32x4*)(src + (size_t)c * 2); v[2 * j] = (f32x4){bflo(rr.x), bfhi(rr.x), bflo(rr.y), bfhi(rr.y)}; v[2 * j + 1] = (f32x4){bflo(rr.z), bfhi(rr.z), bflo(rr.w), bfhi(rr.w)}; }
        else { v[2 * j] = *(const f32x4*)(src + (size_t)c * 4); v[2 * j + 1] = *(const f32x4*)(src + (size_t)c * 4 + 16); }
#pragma unroll
        for (int q = 0; q < 2; ++q) ss += v[2 * j + q][0] * v[2 * j + q][0] + v[2 * j + q][1] * v[2 * j + q][1] + v[2 * j + q][2] * v[2 * j + q][2] + v[2 * j + q][3] * v[2 * j + q][3]; }
    const float rstd = __frsqrt_rn(wave_sum(ss) * (1.f / DM) + EPS);
    bf16_t* o = dst + row * DM;
#pragma unroll
    for (int j = 0; j < 4; ++j) { const int c = 8 * (F.lane + 64 * j); unsigned pk[4];
#pragma unroll
        for (int q = 0; q < 2; ++q) { f32x4 y;
#pragma unroll
            for (int e = 0; e < 4; ++e) y[e] = (v[2 * j + q][e] * rstd * w[2 * j + q][e]) * (1.f + sc[2 * j + q][e]) + sh[2 * j + q][e];
            if (DST_FP8) pk[q] = (unsigned)pk4_fp8(y[0] * FP8_ASC, y[1] * FP8_ASC, y[2] * FP8_ASC, y[3] * FP8_ASC);
            else { pk[2 * q] = pk2(y[0], y[1]); pk[2 * q + 1] = pk2(y[2], y[3]); } }
        if (DST_FP8) *(u32x2*)((unsigned char*)dst + row * DM + c) = (u32x2){pk[0], pk[1]};
        else *(u32x4*)(o + c) = (u32x4){pk[0], pk[1], pk[2], pk[3]}; }
}
template <bool SRC_BF16, bool DST_FP8 = false>
DI void norm_mod_phase(const Frame& F, const void* srcX, const void* srcC, const float* nw, const float* modx_l, const float* modc_l, int sidx, bf16_t* dst, int nrows) {
    constexpr int SB = SRC_BF16 ? 2 : 4;
    f32x4 w[8], sh[8], sc[8];
#pragma unroll
    for (int j = 0; j < 4; ++j) { const int c = 8 * (F.lane + 64 * j); w[2 * j] = *(const f32x4*)(nw + c); w[2 * j + 1] = *(const f32x4*)(nw + c + 4); }
    for (int blk = F.gw; blk < MXR / 16; blk += F.ngw) {
        const int row0 = 16 * blk; const float* shift = modx_l + (size_t)(row0 >> 11) * 12288 + sidx * DM; const float* scale = shift + DM;
#pragma unroll
        for (int j = 0; j < 4; ++j) { const int c = 8 * (F.lane + 64 * j); sh[2 * j] = *(const f32x4*)(shift + c); sh[2 * j + 1] = *(const f32x4*)(shift + c + 4); sc[2 * j] = *(const f32x4*)(scale + c); sc[2 * j + 1] = *(const f32x4*)(scale + c + 4); }
#pragma unroll 1
        for (int i = 0; i < 16; ++i) norm_mod_row<SRC_BF16, DST_FP8>(F, (const char*)srcX + (size_t)(row0 + i) * DM * SB, w, sh, sc, dst, (size_t)(row0 + i));
    }
    if (nrows > MXR) {
        const float* shift = modc_l + sidx * DM; const float* scale = shift + DM;
#pragma unroll
        for (int j = 0; j < 4; ++j) { const int c = 8 * (F.lane + 64 * j); sh[2 * j] = *(const f32x4*)(shift + c); sh[2 * j + 1] = *(const f32x4*)(shift + c + 4); sc[2 * j] = *(const f32x4*)(scale + c); sc[2 * j + 1] = *(const f32x4*)(scale + c + 4); }
        for (int row = MXR + F.gw; row < nrows; row += F.ngw) norm_mod_row<SRC_BF16, DST_FP8>(F, (const char*)srcC + (size_t)(row - MXR) * DM * SB, w, sh, sc, dst, (size_t)row);
    }
}

DI void rope_pair(float& a, float& bsub, int lane, int posA, int posB, float inv) {
    const float pa = __shfl_xor(a, 32), pb = __shfl_xor(bsub, 32);
    const float angA = (float)posA * inv, angB = (float)posB * inv;
    const float sA = __sinf(angA), cA = __cosf(angA), sB = __sinf(angB), cB = __cosf(angB);
    const float sg = (lane < 32) ? -1.f : 1.f;
    a = a * cA + sg * pa * sA; bsub = bsub * cB + sg * pb * sB;
}
DI void gqa_prep_phase(const Frame& F, const Args& a) {
    const bf16_t* Z = (const bf16_t*)(a.ws + WS_Z);
    const float* qn = a.in[I_GQN]; const float* kn = a.in[I_GKN];
    const float inv = exp2f(-(float)(F.lane & 31) * (13.287712379549449f / 32.f));
    const float wq0 = qn[F.lane], wq1 = qn[64 + F.lane], wk0 = kn[F.lane], wk1 = kn[64 + F.lane];
    LAS unsigned char* Lin = F.lds + F.wave * 4608; LAS unsigned char* Lout = Lin + 3072;
    u32x4 nx[3];
    if (F.gw < MT) { const unsigned char* zr = (const unsigned char*)(Z + (size_t)F.gw * EV_IN);
#pragma unroll
        for (int i = 0; i < 3; ++i) nx[i] = *(const u32x4*)(zr + 1024 * i + 16 * F.lane); }
    for (int row = F.gw; row < MT; row += F.ngw) {
        const bool isx = row < MXR; const int t = row & 2047;
#pragma unroll
        for (int i = 0; i < 3; ++i) *(LAS u32x4*)(Lin + 1024 * i + 16 * F.lane) = nx[i];
        { const int nrow = (row + F.ngw < MT) ? row + F.ngw : row; const unsigned char* zn = (const unsigned char*)(Z + (size_t)nrow * EV_IN);
#pragma unroll
          for (int i = 0; i < 3; ++i) nx[i] = *(const u32x4*)(zn + 1024 * i + 16 * F.lane); }
        const LAS unsigned short* Li = (const LAS unsigned short*)Lin;
#pragma unroll
        for (int hv = 0; hv < 10; ++hv) {
            float v0 = __uint_as_float((unsigned)Li[hv * 128 + F.lane] << 16), v1 = __uint_as_float((unsigned)Li[hv * 128 + 64 + F.lane] << 16);
            const float ms = wave_sum(v0 * v0 + v1 * v1) * (1.f / 128.f);
            const float rs = __frsqrt_rn(ms + EPS);
            v0 = v0 * rs * (hv < 8 ? wq0 : wk0); v1 = v1 * rs * (hv < 8 ? wq1 : wk1);
            if (isx) rope_pair(v0, v1, F.lane, t >> 6, t & 63, inv);
            const float q8s = (hv < 8) ? QK8_SC * 1.020139447f : QK8_SC;
            Lout[hv * 128 + F.lane] = (unsigned char)(pk4_fp8(v0 * q8s, 0.f, 0.f, 0.f) & 0xff); Lout[hv * 128 + 64 + F.lane] = (unsigned char)(pk4_fp8(v1 * q8s, 0.f, 0.f, 0.f) & 0xff);
        }
#pragma unroll
        for (int q = 0; q < 4; ++q) Lout[1280 + 64 * q + F.lane] = (unsigned char)(pk4_fp8(__uint_as_float((unsigned)Li[1280 + 64 * q + F.lane] << 16), 0.f, 0.f, 0.f) & 0xff);
        *(u32x4*)(a.ws + WS_Q8 + (size_t)row * 1024 + 16 * F.lane) = *(const LAS u32x4*)(Lout + 16 * F.lane);
        if (F.lane < 32) { const u32x4 w1 = *(const LAS u32x4*)(Lout + 1024 + 16 * F.lane);
            unsigned char* dp = (F.lane < 16) ? (a.ws + WS_K8 + (size_t)row * 256 + 16 * F.lane) : (a.ws + WS_V8G + (size_t)row * 256 + 16 * (F.lane - 16));
            *(u32x4*)dp = w1; }
    }
}

struct AttnP {
    const bf16_t* Q; int ldq;
    const bf16_t* K1; int ldk1;
    const bf16_t* K2; int ldk2;
    const bf16_t* V; int ldv;
    unsigned char* O; int ldo;
    int qrow0;
    int orow0;
    int b;
    int nctx_tiles;
    int xtile0, nx_tiles;
    float sc_log2e;
    const float* rpb; int qgrow0;
};
template <int DK, bool NA, bool FAST>
DI void attn_unit(const Frame& F, const AttnP& p) {
    constexpr int KST = DK * 2 + 16;
    constexpr int VST = 320;
    constexpr int KBYTES = 64 * KST, VBYTES = 64 * VST;
    constexpr int NKS = DK / 16;
    constexpr int KCH = DK / 8;
    constexpr int KLD = (64 * KCH) / 512;
    LAS unsigned char* Ks = F.lds; LAS unsigned char* Vs = F.lds + KBYTES; LAS float* rp = (LAS float*)(F.lds + KBYTES + VBYTES);
    const int lane = F.lane, w = F.wave, r = lane & 31, hh = lane >> 5;
    const int ntiles = p.nctx_tiles + p.nx_tiles;
    if (NA) { for (int i = F.tid; i < 15 * 31; i += 512) rp[i] = p.rpb[i]; }
    bf16x8 qf[NKS];
    { const bf16_t* qp = p.Q + (size_t)(p.qrow0 + 32 * w + r) * p.ldq + 8 * hh;
#pragma unroll
      for (int ks = 0; ks < NKS; ++ks) qf[ks] = *(const bf16x8*)(qp + 16 * ks); }
    f32x16 oacc[4];
#pragma unroll
    for (int d = 0; d < 4; ++d) for (int i = 0; i < 16; ++i) oacc[d][i] = 0.f;
    float m_run = -1e30f, l_run = 0.f;
    u32x4 kreg[KLD], vreg[2];
#define ATT_TILE_ROW(j) (((j) < p.nctx_tiles) ? (MXR + p.b * CTXL + 64 * (j)) : (p.b * SEQ + 64 * (p.xtile0 + (j) - p.nctx_tiles)))
#define ATT_ISSUE(j) do { const int row0_ = ATT_TILE_ROW(j); \
        _Pragma("unroll") for (int i_ = 0; i_ < KLD; ++i_) { const int c_ = F.tid + 512 * i_, kr_ = c_ / KCH, kc_ = c_ % KCH; \
            if (DK == 128 || kc_ < 16) kreg[i_] = *(const u32x4*)(p.K1 + (size_t)(row0_ + kr_) * p.ldk1 + 8 * kc_); \
            else kreg[i_] = *(const u32x4*)(p.K2 + (size_t)(row0_ + kr_) * p.ldk2 + 8 * (kc_ - 16)); } \
        _Pragma("unroll") for (int i_ = 0; i_ < 2; ++i_) { const int c_ = F.tid + 512 * i_, vr_ = c_ >> 4, vc_ = c_ & 15; \
            vreg[i_] = *(const u32x4*)(p.V + (size_t)(row0_ + vr_) * p.ldv + 8 * vc_); } } while (0)
#define ATT_WRITE() do { \
        _Pragma("unroll") for (int i_ = 0; i_ < KLD; ++i_) { const int c_ = F.tid + 512 * i_, kr_ = c_ / KCH, kc_ = c_ % KCH; *(LAS u32x4*)(Ks + kr_ * KST + 16 * kc_) = kreg[i_]; } \
        _Pragma("unroll") for (int i_ = 0; i_ < 2; ++i_) { const int c_ = F.tid + 512 * i_, vr_ = c_ >> 4, vc_ = c_ & 15; *(LAS u32x4*)(Vs + vr_ * VST + 16 * vc_) = vreg[i_]; } } while (0)
    const int qgr = NA ? (p.qgrow0 + (w >> 1)) : 0;
    const int qc = 32 * (w & 1) + r;
    const int r0w = NA ? min(max(qgr - 4, 0), 24) : 0;
    const int csq = min(max(qc - 8, 0), 48);
    const int tq = (lane & 15) >> 2, tp = lane & 3, dsub = (lane >> 4) & 1;
    const unsigned vtr_base = (unsigned)(size_t)(Vs) + (unsigned)((4 * hh + tq) * VST + (16 * dsub + 4 * tp) * 2);
    const unsigned kfr_base = (unsigned)(size_t)(Ks) + (unsigned)(r * KST + 16 * hh);
    ATT_ISSUE(0);
    for (int j = 0; j < ntiles; ++j) {
        __syncthreads();
        ATT_WRITE();
        if (j + 1 < ntiles) ATT_ISSUE(j + 1);
        __syncthreads();
        bool active = true; int dr = 0;
        if (NA && j >= p.nctx_tiles) { const int kr = p.xtile0 + (j - p.nctx_tiles); active = (kr >= r0w) && (kr < r0w + 8); dr = kr - qgr + 7; }
        if (!active) continue;
        f32x16 st[2];
#pragma unroll
        for (int kb = 0; kb < 2; ++kb) for (int i = 0; i < 16; ++i) st[kb][i] = 0.f;
        {
            constexpr int NT = 2 * NKS;
            bf16x8 kr[4];
#define K_READ(R, T) asm volatile("ds_read_b128 %0, %1 offset:%2" : "=v"(R) : "v"(kfr_base), "n"(32 * ((T) / NKS) * KST + 32 * ((T) % NKS)) : "memory")
#define K_WAIT(R, N) asm volatile("s_waitcnt lgkmcnt(%1)" : "+v"(R) : "n"(N) : "memory")
            K_READ(kr[0], 0); K_READ(kr[1], 1); K_READ(kr[2], 2); K_READ(kr[3], 3);
#pragma unroll
            for (int t = 0; t < NT; ++t) {
                K_WAIT(kr[t & 3], (NT - 1 - t) < 3 ? (NT - 1 - t) : 3);
                st[t / NKS] = __builtin_amdgcn_mfma_f32_32x32x16_bf16(kr[t & 3], qf[t % NKS], st[t / NKS], 0, 0, 0);
                if (t + 4 < NT) K_READ(kr[t & 3], t + 4);
            }
#undef K_READ
#undef K_WAIT
        }
        s16x4 vlo[4], vhi[4];
#define V_READ(I, T) asm volatile("ds_read_b64_tr_b16 %0, %2 offset:%3\n\tds_read_b64_tr_b16 %1, %2 offset:%4" : "=&v"(vlo[I]), "=&v"(vhi[I]) : "v"(vtr_base), "n"(16 * ((T) >> 2) * VST + 64 * ((T) & 3)), "n"(16 * ((T) >> 2) * VST + 64 * ((T) & 3) + 8 * VST) : "memory")
#define V_WAIT(I, N) asm volatile("s_waitcnt lgkmcnt(%2)" : "+v"(vlo[I]), "+v"(vhi[I]) : "n"(N) : "memory")
        V_READ(0, 0); V_READ(1, 1); V_READ(2, 2); V_READ(3, 3);
        if constexpr (FAST) {
        float tmax = -1e30f;
        if (NA && j >= p.nctx_tiles) {
#pragma unroll
            for (int kb = 0; kb < 2; ++kb)
#pragma unroll
                for (int i = 0; i < 16; ++i) {
                    const int kc = 32 * kb + (i & 3) + 8 * (i >> 2) + 4 * hh; const bool inw = (kc >= csq) && (kc < csq + 16);
                    const int dc = min(max(kc - qc + 15, 0), 30); const float bias = rp[dr * 31 + dc];
                    const float sv = inw ? __builtin_fmaf(st[kb][i], p.sc_log2e, bias * 1.4426950408889634f) : -1e30f;
                    st[kb][i] = sv; tmax = fmaxf(tmax, sv); }
        } else {
#pragma unroll
            for (int kb = 0; kb < 2; ++kb)
#pragma unroll
                for (int i = 0; i < 16; ++i) tmax = fmaxf(tmax, st[kb][i]);
            tmax *= p.sc_log2e;
        }
        tmax = fmaxf(tmax, __shfl_xor(tmax, 32));
        if (__any(tmax > m_run + 11.5f)) {
            const float m_new = fmaxf(m_run, tmax);
            const float alpha = __builtin_amdgcn_exp2f(m_run - m_new);
            m_run = m_new; l_run *= alpha;
#pragma unroll
            for (int d = 0; d < 4; ++d)
#pragma unroll
                for (int i = 0; i < 16; ++i) oacc[d][i] *= alpha;
        }
        float psum = 0.f;
        if (NA && j >= p.nctx_tiles) {
#pragma unroll
            for (int kb = 0; kb < 2; ++kb)
#pragma unroll
                for (int i = 0; i < 16; ++i) { const float e = __builtin_amdgcn_exp2f(st[kb][i] - m_run); st[kb][i] = e; psum += e; }
        } else {
#pragma unroll
            for (int kb = 0; kb < 2; ++kb)
#pragma unroll
                for (int i = 0; i < 16; ++i) { const float e = __builtin_amdgcn_exp2f(__builtin_fmaf(st[kb][i], p.sc_log2e, -m_run)); st[kb][i] = e; psum += e; }
        }
        l_run += psum;
        } else {
        float tmax = -1e30f;
#pragma unroll
        for (int kb = 0; kb < 2; ++kb)
#pragma unroll
            for (int i = 0; i < 16; ++i) {
                float s = st[kb][i] * p.sc_log2e;
                if (NA && j >= p.nctx_tiles) { const int kc = 32 * kb + (i & 3) + 8 * (i >> 2) + 4 * hh; const bool inw = (kc >= csq) && (kc < csq + 16);
                    const int dc = min(max(kc - qc + 15, 0), 30); const float bias = rp[dr * 31 + dc];
                    s = inw ? (s + bias * 1.4426950408889634f) : -1e30f; }
                st[kb][i] = s; tmax = fmaxf(tmax, s); }
        tmax = fmaxf(tmax, __shfl_xor(tmax, 32));
        const float m_new = fmaxf(m_run, tmax);
        const float alpha = exp2f(m_run - m_new);
        m_run = m_new;
        float psum = 0.f;
#pragma unroll
        for (int kb = 0; kb < 2; ++kb)
#pragma unroll
            for (int i = 0; i < 16; ++i) { const float e = exp2f(st[kb][i] - m_new); st[kb][i] = e; psum += e; }
        l_run = l_run * alpha + psum;
#pragma unroll
        for (int d = 0; d < 4; ++d)
#pragma unroll
            for (int i = 0; i < 16; ++i) oacc[d][i] *= alpha;
        }
#pragma unroll
        for (int t = 0; t < 16; ++t) {
            const int T = t >> 2, KB = T >> 1, S = T & 1, d = t & 3;
            u32x4 pp; pp.x = pk2(st[KB][8 * S + 0], st[KB][8 * S + 1]); pp.y = pk2(st[KB][8 * S + 2], st[KB][8 * S + 3]);
            pp.z = pk2(st[KB][8 * S + 4], st[KB][8 * S + 5]); pp.w = pk2(st[KB][8 * S + 6], st[KB][8 * S + 7]);
            const bf16x8 pf = __builtin_bit_cast(bf16x8, pp);
            if (t < 13) V_WAIT(t & 3, 6); else if (t == 13) V_WAIT(t & 3, 4); else if (t == 14) V_WAIT(t & 3, 2); else V_WAIT(t & 3, 0);
            oacc[d] = __builtin_amdgcn_mfma_f32_32x32x16_bf16(__builtin_shufflevector(vlo[t & 3], vhi[t & 3], 0, 1, 2, 3, 4, 5, 6, 7), pf, oacc[d], 0, 0, 0);
            if (t + 4 < 16) {
                if ((t & 3) == 0) V_READ(0, t + 4); else if ((t & 3) == 1) V_READ(1, t + 4); else if ((t & 3) == 2) V_READ(2, t + 4); else V_READ(3, t + 4);
            }
        }
#undef V_READ
#undef V_WAIT
    }
    const float lt = l_run + __shfl_xor(l_run, 32);
    const float il = 1.f / lt;
    unsigned char* op = p.O + (size_t)(p.orow0 + 32 * w + r) * p.ldo;
    const float ils = il * FP8_ASC;
#pragma unroll
    for (int d = 0; d < 4; ++d)
#pragma unroll
        for (int g = 0; g < 4; ++g) *(int*)(op + 32 * d + 8 * g + 4 * hh) = pk4_fp8(oacc[d][4 * g + 0] * ils, oacc[d][4 * g + 1] * ils, oacc[d][4 * g + 2] * ils, oacc[d][4 * g + 3] * ils);
    __syncthreads();
#undef ATT_TILE_ROW
#undef ATT_ISSUE
#undef ATT_WRITE
}

typedef int i32x8 __attribute__((ext_vector_type(8)));
struct AttnQK8 { const unsigned char* Q8; int ldq8; const unsigned char* K8a; int ldk8a; const unsigned char* K8b; int ldk8b; const unsigned char* V8; int ldv8; };
template <int DK, bool QBF16, bool NA = false, bool QROPE = false>
DI void attn_unit_f8(const Frame& F, const AttnP& p, const AttnQK8& e) {
    constexpr int KST = DK + 16, VS8 = 144, KBYTES = 64 * KST, VBYTES = 64 * VS8;
    constexpr float QC = (DK == 192) ? 1.665880740f : 1.020139447f; constexpr int KSCALE = ((DK == 192) ? 115 : 116) * 0x01010101;
    constexpr float PTHR = 4.f;
    constexpr int NC = DK / 64, KCH = DK / 16, NCHUNK = 64 * KCH, KLD = (NCHUNK + 511) / 512, NT = 2 * NC;
    LAS unsigned char* Ks = F.lds; LAS unsigned char* Vs = F.lds + KBYTES; LAS float* rp = (LAS float*)(F.lds + KBYTES + VBYTES);
    const int lane = F.lane, w = F.wave, r = lane & 31, hh = lane >> 5;
    const int ntiles = p.nctx_tiles + p.nx_tiles;
    if (NA) { for (int i = F.tid; i < 15 * 31; i += 512) rp[i] = p.rpb[i]; }
    i32x8 qf[NC];
    if constexpr (QBF16) {
        const bf16_t* qp = p.Q + (size_t)(p.qrow0 + 32 * w + r) * p.ldq + 32 * hh;
#pragma unroll
        for (int c = 0; c < NC; ++c) {
#pragma unroll
            for (int g = 0; g < 4; ++g) { const u32x4 q4 = *(const u32x4*)(qp + 64 * c + 8 * g);
                qf[c][2 * g] = pk4_fp8(bflo(q4.x) * (QK8_SC * QC), bfhi(q4.x) * (QK8_SC * QC), bflo(q4.y) * (QK8_SC * QC), bfhi(q4.y) * (QK8_SC * QC));
                qf[c][2 * g + 1] = pk4_fp8(bflo(q4.z) * (QK8_SC * QC), bfhi(q4.z) * (QK8_SC * QC), bflo(q4.w) * (QK8_SC * QC), bfhi(q4.w) * (QK8_SC * QC)); } }
        if constexpr (QROPE) {
            float v[32];
#pragma unroll
            for (int g = 0; g < 4; ++g) { const u32x4 q4 = *(const u32x4*)(qp + 64 * (NC - 1) + 8 * g);
                v[8 * g + 0] = bflo(q4.x); v[8 * g + 1] = bfhi(q4.x); v[8 * g + 2] = bflo(q4.y); v[8 * g + 3] = bfhi(q4.y);
                v[8 * g + 4] = bflo(q4.z); v[8 * g + 5] = bfhi(q4.z); v[8 * g + 6] = bflo(q4.w); v[8 * g + 7] = bfhi(q4.w); }
            const int tpos = (p.qrow0 + 32 * w + r) & 2047; const float pos = (float)(hh ? (tpos & 63) : (tpos >> 6));
#pragma unroll
            for (int i = 0; i < 16; ++i) { const float ang = pos * exp2f(-(float)i * (13.287712379549449f / 16.f)); const float sn = __sinf(ang), cs = __cosf(ang);
                const float x0 = v[i], x1 = v[i + 16]; v[i] = x0 * cs - x1 * sn; v[i + 16] = x1 * cs + x0 * sn; }
#pragma unroll
            for (int g = 0; g < 8; ++g) qf[NC - 1][g] = pk4_fp8(v[4 * g] * (QK8_SC * QC), v[4 * g + 1] * (QK8_SC * QC), v[4 * g + 2] * (QK8_SC * QC), v[4 * g + 3] * (QK8_SC * QC));
        }
    } else {
      const unsigned char* qp = e.Q8 + (size_t)(p.qrow0 + 32 * w + r) * e.ldq8 + 32 * hh;
#pragma unroll
      for (int c = 0; c < NC; ++c) { const u32x4 qa = *(const u32x4*)(qp + 64 * c), qb = *(const u32x4*)(qp + 64 * c + 16); qf[c] = __builtin_bit_cast(i32x8, __builtin_shufflevector(qa, qb, 0, 1, 2, 3, 4, 5, 6, 7)); } }
    f32x16 oacc[4];
#pragma unroll
    for (int d = 0; d < 4; ++d) for (int i = 0; i < 16; ++i) oacc[d][i] = 0.f;
    constexpr bool LSUM = (DK == 128 && !NA);
    float l_run = 0.f;
    f32x16 lacc;
#pragma unroll
    for (int i = 0; i < 16; ++i) lacc[i] = 0.f;
    f32x16 cinit;
#pragma unroll
    for (int i = 0; i < 16; ++i) cinit[i] = 0.f;
    u32x4 kreg[KLD], vreg;
#define A8_TILE_ROW(j) (((j) < p.nctx_tiles) ? (MXR + p.b * CTXL + 64 * (j)) : (p.b * SEQ + 64 * (p.xtile0 + (j) - p.nctx_tiles)))
#define A8_ISSUE(j) do { const int row0_ = A8_TILE_ROW(j); \
        _Pragma("unroll") for (int i_ = 0; i_ < KLD; ++i_) { const int c_ = F.tid + 512 * i_, kr_ = c_ / KCH, kc_ = c_ % KCH; \
            if (c_ < NCHUNK) { if (DK == 128 || kc_ < 8) kreg[i_] = *(const u32x4*)(e.K8a + (size_t)(row0_ + kr_) * e.ldk8a + 16 * kc_); \
                               else kreg[i_] = *(const u32x4*)(e.K8b + (size_t)(row0_ + kr_) * e.ldk8b + 16 * (kc_ - 8)); } } \
        vreg = *(const u32x4*)(e.V8 + (size_t)(row0_ + (F.tid >> 3)) * e.ldv8 + 16 * (F.tid & 7)); } while (0)
#define A8_WRITE() do { \
        _Pragma("unroll") for (int i_ = 0; i_ < KLD; ++i_) { const int c_ = F.tid + 512 * i_, kr_ = c_ / KCH, kc_ = c_ % KCH; if (c_ < NCHUNK) *(LAS u32x4*)(Ks + kr_ * KST + 16 * kc_) = kreg[i_]; } \
        *(LAS u32x4*)(Vs + (F.tid >> 3) * VS8 + 16 * (F.tid & 7)) = vreg; } while (0)
    const int qgr = NA ? (p.qgrow0 + (w >> 1)) : 0;
    const int qc = 32 * (w & 1) + r;
    const int r0w = NA ? min(max(qgr - 4, 0), 24) : 0;
    const int csq = min(max(qc - 8, 0), 48);
    const unsigned vt_base = (unsigned)(size_t)(Vs) + (unsigned)((8 * (((lane & 15) >> 1) >> 2) + 4 * hh + (((lane & 15) >> 1) & 3)) * VS8 + 16 * ((lane >> 4) & 1) + 8 * (lane & 1));
    const unsigned kfr_base = (unsigned)(size_t)(Ks) + (unsigned)(r * KST + 32 * hh);
    A8_ISSUE(0);
    for (int j = 0; j < ntiles; ++j) {
        __syncthreads();
        A8_WRITE();
        if (j + 1 < ntiles) A8_ISSUE(j + 1);
        __syncthreads();
        bool active = true; int dr = 0;
        if (NA && j >= p.nctx_tiles) { const int krow = p.xtile0 + (j - p.nctx_tiles); active = (krow >= r0w) && (krow < r0w + 8); dr = krow - qgr + 7; }
        if (!active) continue;
        f32x16 st[2];
        {
            u32x4 klo[4], khi[4];
#define K8_READ(I, T) asm volatile("ds_read_b128 %0, %2 offset:%3\n\tds_read_b128 %1, %2 offset:%4" : "=&v"(klo[I]), "=&v"(khi[I]) : "v"(kfr_base), "n"(32 * ((T) / NC) * KST + 64 * ((T) % NC)), "n"(32 * ((T) / NC) * KST + 64 * ((T) % NC) + 16) : "memory")
#define K8_WAIT(I, N) asm volatile("s_waitcnt lgkmcnt(%2)" : "+v"(klo[I]), "+v"(khi[I]) : "n"(N) : "memory")
            K8_READ(0, 0); K8_READ(1, 1); K8_READ(2, 2); K8_READ(3, 3);
#pragma unroll
            for (int t = 0; t < NT; ++t) {
                const int last = (t + 3 < NT - 1) ? t + 3 : NT - 1;
                if ((t & 3) == 0) K8_WAIT(0, 2 * (last - t)); else if ((t & 3) == 1) K8_WAIT(1, 2 * (last - t)); else if ((t & 3) == 2) K8_WAIT(2, 2 * (last - t)); else K8_WAIT(3, 2 * (last - t));
                const i32x8 kf = __builtin_bit_cast(i32x8, __builtin_shufflevector(klo[t & 3], khi[t & 3], 0, 1, 2, 3, 4, 5, 6, 7));
                st[t / NC] = __builtin_amdgcn_mfma_scale_f32_32x32x64_f8f6f4(kf, qf[t % NC], (t % NC == 0) ? cinit : st[t / NC], 0, 0, 0, KSCALE, 0, 0x7f7f7f7f);
                if (t + 4 < NT) { if ((t & 3) == 0) K8_READ(0, t + 4); else if ((t & 3) == 1) K8_READ(1, t + 4); else if ((t & 3) == 2) K8_READ(2, t + 4); else K8_READ(3, t + 4); }
            }
#undef K8_READ
#undef K8_WAIT
        }
        u32x2 va[2][4];
#define V_READ(I, D) asm volatile("ds_read_b64_tr_b8 %0, %4 offset:%5\n\tds_read_b64_tr_b8 %1, %4 offset:%6\n\tds_read_b64_tr_b8 %2, %4 offset:%7\n\tds_read_b64_tr_b8 %3, %4 offset:%8" \
            : "=&v"(va[I][0]), "=&v"(va[I][1]), "=&v"(va[I][2]), "=&v"(va[I][3]) : "v"(vt_base), "n"(32 * (D)), "n"(16 * VS8 + 32 * (D)), "n"(32 * VS8 + 32 * (D)), "n"(48 * VS8 + 32 * (D)) : "memory")
#define V_WAIT(I, N) asm volatile("s_waitcnt lgkmcnt(%4)" : "+v"(va[I][0]), "+v"(va[I][1]), "+v"(va[I][2]), "+v"(va[I][3]) : "n"(N) : "memory")
        V_READ(0, 0); V_READ(1, 1);
        float tmax = -1e30f;
        const bool masked = NA && j >= p.nctx_tiles;
        if (masked) {
#pragma unroll
            for (int kb = 0; kb < 2; ++kb)
#pragma unroll
                for (int i = 0; i < 16; ++i) {
                    const int kc = 32 * kb + (i & 3) + 8 * (i >> 2) + 4 * hh; const bool inw = (kc >= csq) && (kc < csq + 16);
                    const int dc = min(max(kc - qc + 15, 0), 30); const float bias = rp[dr * 31 + dc];
                    const float sv = inw ? __builtin_fmaf(bias, 1.4426950408889634f, st[kb][i]) : -1e30f;
                    st[kb][i] = sv; tmax = fmaxf(tmax, sv); }
        } else {
#pragma unroll
            for (int kb = 0; kb < 2; ++kb)
#pragma unroll
                for (int i = 0; i < 16; ++i) tmax = fmaxf(tmax, st[kb][i]);
        }
        tmax = fmaxf(tmax, __shfl_xor(tmax, 32));
        if (j == 0 || __any(tmax > 4.f + PTHR)) {
            const float dm = (j == 0) ? (tmax - 4.f) : fmaxf(tmax - 4.f, 0.f);
            const float alpha = __builtin_amdgcn_exp2f(-dm);
            l_run *= alpha;
            if constexpr (LSUM) {
#pragma unroll
                for (int i = 0; i < 16; ++i) lacc[i] *= alpha; }
#pragma unroll
            for (int d = 0; d < 4; ++d)
#pragma unroll
                for (int i = 0; i < 16; ++i) oacc[d][i] *= alpha;
#pragma unroll
            for (int kb = 0; kb < 2; ++kb)
#pragma unroll
                for (int i = 0; i < 16; ++i) st[kb][i] -= dm;
            const float cn = cinit[0] - dm;
#pragma unroll
            for (int i = 0; i < 16; ++i) cinit[i] = cn;
        }
        float psum = 0.f;
#pragma unroll
        for (int kb = 0; kb < 2; ++kb)
#pragma unroll
            for (int i = 0; i < 16; ++i) { const float ex = __builtin_amdgcn_exp2f(st[kb][i]); st[kb][i] = ex; if constexpr (!LSUM) psum += ex; }
        l_run += psum;
        i32x8 pf;
#pragma unroll
        for (int v = 0; v < 8; ++v) { const int kb = v >> 2, m = v & 3;
            int t = __builtin_amdgcn_cvt_pk_fp8_f32(st[kb][4 * m], st[kb][4 * m + 1], 0, false); pf[v] = __builtin_amdgcn_cvt_pk_fp8_f32(st[kb][4 * m + 2], st[kb][4 * m + 3], t, true); }
        if constexpr (LSUM) { i32x8 ones; for (int v = 0; v < 8; ++v) ones[v] = 0x38383838;
            lacc = __builtin_amdgcn_mfma_scale_f32_32x32x64_f8f6f4(ones, pf, lacc, 0, 0, 0, 0x7f7f7f7f, 0, 0x7f7f7f7f); }
#pragma unroll
        for (int d = 0; d < 4; ++d) {
            if (d == 0) V_WAIT(0, 4); else if (d == 1) V_WAIT(1, 4); else if (d == 2) V_WAIT(0, 4); else V_WAIT(1, 0);
            const i32x8 vf = __builtin_bit_cast(i32x8, __builtin_shufflevector(__builtin_shufflevector(va[d & 1][0], va[d & 1][1], 0, 1, 2, 3), __builtin_shufflevector(va[d & 1][2], va[d & 1][3], 0, 1, 2, 3), 0, 1, 2, 3, 4, 5, 6, 7));
            oacc[d] = __builtin_amdgcn_mfma_scale_f32_32x32x64_f8f6f4(vf, pf, oacc[d], 0, 0, 0, 0x7f7f7f7f, 0, 0x7f7f7f7f);
            if (d == 0) V_READ(0, 2); else if (d == 1) V_READ(1, 3);
        }
#undef V_READ
#undef V_WAIT
    }
    const float lt = LSUM ? lacc[0] : (l_run + __shfl_xor(l_run, 32));
    const float il = 1.f / lt;
    unsigned char* op = p.O + (size_t)(p.orow0 + 32 * w + r) * p.ldo;
    const float ils = il * FP8_ASC;
#pragma unroll
    for (int d = 0; d < 4; ++d) {
        unsigned wq[4];
#pragma unroll
        for (int g = 0; g < 4; ++g) wq[g] = (unsigned)pk4_fp8(oacc[d][4 * g + 0] * ils, oacc[d][4 * g + 1] * ils, oacc[d][4 * g + 2] * ils, oacc[d][4 * g + 3] * ils);
        const auto s02 = __builtin_amdgcn_permlane32_swap(wq[0], wq[2], false, false), s13 = __builtin_amdgcn_permlane32_swap(wq[1], wq[3], false, false);
        *(u32x4*)(op + 32 * d + 16 * hh) = (u32x4){s02[0], s02[1], s13[0], s13[1]};
    }
    __syncthreads();
#undef A8_TILE_ROW
#undef A8_ISSUE
#undef A8_WRITE
}

DI int hg_tok_row(int b, int dir, int c, int t) {
    if (c < 8) { const int pos = 32 * c + t; return MXR + b * CTXL + (dir ? (CTXL - 1 - pos) : pos); }
    const int pos = 32 * (c - 8) + t; return b * SEQ + (dir ? (SEQ - 1 - pos) : pos);
}
DI void hgrn_pair(const Frame& F, const Args& a, int pair) {
    const int b = pair >> 3, h = pair & 7, dir = F.tid >> 8;
    const bf16_t* Z = (const bf16_t*)(a.ws + WS_Z);
    bf16_t* OUT = (bf16_t*)(a.ws + (dir ? WS_OB : WS_OF));
    LAS unsigned char* base = F.lds + dir * 65536;
    LAS float* G = (LAS float*)base;
    LAS unsigned char* QE1 = base + 16384;
    LAS unsigned char* KE = base + 25088;
    LAS unsigned char* QE2 = base + 33792;
    LAS unsigned char* KDr = base + 42496;
    LAS unsigned char* VVr = base + 51712;
    LAS float* DL = (LAS float*)(base + 60928);
    const int t256 = F.tid & 255, lane = F.lane, wl = F.wave & 3;
    const int tau = t256 >> 3, dq = (t256 & 7) * 16;
    LAS float* LB = (LAS float*)(base + 61440);
    if (t256 < 128) { const float* hl = a.in[I_HLB] + (size_t)dir * 3 * 1024 + h * 128 + t256; const float v0 = hl[0], v1 = hl[1024], v2 = hl[2048]; const float mx = fmaxf(v0, fmaxf(v1, v2));
        const float e0 = __expf(v0 - mx), e1 = __expf(v1 - mx), e2 = __expf(v2 - mx); LB[t256] = e0 / (e0 + e1 + e2); }
    __syncthreads();
    const int qcol = 1536 + h * 128 + dq, fcol = (dir ? 3584 : 2560) + h * 128 + dq, vcol = 4608 + h * 128 + dq;
    u32x4 rq[2], rf[2], rv[2];
#pragma unroll
    for (int g = 0; g < 2; ++g) {
        { const bf16_t* zr = Z + (size_t)hg_tok_row(b, dir, 0, tau) * EV_IN + 8 * g; rq[g] = *(const u32x4*)(zr + qcol); rf[g] = *(const u32x4*)(zr + fcol); rv[g] = *(const u32x4*)(zr + vcol); }
    }
    f32x4 S[2][8];
#pragma unroll
    for (int nb = 0; nb < 2; ++nb)
#pragma unroll
        for (int i = 0; i < 8; ++i) S[nb][i] = (f32x4){0.f, 0.f, 0.f, 0.f};
    const int fr = lane & 15, fg = lane >> 4;
    for (int c = 0; c < 72; ++c) {
        float kv[2][8], gv[2][8];
#pragma unroll
        for (int g = 0; g < 2; ++g) {
            const unsigned uf[4] = {rf[g].x, rf[g].y, rf[g].z, rf[g].w};
            const f32x4 lb0 = *(const LAS f32x4*)(LB + dq + 8 * g), lb1 = *(const LAS f32x4*)(LB + dq + 8 * g + 4); const float lbv[8] = {lb0[0], lb0[1], lb0[2], lb0[3], lb1[0], lb1[1], lb1[2], lb1[3]};
#pragma unroll
            for (int i = 0; i < 4; ++i) {
                const float f0 = bflo(uf[i]), f1 = bfhi(uf[i]);
                const float s0 = 1.f / (1.f + __expf(-f0)), s1 = 1.f / (1.f + __expf(-f1));
                const float l0 = lbv[2 * i], l1 = lbv[2 * i + 1];
                kv[g][2 * i] = (1.f - l0) * (1.f - s0); kv[g][2 * i + 1] = (1.f - l1) * (1.f - s1);
                gv[g][2 * i] = __logf(l0 + (1.f - l0) * s0); gv[g][2 * i + 1] = __logf(l1 + (1.f - l1) * s1); }
            *(LAS f32x4*)(G + tau * 128 + dq + 8 * g) = (f32x4){gv[g][0], gv[g][1], gv[g][2], gv[g][3]};
            *(LAS f32x4*)(G + tau * 128 + dq + 8 * g + 4) = (f32x4){gv[g][4], gv[g][5], gv[g][6], gv[g][7]}; }
        __syncthreads();
        if (t256 < 128) { float run = 0.f;
#pragma unroll
            for (int t = 0; t < 32; ++t) { run += G[t * 128 + t256]; G[t * 128 + t256] = run; } }
        __syncthreads();
#pragma unroll
        for (int g = 0; g < 2; ++g) { const int d0 = dq + 8 * g;
          const f32x4 c0 = *(const LAS f32x4*)(G + tau * 128 + d0), c1 = *(const LAS f32x4*)(G + tau * 128 + d0 + 4);
          const f32x4 m0 = *(const LAS f32x4*)(G + 15 * 128 + d0), m1 = *(const LAS f32x4*)(G + 15 * 128 + d0 + 4);
          const f32x4 e0 = *(const LAS f32x4*)(G + 31 * 128 + d0), e1 = *(const LAS f32x4*)(G + 31 * 128 + d0 + 4);
          float cu[8] = {c0[0], c0[1], c0[2], c0[3], c1[0], c1[1], c1[2], c1[3]};
          float mm[8] = {m0[0], m0[1], m0[2], m0[3], m1[0], m1[1], m1[2], m1[3]};
          float la[8] = {e0[0], e0[1], e0[2], e0[3], e1[0], e1[1], e1[2], e1[3]};
          const unsigned uq[4] = {rq[g].x, rq[g].y, rq[g].z, rq[g].w};
          float qv[8], q1[8], k1[8], q2[8], kd[8];
#pragma unroll
          for (int i = 0; i < 4; ++i) { qv[2 * i] = bflo(uq[i]); qv[2 * i + 1] = bfhi(uq[i]); }
#pragma unroll
          for (int i = 0; i < 8; ++i) { q1[i] = qv[i] * __expf(cu[i] - mm[i]); k1[i] = kv[g][i] * __expf(mm[i] - cu[i]); q2[i] = qv[i] * __expf(cu[i]); kd[i] = kv[g][i] * __expf(la[i] - cu[i]); }
          u32x4 o;
          o.x = pk2(q1[0], q1[1]); o.y = pk2(q1[2], q1[3]); o.z = pk2(q1[4], q1[5]); o.w = pk2(q1[6], q1[7]); *(LAS u32x4*)(QE1 + tau * 272 + d0 * 2) = o;
          o.x = pk2(k1[0], k1[1]); o.y = pk2(k1[2], k1[3]); o.z = pk2(k1[4], k1[5]); o.w = pk2(k1[6], k1[7]); *(LAS u32x4*)(KE + tau * 272 + d0 * 2) = o;
          o.x = pk2(q2[0], q2[1]); o.y = pk2(q2[2], q2[3]); o.z = pk2(q2[4], q2[5]); o.w = pk2(q2[6], q2[7]); *(LAS u32x4*)(QE2 + tau * 272 + d0 * 2) = o;
          o.x = pk2(kd[0], kd[1]); o.y = pk2(kd[2], kd[3]); o.z = pk2(kd[4], kd[5]); o.w = pk2(kd[6], kd[7]); *(LAS u32x4*)(KDr + tau * 288 + d0 * 2) = o;
          *(LAS u32x4*)(VVr + tau * 288 + d0 * 2) = rv[g];
          if (tau == 31) {
#pragma unroll
              for (int i = 0; i < 8; ++i) DL[d0 + i] = __expf(la[i]); } }
#pragma unroll
        for (int g = 0; g < 2; ++g) { const int cn = (c + 1 < 72) ? c + 1 : 71; const bf16_t* zr = Z + (size_t)hg_tok_row(b, dir, cn, tau) * EV_IN + 8 * g; rq[g] = *(const u32x4*)(zr + qcol); rf[g] = *(const u32x4*)(zr + fcol); rv[g] = *(const u32x4*)(zr + vcol); }
        __syncthreads();
        f32x4 X00 = {0.f, 0.f, 0.f, 0.f}, X01 = X00, X11 = X00;
#pragma unroll
        for (int ks = 0; ks < 4; ++ks) {
            const bf16x8 ke0 = *(const LAS bf16x8*)(KE + fr * 272 + (32 * ks + 8 * fg) * 2), ke1 = *(const LAS bf16x8*)(KE + (16 + fr) * 272 + (32 * ks + 8 * fg) * 2);
            const bf16x8 qe0 = *(const LAS bf16x8*)(QE1 + fr * 272 + (32 * ks + 8 * fg) * 2), qe1 = *(const LAS bf16x8*)(QE1 + (16 + fr) * 272 + (32 * ks + 8 * fg) * 2);
            X00 = __builtin_amdgcn_mfma_f32_16x16x32_bf16(ke0, qe0, X00, 0, 0, 0);
            X01 = __builtin_amdgcn_mfma_f32_16x16x32_bf16(ke0, qe1, X01, 0, 0, 0);
            X11 = __builtin_amdgcn_mfma_f32_16x16x32_bf16(ke1, qe1, X11, 0, 0, 0);
        }
#pragma unroll
        for (int i = 0; i < 4; ++i) { const bool keep = (4 * fg + i) <= fr; X00[i] = keep ? X00[i] : 0.f; X11[i] = keep ? X11[i] : 0.f; }
        u32x4 p0; p0.x = pk2(X00[0], X00[1]); p0.y = pk2(X00[2], X00[3]); p0.z = 0u; p0.w = 0u;
        u32x4 p1; p1.x = pk2(X01[0], X01[1]); p1.y = pk2(X01[2], X01[3]); p1.z = pk2(X11[0], X11[1]); p1.w = pk2(X11[2], X11[3]);
#pragma unroll
        for (int nb = 0; nb < 2; ++nb) {
            const int dvc = 32 * wl + 16 * nb;
            bf16x8 vf;
            { s16x4 v0, v1; const unsigned va = (unsigned)(size_t)VVr + (unsigned)((4 * fg + ((lane & 15) >> 2)) * 288 + (dvc + 4 * (lane & 3)) * 2);
              asm volatile("ds_read_b64_tr_b16 %0, %2\n\tds_read_b64_tr_b16 %1, %2 offset:4608\n\ts_waitcnt lgkmcnt(0)" : "=&v"(v0), "=&v"(v1) : "v"(va) : "memory");
              vf = __builtin_shufflevector(v0, v1, 0, 1, 2, 3, 4, 5, 6, 7); }
            f32x4 o0 = {0.f, 0.f, 0.f, 0.f}, o1 = o0;
            o0 = __builtin_amdgcn_mfma_f32_16x16x32_bf16(__builtin_bit_cast(bf16x8, p0), vf, o0, 0, 0, 0);
            o1 = __builtin_amdgcn_mfma_f32_16x16x32_bf16(__builtin_bit_cast(bf16x8, p1), vf, o1, 0, 0, 0);
#pragma unroll
            for (int ks = 0; ks < 4; ++ks) {
                u32x4 sp; sp.x = pk2(S[nb][2 * ks][0], S[nb][2 * ks][1]); sp.y = pk2(S[nb][2 * ks][2], S[nb][2 * ks][3]); sp.z = pk2(S[nb][2 * ks + 1][0], S[nb][2 * ks + 1][1]); sp.w = pk2(S[nb][2 * ks + 1][2], S[nb][2 * ks + 1][3]);
                const bf16x8 sf = __builtin_bit_cast(bf16x8, sp);
                const s16x4 a00 = *(const LAS s16x4*)(QE2 + fr * 272 + (32 * ks + 4 * fg) * 2), a01 = *(const LAS s16x4*)(QE2 + fr * 272 + (32 * ks + 16 + 4 * fg) * 2);
                const s16x4 a10 = *(const LAS s16x4*)(QE2 + (16 + fr) * 272 + (32 * ks + 4 * fg) * 2), a11 = *(const LAS s16x4*)(QE2 + (16 + fr) * 272 + (32 * ks + 16 + 4 * fg) * 2);
                o0 = __builtin_amdgcn_mfma_f32_16x16x32_bf16(__builtin_shufflevector(a00, a01, 0, 1, 2, 3, 4, 5, 6, 7), sf, o0, 0, 0, 0);
                o1 = __builtin_amdgcn_mfma_f32_16x16x32_bf16(__builtin_shufflevector(a10, a11, 0, 1, 2, 3, 4, 5, 6, 7), sf, o1, 0, 0, 0);
            }
#pragma unroll
            for (int db = 0; db < 8; ++db) {
                const f32x4 dl = *(const LAS f32x4*)(DL + 16 * db + 4 * fg);
                s16x4 k0, k1; { const unsigned ka = (unsigned)(size_t)KDr + (unsigned)((4 * fg + ((lane & 15) >> 2)) * 288 + (16 * db + 4 * (lane & 3)) * 2);
                  asm volatile("ds_read_b64_tr_b16 %0, %2\n\tds_read_b64_tr_b16 %1, %2 offset:4608\n\ts_waitcnt lgkmcnt(0)" : "=&v"(k0), "=&v"(k1) : "v"(ka) : "memory"); }
                f32x4 sc = S[nb][db] * dl;
                S[nb][db] = __builtin_amdgcn_mfma_f32_16x16x32_bf16(__builtin_shufflevector(k0, k1, 0, 1, 2, 3, 4, 5, 6, 7), vf, sc, 0, 0, 0);
            }
#pragma unroll
            for (int i = 0; i < 4; ++i) {
                OUT[(size_t)hg_tok_row(b, dir, c, 4 * fg + i) * 1024 + h * 128 + dvc + fr] = (bf16_t)(pk2(o0[i], 0.f) & 0xffffu);
                OUT[(size_t)hg_tok_row(b, dir, c, 16 + 4 * fg + i) * 1024 + h * 128 + dvc + fr] = (bf16_t)(pk2(o1[i], 0.f) & 0xffffu);
            }
        }
    }
    __syncthreads();
}

DI void hgrn_readout_phase(const Frame& F, const Args& a) {
    const bf16_t* OFp = (const bf16_t*)(a.ws + WS_OF); const bf16_t* OBp = (const bf16_t*)(a.ws + WS_OB);
    const bf16_t* Z = (const bf16_t*)(a.ws + WS_Z); unsigned char* Y = a.ws + WS_ACT;
    const float* wn = a.in[I_HON] + 16 * F.lane;
    float wv[16];
#pragma unroll
    for (int i = 0; i < 16; ++i) wv[i] = wn[i];
    for (int row = F.gw; row < MT; row += F.ngw) {
        const u32x4 f0 = *(const u32x4*)(OFp + (size_t)row * 1024 + 16 * F.lane), f1 = *(const u32x4*)(OFp + (size_t)row * 1024 + 16 * F.lane + 8);
        const u32x4 b0 = *(const u32x4*)(OBp + (size_t)row * 1024 + 16 * F.lane), b1 = *(const u32x4*)(OBp + (size_t)row * 1024 + 16 * F.lane + 8);
        const u32x4 g0 = *(const u32x4*)(Z + (size_t)row * EV_IN + 5632 + 16 * F.lane), g1 = *(const u32x4*)(Z + (size_t)row * EV_IN + 5632 + 16 * F.lane + 8);
        const unsigned uf[8] = {f0.x, f0.y, f0.z, f0.w, f1.x, f1.y, f1.z, f1.w}, ub[8] = {b0.x, b0.y, b0.z, b0.w, b1.x, b1.y, b1.z, b1.w}, ug[8] = {g0.x, g0.y, g0.z, g0.w, g1.x, g1.y, g1.z, g1.w};
        float o[16], gt[16]; float ss = 0.f;
#pragma unroll
        for (int i = 0; i < 8; ++i) { o[2 * i] = bflo(uf[i]) + bflo(ub[i]); o[2 * i + 1] = bfhi(uf[i]) + bfhi(ub[i]); gt[2 * i] = bflo(ug[i]); gt[2 * i + 1] = bfhi(ug[i]);
            ss += o[2 * i] * o[2 * i] + o[2 * i + 1] * o[2 * i + 1]; }
        ss += __shfl_xor(ss, 1); ss += __shfl_xor(ss, 2); ss += __shfl_xor(ss, 4);
        const float rs = __frsqrt_rn(ss * (1.f / 128.f) + EPS);
        unsigned pk[4];
#pragma unroll
        for (int i = 0; i < 4; ++i) { float y4[4];
#pragma unroll
            for (int e = 0; e < 4; ++e) y4[e] = o[4 * i + e] * rs * wv[4 * i + e] * silu_f(gt[4 * i + e]) * FP8_ASC;
            pk[i] = (unsigned)pk4_fp8(y4[0], y4[1], y4[2], y4[3]); }
        *(u32x4*)(Y + (size_t)row * DM + 1024 + 16 * F.lane) = (u32x4){pk[0], pk[1], pk[2], pk[3]};
    }
}

DI void mixer0_phase(const Frame& F, const Args& a) {
    for (int pair = F.wg; pair < 128; pair += F.G) hgrn_pair(F, a, pair);
    const bf16_t* Z = (const bf16_t*)(a.ws + WS_Z); unsigned char* Y = a.ws + WS_ACT;
    unsigned* qctr = (unsigned*)(a.ws + WS_CTL) + CW_QUEUE;
    volatile LAS unsigned* qslot = (volatile LAS unsigned*)(F.lds + LDS_MISC + 64);
    if (F.tid == 0) *qslot = __hip_atomic_fetch_add(qctr, 1u, __ATOMIC_RELAXED, __HIP_MEMORY_SCOPE_AGENT);
    __syncthreads();
    int u = (int)*qslot;
    while (u < 1024 + 128) {
        unsigned nxt = 0u;
        if (F.tid == 0) nxt = __hip_atomic_fetch_add(qctr, 1u, __ATOMIC_RELAXED, __HIP_MEMORY_SCOPE_AGENT);
        AttnP p{};
        p.ldq = EV_IN; p.ldk1 = EV_IN; p.K2 = nullptr; p.ldk2 = 0; p.ldv = EV_IN; p.ldo = DM; p.nctx_tiles = 4; p.xtile0 = 0;
        p.sc_log2e = 0.08838834764831845f * 1.4426950408889634f; p.rpb = nullptr; p.qgrow0 = 0;
        int b, head;
        if (u < 1024) { const int qb = u & 7; head = (u >> 3) & 7; b = u >> 6; p.qrow0 = b * SEQ + 256 * qb; p.nx_tiles = 32; }
        else { const int v = u - 1024; head = v & 7; b = v >> 3; p.qrow0 = MXR + b * CTXL; p.nx_tiles = 0; }
        const int kvh = head >> 2;
        p.b = b; p.orow0 = p.qrow0;
        p.Q = Z + head * 128; p.K1 = Z + 1024 + kvh * 128; p.V = Z + 1280 + kvh * 128; p.O = Y + head * 128;
        const AttnQK8 e{a.ws + WS_Q8 + head * 128, 1024, a.ws + WS_K8 + kvh * 128, 256, nullptr, 0, a.ws + WS_V8G + kvh * 128, 256};
        attn_unit_f8<128, false>(F, p, e);
        if (F.tid == 0) *qslot = nxt;
        __syncthreads();
        u = (int)*qslot;
    }
}

DI void rope64(float& v, int lane, int t, float inv16) {
    const float pv = __shfl_xor(v, 16);
    const int pos = (lane < 32) ? (t >> 6) : (t & 63);
    const float ang = (float)pos * inv16;
    const float sn = __sinf(ang), cs = __cosf(ang);
    const float sg = ((lane & 16) == 0) ? -1.f : 1.f;
    v = v * cs + sg * pv * sn;
}
DI void mla_prep_phase(const Frame& F, const Args& a) {
    bf16_t* Z = (bf16_t*)(a.ws + WS_Z);
    const float inv16 = exp2f(-(float)(F.lane & 15) * (13.287712379549449f / 16.f));
    f32x4 wq0 = *(const f32x4*)(a.in[I_MQN] + 8 * F.lane), wq1 = *(const f32x4*)(a.in[I_MQN] + 8 * F.lane + 4);
    f32x4 wk0 = *(const f32x4*)(a.in[I_MKVN] + 8 * F.lane), wk1 = *(const f32x4*)(a.in[I_MKVN] + 8 * F.lane + 4);
    for (int row = F.gw; row < MT; row += F.ngw) {
        bf16_t* zr = Z + (size_t)row * OD_INP;
#pragma unroll
        for (int part = 0; part < 2; ++part) {
            bf16_t* p = zr + 3072 + part * 512 + 8 * F.lane;
            const u32x4 u = *(const u32x4*)p; const unsigned uu[4] = {u.x, u.y, u.z, u.w};
            float v[8]; float ss = 0.f;
#pragma unroll
            for (int i = 0; i < 4; ++i) { v[2 * i] = bflo(uu[i]); v[2 * i + 1] = bfhi(uu[i]); ss += v[2 * i] * v[2 * i] + v[2 * i + 1] * v[2 * i + 1]; }
            const float rs = __frsqrt_rn(wave_sum(ss) * (1.f / 512.f) + EPS);
            const f32x4 w0 = part ? wk0 : wq0, w1 = part ? wk1 : wq1;
            u32x2 o; o.x = (unsigned)pk4_fp8(v[0] * rs * w0[0] * FP8_ASC, v[1] * rs * w0[1] * FP8_ASC, v[2] * rs * w0[2] * FP8_ASC, v[3] * rs * w0[3] * FP8_ASC);
            o.y = (unsigned)pk4_fp8(v[4] * rs * w1[0] * FP8_ASC, v[5] * rs * w1[1] * FP8_ASC, v[6] * rs * w1[2] * FP8_ASC, v[7] * rs * w1[3] * FP8_ASC);
            *(u32x2*)(a.ws + WS_ACT + (size_t)part * MT * 512 + (size_t)row * 512 + 8 * F.lane) = o;
        }
        { float v = __uint_as_float((unsigned)zr[4096 + F.lane] << 16); if (row < MXR) rope64(v, F.lane, row & 2047, inv16);
          (a.ws + WS_K8R)[(size_t)row * 64 + F.lane] = (unsigned char)(pk4_fp8(v * QK8_SC, 0.f, 0.f, 0.f) & 0xff); }
    }
}
DI void mla_qrope_phase(const Frame& F, const Args& a) {
    bf16_t* Q = (bf16_t*)(a.ws + WS_QUP);
    const float inv16 = exp2f(-(float)(F.lane & 15) * (13.287712379549449f / 16.f));
    unsigned short nx[8];
    if (F.gw < MXR) {
#pragma unroll
        for (int h = 0; h < 8; ++h) nx[h] = Q[(size_t)F.gw * 1536 + h * 192 + 128 + F.lane]; }
    for (int row = F.gw; row < MXR; row += F.ngw) {
        bf16_t* qr = Q + (size_t)row * 1536;
        unsigned short cu[8];
#pragma unroll
        for (int h = 0; h < 8; ++h) cu[h] = nx[h];
        { const int nrow = (row + F.ngw < MXR) ? row + F.ngw : row;
#pragma unroll
          for (int h = 0; h < 8; ++h) nx[h] = Q[(size_t)nrow * 1536 + h * 192 + 128 + F.lane]; }
#pragma unroll
        for (int h = 0; h < 8; ++h) { float v = __uint_as_float((unsigned)cu[h] << 16); rope64(v, F.lane, row & 2047, inv16); qr[h * 192 + 128 + F.lane] = (bf16_t)(pk2(v, 0.f) & 0xffffu); }
    }
}

DI void mixer1_phase(const Frame& F, const Args& a) {
    const bf16_t* Z = (const bf16_t*)(a.ws + WS_Z); unsigned char* Y = a.ws + WS_ACT;
    const bf16_t* QUP = (const bf16_t*)(a.ws + WS_QUP); const bf16_t* KVUP = (const bf16_t*)(a.ws + WS_KVUP);
    unsigned* qctr = (unsigned*)(a.ws + WS_CTL) + CW_QUEUE2;
    volatile LAS unsigned* qslot = (volatile LAS unsigned*)(F.lds + LDS_MISC + 64);
    if (F.tid == 0) *qslot = __hip_atomic_fetch_add(qctr, 1u, __ATOMIC_RELAXED, __HIP_MEMORY_SCOPE_AGENT);
    __syncthreads();
    int u = (int)*qslot;
    while (u < 1024) {
        unsigned nxt = 0u;
        if (F.tid == 0) nxt = __hip_atomic_fetch_add(qctr, 1u, __ATOMIC_RELAXED, __HIP_MEMORY_SCOPE_AGENT);
        AttnP p{};
        const int qb = u & 7, head = (u >> 3) & 7, b = u >> 6;
        p.b = b; p.qrow0 = b * SEQ + 256 * qb; p.orow0 = p.qrow0; p.ldo = DM; p.nctx_tiles = 4;
        p.Q = QUP + head * 192; p.ldq = 1536; p.K1 = KVUP + head * 256; p.ldk1 = 2048; p.K2 = Z + 4096; p.ldk2 = OD_INP; p.V = KVUP + head * 256 + 128; p.ldv = 2048;
        p.O = Y + 1024 + head * 128; p.xtile0 = 0; p.nx_tiles = 32; p.sc_log2e = 0.07216878364870323f * 1.4426950408889634f; p.rpb = nullptr; p.qgrow0 = 0;
        const AttnQK8 e{nullptr, 0, a.ws + WS_K8N + head * 128, 1024, a.ws + WS_K8R, 64, a.ws + WS_V8M + head * 128, 1024};
        attn_unit_f8<192, true, false, true>(F, p, e);
        if (F.tid == 0) *qslot = nxt;
        __syncthreads();
        u = (int)*qslot;
    }
    while (u < 2048) {
        unsigned nxt = 0u;
        if (F.tid == 0) nxt = __hip_atomic_fetch_add(qctr, 1u, __ATOMIC_RELAXED, __HIP_MEMORY_SCOPE_AGENT);
        AttnP p{};
        const int v = u - 1024, qb = v & 7, head = (v >> 3) & 7, b = v >> 6;
        p.b = b; p.qrow0 = b * SEQ + 256 * qb; p.orow0 = p.qrow0; p.ldo = DM; p.nctx_tiles = 4;
        p.Q = Z + head * 128; p.ldq = OD_INP; p.K1 = Z + 1024 + head * 128; p.ldk1 = OD_INP; p.K2 = nullptr; p.ldk2 = 0; p.V = Z + 2048 + head * 128; p.ldv = OD_INP;
        p.O = Y + head * 128; p.sc_log2e = 0.08838834764831845f * 1.4426950408889634f; p.rpb = a.in[I_RPB] + head * 15 * 31; p.qgrow0 = 4 * qb;
        const int rlo = min(max(4 * qb - 4, 0), 24), rhi = min(max(4 * qb + 3 - 4, 0), 24) + 8;
        p.xtile0 = rlo; p.nx_tiles = rhi - rlo;
        const AttnQK8 e{nullptr, 0, a.ws + WS_K8NA + head * 128, 1024, nullptr, 0, a.ws + WS_V8NA + head * 128, 1024};
        attn_unit_f8<128, true, true>(F, p, e);
        if (F.tid == 0) *qslot = nxt;
        __syncthreads();
        u = (int)*qslot;
    }
}

#define CEX(a, b) do { const float _hi = fmaxf(a, b), _lo = fminf(a, b); a = _hi; b = _lo; } while (0)
DI void bitonic_merge16(float (&c)[16]) {
#pragma unroll
    for (int st = 8; st >= 1; st >>= 1)
#pragma unroll
        for (int i = 0; i < 16; ++i) if ((i & st) == 0) CEX(c[i], c[i + st]);
}
DI void sort16_desc(float (&a)[16]) {
#pragma unroll
    for (int k = 2; k <= 16; k <<= 1)
#pragma unroll
        for (int j = k >> 1; j >= 1; j >>= 1)
#pragma unroll
            for (int i = 0; i < 16; ++i) { const int l = i ^ j; if (l > i) { const bool desc = (i & k) == 0;
                const float hi = fmaxf(a[i], a[l]), lo = fminf(a[i], a[l]); a[i] = desc ? hi : lo; a[l] = desc ? lo : hi; } }
}
DI void insert16(float (&a)[16], float x) {
#pragma unroll
    for (int i = 0; i < 16; ++i) { const float hi = fmaxf(a[i], x); x = fminf(a[i], x); a[i] = hi; }
}
struct CandTab { int ci[50], cj[50];
    constexpr CandTab() : ci{}, cj{} { int n = 0; for (int i = 0; i < 16; ++i) for (int j = 0; j < 16; ++j) if ((i + 1) * (j + 1) <= 16) { ci[n] = i; cj[n] = j; ++n; } } };
DI void peer_topk_wave(const Frame& F, const bf16_t* PQ, const LAS unsigned char* keysL  , int tok0, int head, int* eidx, float* gate, LAS unsigned char* scr  ) {
    const int lane = F.lane, r = lane & 31, hh = lane >> 5;
    float top[2][16];
#pragma unroll
    for (int p = 0; p < 2; ++p) {
        f32x16 st[4];
#pragma unroll
        for (int kb = 0; kb < 4; ++kb) for (int i = 0; i < 16; ++i) st[kb][i] = 0.f;
        const bf16_t* qp = PQ + (size_t)(tok0 + r) * DM + head * 256 + p * 128 + 8 * hh;
        const LAS unsigned char* kp = keysL + p * (128 * 272) + r * 272 + 16 * hh;
#pragma unroll 2
        for (int ks = 0; ks < 8; ++ks) {
            const bf16x8 qf = *(const bf16x8*)(qp + 16 * ks);
#pragma unroll
            for (int kb = 0; kb < 4; ++kb) { const bf16x8 kf = *(const LAS bf16x8*)(kp + kb * (32 * 272) + 32 * ks);
                st[kb] = __builtin_amdgcn_mfma_f32_32x32x16_bf16(kf, qf, st[kb], 0, 0, 0); }
        }
        float blk[4][16];
#pragma unroll
        for (int kb = 0; kb < 4; ++kb) {
#pragma unroll
            for (int i = 0; i < 16; ++i) { const unsigned key = 32 * kb + (i & 3) + 8 * (i >> 2) + 4 * hh; blk[kb][i] = __uint_as_float((__float_as_uint(st[kb][i]) & 0xffffff80u) | key); }
            sort16_desc(blk[kb]);
        }
        float m01[16], m23[16], aa[16];
#pragma unroll
        for (int i = 0; i < 16; ++i) { m01[i] = fmaxf(blk[0][i], blk[1][15 - i]); m23[i] = fmaxf(blk[2][i], blk[3][15 - i]); }
        bitonic_merge16(m01); bitonic_merge16(m23);
#pragma unroll
        for (int i = 0; i < 16; ++i) aa[i] = fmaxf(m01[i], m23[15 - i]);
        bitonic_merge16(aa);
        float cc[16];
#pragma unroll
        for (int i = 0; i < 16; ++i) cc[i] = fmaxf(aa[i], __shfl_xor(aa[15 - i], 32));
        bitonic_merge16(cc);
#pragma unroll
        for (int i = 0; i < 16; ++i) top[p][i] = cc[i];
    }
    LAS unsigned char* my = scr + r * 32;
#pragma unroll
    for (int p = 0; p < 2; ++p)
#pragma unroll
        for (int q4 = 0; q4 < 4; ++q4) { unsigned wv = 0;
#pragma unroll
            for (int e = 0; e < 4; ++e) wv |= (__float_as_uint(top[p][4 * q4 + e]) & 0x7fu) << (8 * e);
            *(LAS unsigned*)(my + p * 16 + 4 * q4) = wv; }
    float va[16], vb[16];
#pragma unroll
    for (int i = 0; i < 16; ++i) { va[i] = __uint_as_float(__float_as_uint(top[0][i]) & 0xffffff80u); vb[i] = __uint_as_float(__float_as_uint(top[1][i]) & 0xffffff80u); }
    float cd[16];
#pragma unroll
    for (int i = 0; i < 16; ++i) cd[i] = -3.0e38f;
#pragma unroll
    for (int k = 0; k < 25; ++k) {
        constexpr CandTab T{};
        const int i0 = T.ci[2 * k], j0 = T.cj[2 * k], i1 = T.ci[2 * k + 1], j1 = T.cj[2 * k + 1];
        const float s0 = va[i0] + vb[j0], s1 = va[i1] + vb[j1];
        const float x0 = __uint_as_float((__float_as_uint(s0) & 0xffffff00u) | (unsigned)(i0 * 16 + j0));
        const float x1 = __uint_as_float((__float_as_uint(s1) & 0xffffff00u) | (unsigned)(i1 * 16 + j1));
        insert16(cd, hh ? x1 : x0);
    }
    float cc[16];
#pragma unroll
    for (int i = 0; i < 16; ++i) cc[i] = fmaxf(cd[i], __shfl_xor(cd[15 - i], 32));
    bitonic_merge16(cc);
    float sv[16]; float den = 0.f;
    const float mx = __uint_as_float(__float_as_uint(cc[0]) & 0xffffff00u);
#pragma unroll
    for (int i = 0; i < 16; ++i) { sv[i] = __expf(__uint_as_float(__float_as_uint(cc[i]) & 0xffffff00u) - mx); den += sv[i]; }
    const float iden = 1.f / den;
    asm volatile("s_waitcnt lgkmcnt(0)" ::: "memory");
    if (hh == 0) {
        int* ep = eidx + (size_t)(tok0 + r) * 128 + head * 16; float* gp = gate + (size_t)(tok0 + r) * 128 + head * 16;
#pragma unroll
        for (int q4 = 0; q4 < 4; ++q4) { int ev[4]; float gv[4];
#pragma unroll
            for (int e = 0; e < 4; ++e) { const unsigned code = __float_as_uint(cc[4 * q4 + e]) & 0xffu; const unsigned ia = my[code >> 4], ib = my[16 + (code & 15u)];
                ev[e] = (int)(ia * 128u + ib); gv[e] = sv[4 * q4 + e] * iden; }
            *(int4*)(ep + 4 * q4) = make_int4(ev[0], ev[1], ev[2], ev[3]); *(f32x4*)(gp + 4 * q4) = (f32x4){gv[0], gv[1], gv[2], gv[3]}; }
    }
}
DI void peer_topk_phase(const Frame& F, const Args& a, int layer, int ntok) {
    const bf16_t* PQ = (const bf16_t*)(a.ws + WS_PQ); const int head = F.wg & 7;
    const bf16_t* keys = (const bf16_t*)(a.ws + WS_KEYS) + ((size_t)layer * 8 + head) * 2 * 128 * 128;
    int* eidx = (int*)(a.ws + WS_EIDX); float* gate = (float*)(a.ws + WS_GATE);
    LAS unsigned char* keysL = F.lds; LAS unsigned char* scr = F.lds + 2 * 128 * 272 + F.wave * 2048;
    for (int c = F.tid; c < 2 * 128 * 16; c += 512) { const int row = c >> 4, ch = c & 15; *(LAS u32x4*)(keysL + row * 272 + 16 * ch) = *(const u32x4*)(keys + (size_t)row * 128 + 8 * ch); }
    __syncthreads();
    const int nblk = ntok / 256;
    for (int blk = F.wg >> 3; blk < nblk; blk += F.G >> 3) peer_topk_wave(F, PQ, keysL, 256 * blk + 32 * F.wave, head, eidx, gate, scr);
    __syncthreads();
}

typedef __bf16 bf16p __attribute__((ext_vector_type(2)));
DI float fp6_dot32(const u32x6 r, const unsigned (&xw)[16]) {
    const bf16x32v d = __builtin_amdgcn_cvt_scalef32_pk32_bf16_fp6(r, 1.0f);
    float d0 = 0.f, d1 = 0.f;
#pragma unroll
    for (int i = 0; i < 8; ++i) {
        const bf16p lo = {d[4 * i], d[4 * i + 1]}, hi = {d[4 * i + 2], d[4 * i + 3]};
        d0 = __builtin_amdgcn_fdot2_f32_bf16(lo, __builtin_bit_cast(bf16p, xw[2 * i]), d0, false);
        d1 = __builtin_amdgcn_fdot2_f32_bf16(hi, __builtin_bit_cast(bf16p, xw[2 * i + 1]), d1, false);
    }
    return d0 + d1;
}
DI void fp6_axpy32(const u32x6 r, float w, f32x2 (&acc)[16]) {
    const f32x32v d = __builtin_amdgcn_cvt_scalef32_pk32_f32_fp6(r, 1.0f);
    const f32x2 w2 = {w, w};
#pragma unroll
    for (int i = 0; i < 16; ++i) { const f32x2 v2 = {d[2 * i], d[2 * i + 1]}; acc[i] = __builtin_elementwise_fma(w2, v2, acc[i]); }
}
typedef _Float16 h16x2 __attribute__((ext_vector_type(2)));
typedef _Float16 h16x32 __attribute__((ext_vector_type(32)));
constexpr float VW_SC = 64.f;
DI void fp6_axpy32_h(const u32x6 r, unsigned wbits  , h16x2 (&acc)[16]) {
    const h16x32 d = __builtin_amdgcn_cvt_scalef32_pk32_f16_fp6(r, 1.0f);
    const h16x2 w2 = __builtin_bit_cast(h16x2, wbits);
#pragma unroll
    for (int i = 0; i < 16; ++i) { const h16x2 v2 = {d[2 * i], d[2 * i + 1]}; acc[i] = __builtin_elementwise_fma(w2, v2, acc[i]); }
}
DI unsigned h2add(unsigned a, unsigned b) { const h16x2 r = __builtin_bit_cast(h16x2, a) + __builtin_bit_cast(h16x2, b); return __builtin_bit_cast(unsigned, r); }
DI u32x6 ld_row24(const unsigned char* p) { const u32x4 a = *(const u32x4*)p; const u32x2 b = *(const u32x2*)(p + 16); return (u32x6){a.x, a.y, a.z, a.w, b.x, b.y}; }
template <bool FINAL>
DI void peer_gather_phase(const Frame& F, const Args& a, int layer, int ntok) {
    const bf16_t* Fa = (const bf16_t*)(a.ws + WS_ACT); const unsigned char* U = a.ws + WS_U; const unsigned char* V = a.ws + WS_V;
    const float* SU = (const float*)(a.ws + WS_SU); const float* SV = (const float*)(a.ws + WS_SV);
    const int* eidx = (const int*)(a.ws + WS_EIDX); const float* gate = (const float*)(a.ws + WS_GATE);
    bf16_t* H = (bf16_t*)(a.ws + WS_H); float* HP = (float*)(a.ws + WS_HP);
    const float* modx = (const float*)(a.ws + WS_MODX) + (size_t)layer * 16 * 12288; const float* modc = (const float*)(a.ws + WS_MODC) + (size_t)layer * 12288;
    const int lane = F.lane, g8 = lane >> 3, p8 = lane & 7;
    LAS float* hpL = (LAS float*)(F.lds + F.wave * 13824); LAS unsigned short* eiL = (LAS unsigned short*)(F.lds + F.wave * 13824 + 18 * 512);
#pragma unroll 1
    for (int s = 0; s < 8; ++s) {
        const unsigned char* Us = U + (size_t)s * 16384 * SLB; const unsigned lo8 = 24u * (unsigned)p8;
#pragma unroll 1
        for (int tok = F.gw, kt = 0; tok < ntok; tok += F.ngw, ++kt) {
            unsigned xw[16];
            { const bf16_t* xp = Fa + (size_t)tok * DM + 256 * s + 32 * p8;
              const u32x4 x0 = *(const u32x4*)xp, x1 = *(const u32x4*)(xp + 8), x2 = *(const u32x4*)(xp + 16), x3 = *(const u32x4*)(xp + 24);
              xw[0] = x0.x; xw[1] = x0.y; xw[2] = x0.z; xw[3] = x0.w; xw[4] = x1.x; xw[5] = x1.y; xw[6] = x1.z; xw[7] = x1.w;
              xw[8] = x2.x; xw[9] = x2.y; xw[10] = x2.z; xw[11] = x2.w; xw[12] = x3.x; xw[13] = x3.y; xw[14] = x3.z; xw[15] = x3.w; }
            if (s == 0) { const int tp = 8 * (lane & 7) + (lane >> 3);
                eiL[kt * 128 + tp] = (unsigned short)eidx[(size_t)tok * 128 + lane]; eiL[kt * 128 + 64 + tp] = (unsigned short)eidx[(size_t)tok * 128 + 64 + lane]; }
            float hs[2] = {0.f, 0.f};
#pragma unroll
            for (int half = 0; half < 2; ++half) {
                u32x6 ra[8];
                const u32x4 ew = *(const LAS u32x4*)(eiL + kt * 128 + 64 * half + 8 * g8);
#pragma unroll
                for (int i = 0; i < 8; ++i) { const unsigned e = (i & 1) ? (ew[i >> 1] >> 16) : (ew[i >> 1] & 0xffffu); ra[i] = ld_row24(Us + (e * (unsigned)SLB + lo8)); }
                float d8[8];
#pragma unroll
                for (int i = 0; i < 8; ++i) d8[i] = fp6_dot32(ra[i], xw);
                float b4[4], c2[2];
                { const bool bit = (lane & 4) != 0;
#pragma unroll
                  for (int k = 0; k < 4; ++k) { const float kp = bit ? d8[4 + k] : d8[k], snd = bit ? d8[k] : d8[4 + k]; b4[k] = kp + __shfl_xor(snd, 4); } }
                { const bool bit = (lane & 2) != 0;
#pragma unroll
                  for (int k = 0; k < 2; ++k) { const float kp = bit ? b4[2 + k] : b4[k], snd = bit ? b4[k] : b4[2 + k]; c2[k] = kp + __shfl_xor(snd, 2); } }
                { const bool bit = (lane & 1) != 0; const float kp = bit ? c2[1] : c2[0], snd = bit ? c2[0] : c2[1]; hs[half] = kp + __shfl_xor(snd, 1); }
            }
            LAS float* hp = hpL + kt * 128 + lane;
            if (s > 0) { hs[0] += hp[0]; hs[1] += hp[64]; }
            hp[0] = hs[0]; hp[64] = hs[1];
        }
    }
#pragma unroll 1
    for (int s = 0; s < 8; ++s) {
        const unsigned char* Vs = V + (size_t)s * 16384 * SLB; const unsigned lo8 = 24u * (unsigned)p8;
#pragma unroll 1
        for (int tok = F.gw, kt = 0; tok < ntok; tok += F.ngw, ++kt) {
            LAS float* hp = hpL + kt * 128;
            if (s == 0) { const int e0 = eiL[kt * 128 + lane], e1 = eiL[kt * 128 + 64 + lane]; const int pp = 8 * (lane & 7) + (lane >> 3);
                const _Float16 w0h = (_Float16)(gate[(size_t)tok * 128 + pp] * gelu_tanh(hp[lane] * SU[e0]) * (SV[e0] * VW_SC)), w1h = (_Float16)(gate[(size_t)tok * 128 + 64 + pp] * gelu_tanh(hp[64 + lane] * SU[e1]) * (SV[e1] * VW_SC));
                ((LAS unsigned*)hp)[lane] = __builtin_bit_cast(unsigned, (h16x2){w0h, w0h}); ((LAS unsigned*)hp)[64 + lane] = __builtin_bit_cast(unsigned, (h16x2){w1h, w1h}); }
            h16x2 acc[16];
#pragma unroll
            for (int i = 0; i < 16; ++i) acc[i] = (h16x2){(_Float16)0.f, (_Float16)0.f};
#pragma unroll
            for (int half = 0; half < 2; ++half) {
                u32x6 ra[8]; unsigned wj[8];
                const u32x4 ew = *(const LAS u32x4*)(eiL + kt * 128 + 64 * half + 8 * g8);
                const u32x4 wa = *(const LAS u32x4*)(hp + 64 * half + 8 * g8), wb = *(const LAS u32x4*)(hp + 64 * half + 8 * g8 + 4);
#pragma unroll
                for (int i = 0; i < 8; ++i) { const unsigned e = (i & 1) ? (ew[i >> 1] >> 16) : (ew[i >> 1] & 0xffffu); wj[i] = (i < 4) ? wa[i & 3] : wb[i & 3]; ra[i] = ld_row24(Vs + (e * (unsigned)SLB + lo8)); }
#pragma unroll
                for (int i = 0; i < 8; ++i) fp6_axpy32_h(ra[i], wj[i], acc);
            }
            unsigned P[16], Q[8], R[4], T[2]; f32x4 r4;
#pragma unroll
            for (int k = 0; k < 16; ++k) P[k] = __builtin_bit_cast(unsigned, acc[k]);
            { const bool bit = (lane & 32) != 0;
#pragma unroll
              for (int k = 0; k < 8; ++k) { const unsigned snd = bit ? P[k] : P[8 + k], kp = bit ? P[8 + k] : P[k]; Q[k] = h2add(kp, (unsigned)__shfl_xor((int)snd, 32)); } }
            { const bool bit = (lane & 16) != 0;
#pragma unroll
              for (int k = 0; k < 4; ++k) { const unsigned snd = bit ? Q[k] : Q[4 + k], kp = bit ? Q[4 + k] : Q[k]; R[k] = h2add(kp, (unsigned)__shfl_xor((int)snd, 16)); } }
            { const bool bit = (lane & 8) != 0;
#pragma unroll
              for (int k = 0; k < 2; ++k) { const unsigned snd = bit ? R[k] : R[2 + k], kp = bit ? R[2 + k] : R[k]; T[k] = h2add(kp, (unsigned)__shfl_xor((int)snd, 8)); } }
            { const h16x2 t0 = __builtin_bit_cast(h16x2, T[0]), t1 = __builtin_bit_cast(h16x2, T[1]);
              r4 = (f32x4){(float)t0[0], (float)t0[1], (float)t1[0], (float)t1[1]} * (1.f / VW_SC); }
            const float* g5 = ((tok < MXR) ? (modx + (size_t)(tok >> 11) * 12288) : modc) + 5 * DM;
            const int col = 256 * s + 32 * p8 + 4 * g8;
            bf16_t* hrow = H + (size_t)tok * DM;
            const u32x2 hb = *(const u32x2*)(hrow + col); const f32x4 h4 = {bflo(hb.x), bfhi(hb.x), bflo(hb.y), bfhi(hb.y)}, gg = *(const f32x4*)(g5 + col);
            { const f32x4 y4 = h4 + gg * r4; u32x2 ob; ob.x = pk2(y4[0], y4[1]); ob.y = pk2(y4[2], y4[3]); *(u32x2*)(hrow + col) = ob; }
            if (!FINAL && s == 7) {
                asm volatile("s_waitcnt vmcnt(0)" ::: "memory");
                f32x4 v[8]; float ss = 0.f;
#pragma unroll
                for (int j = 0; j < 8; ++j) { const u32x2 hb2 = *(const u32x2*)(hrow + 4 * (lane + 64 * j)); v[j] = (f32x4){bflo(hb2.x), bfhi(hb2.x), bflo(hb2.y), bfhi(hb2.y)}; ss += v[j][0] * v[j][0] + v[j][1] * v[j][1] + v[j][2] * v[j][2] + v[j][3] * v[j][3]; }
                const float rs = __frsqrt_rn(wave_sum(ss) * (1.f / DM) + EPS);
                const float* nw = a.in[I_N1W] + (size_t)(layer + 1) * DM;
                const float* mod1 = (tok < MXR) ? ((const float*)(a.ws + WS_MODX) + ((size_t)(layer + 1) * 16 + (tok >> 11)) * 12288) : ((const float*)(a.ws + WS_MODC) + (size_t)(layer + 1) * 12288);
                bf16_t* ao = (bf16_t*)(a.ws + WS_ACT) + (size_t)tok * DM;
#pragma unroll
                for (int j = 0; j < 8; ++j) { const int cc = 4 * (lane + 64 * j); const f32x4 w4 = *(const f32x4*)(nw + cc), sh = *(const f32x4*)(mod1 + cc), sc4 = *(const f32x4*)(mod1 + DM + cc);
                    f32x4 y;
#pragma unroll
                    for (int e = 0; e < 4; ++e) y[e] = (v[j][e] * rs * w4[e]) * (1.f + sc4[e]) + sh[e];
                    *(int*)((unsigned char*)(a.ws + WS_A8) + (size_t)tok * DM + cc) = pk4_fp8(y[0] * FP8_ASC, y[1] * FP8_ASC, y[2] * FP8_ASC, y[3] * FP8_ASC); }
            }
            if (FINAL && s == 7) {
                asm volatile("s_waitcnt vmcnt(0)" ::: "memory");
                f32x4 v[8]; float ss = 0.f;
#pragma unroll
                for (int j = 0; j < 8; ++j) { const u32x2 hb2 = *(const u32x2*)(hrow + 4 * (lane + 64 * j)); v[j] = (f32x4){bflo(hb2.x), bfhi(hb2.x), bflo(hb2.y), bfhi(hb2.y)}; ss += v[j][0] * v[j][0] + v[j][1] * v[j][1] + v[j][2] * v[j][2] + v[j][3] * v[j][3]; }
                const float rs = __frsqrt_rn(wave_sum(ss) * (1.f / DM) + EPS);
                const float* fw = a.in[I_FNW]; float* op = a.out + (size_t)tok * DM;
#pragma unroll
                for (int j = 0; j < 8; ++j) { const int cc = 4 * (lane + 64 * j); const f32x4 w4 = *(const f32x4*)(fw + cc);
                    f32x4 ov = v[j] * rs * w4;
#if DBG_SANITIZE
                    for (int e = 0; e < 4; ++e) if (!(fabsf(ov[e]) < 1e30f)) ov[e] = 1.0e4f;
#endif
                    *(f32x4*)(op + cc) = ov; }
            }
        }
    }
}

__global__ void __launch_bounds__(512, 2) fwd_kernel(Args args) {
    extern __shared__ __attribute__((aligned(16))) unsigned char lds_raw[];
    Frame F;
    F.lds = (LAS unsigned char*)lds_raw;
    F.tid = threadIdx.x; F.lane = F.tid & 63; F.wave = __builtin_amdgcn_readfirstlane(F.tid >> 6);
    F.G = gridDim.x; F.wg = blockIdx.x; F.gw = F.wg * 8 + F.wave; F.ngw = F.G * 8;
    volatile LAS unsigned* MISC = (volatile LAS unsigned*)(F.lds + LDS_MISC);
    if (F.tid < 4) MISC[F.tid] = 0u;
    __syncthreads();
    unsigned char* ws = args.ws;
    const int lo = args.ph_lo, hi = args.ph_hi;
    XcdBarrier bar; bar.bar = (unsigned*)(ws + WS_CTL) + CW_BAR; bar.x = 0; bar.st = nullptr;
    if (hi - lo > 1) bar = xcd_barrier_post((unsigned*)(ws + WS_CTL) + CW_BAR, MISC);
#ifndef PH_MASK
#define PH_MASK 0xffffffffu
#endif
#define IN(k) ((((PH_MASK) >> (k)) & 1u) && lo <= (k) && (k) < hi)
#define SEAM(k) do { if (IN(k) && IN((k) + 1)) xcd_barrier(bar); } while (0)
    const float* modx = (const float*)(ws + WS_MODX); const float* modc = (const float*)(ws + WS_MODC);
    bf16_t* ACT = (bf16_t*)(ws + WS_ACT); bf16_t* H = (bf16_t*)(ws + WS_H); bf16_t* Z = (bf16_t*)(ws + WS_Z);

#define REP2(k) if (((DBG_REPMASK) >> (k)) & 1u)
#define P0_BODY  { prologue(F, args); }
#define P1_BODY  { norm_mod_phase<false, true>(F, args.in[I_X], args.in[I_CTX], args.in[I_N1W], modx, modc, 0, ACT, MT); }
#define P2_BODY  { pg8::Gemm g{ACT, (const bf16_t*)(ws + WS_WIN0), MT, EV_IN, DM / 2, DM / 2, DM / 2}; pg8::StaticOrder S; S.init(MT, EV_IN, F.G, F.wg); \
        pg8::EpiBf16 E{Z, EV_IN, 1.f / (FP8_WSC * FP8_ASC)}; pg8::gemm_phase<pg8::EpiBf16, true>(F.lds, g, S, E); }
#define P3_BODY  { gqa_prep_phase(F, args); }
#define P4_BODY  { mixer0_phase(F, args); }
#define P5_BODY  { hgrn_readout_phase(F, args); }
#define P6_BODY  { pg8::Gemm g{ACT, (const bf16_t*)(ws + WS_WOUT0), MT, DM, DM / 2, DM / 2, DM / 2}; pg8::StaticOrder S; S.init(MT, DM, F.G, F.wg); \
        pg8::EpiResid<false> E{H, args.in[I_X], args.in[I_CTX], modx + 2 * DM, modc + 2 * DM, 12288, 1.f / (FP8_WSC * FP8_ASC)}; pg8::gemm_phase<pg8::EpiResid<false>, true>(F.lds, g, S, E); }
#define P7_BODY  { norm_mod_phase<true>(F, H, H + (size_t)MXR * DM, args.in[I_N2W], modx, modc, 3, ACT, MT); }
#define P8_BODY  { pg8::Gemm g{ACT, (const bf16_t*)(ws + WS_WPQ), MT, DM, DM, DM, DM}; pg8::StaticOrder S; S.init(MT, DM, F.G, F.wg); \
        pg8::EpiBf16 E{(bf16_t*)(ws + WS_PQ), DM}; pg8::gemm_phase(F.lds, g, S, E); }
#define P9_BODY  { peer_topk_phase(F, args, 0, MT); }
#define P10_BODY { peer_gather_phase<false>(F, args, 0, MT); }
#define P11_BODY { }
#define P12_BODY { pg8::Gemm g{(const bf16_t*)(ws + WS_A8), (const bf16_t*)(ws + WS_WIN1), MT, OD_INP, DM / 2, DM / 2, DM / 2}; pg8::StaticOrder S; S.init(MT, OD_INP, F.G, F.wg); \
        pg8::EpiZ1 E{Z, OD_INP, 1.f / (FP8_WSC * FP8_ASC), ws + WS_K8NA, QK8_SC / (FP8_WSC * FP8_ASC), ws + WS_V8NA}; pg8::gemm_phase<pg8::EpiZ1, true>(F.lds, g, S, E); }
#define P13_BODY { mla_prep_phase(F, args); }
#define P14_BODY { \
        { pg8::Gemm g{ACT, (const bf16_t*)(ws + WS_WQUP), MXR, 1536, 256, 256, 256}; pg8::StaticOrder S; S.init(MXR, 1536, F.G, F.wg); \
          pg8::EpiBf16 E{(bf16_t*)(ws + WS_QUP), 1536, 1.f / (FP8_WSC2 * FP8_ASC)}; pg8::gemm_phase<pg8::EpiBf16, true>(F.lds, g, S, E); } \
        { pg8::Gemm g{(const bf16_t*)(ws + WS_ACT + (size_t)MT * 512), (const bf16_t*)(ws + WS_WKVUP), MT, 2048, 256, 256, 256}; pg8::StaticOrder S; S.init(MT, 2048, F.G, F.wg); \
          pg8::EpiKV8 E{ws + WS_V8M, 1.f / (FP8_WSC2 * FP8_ASC), ws + WS_K8N, QK8_SC / (FP8_WSC2 * FP8_ASC)}; pg8::gemm_phase<pg8::EpiKV8, true>(F.lds, g, S, E); } }
#define P15_BODY { }
#define P16_BODY { mixer1_phase(F, args); }
#define P17_BODY { pg8::Gemm g{ACT, (const bf16_t*)(ws + WS_WOUT1), MXR, DM, DM / 2, DM / 2, DM / 2}; pg8::StaticOrder S; S.init(MXR, DM, F.G, F.wg); \
        pg8::EpiResid<true> E{H, H, H, modx + (size_t)16 * 12288 + 2 * DM, modc + 12288 + 2 * DM, 12288, 1.f / (FP8_WSC * FP8_ASC)}; pg8::gemm_phase<pg8::EpiResid<true>, true>(F.lds, g, S, E); }
#define P18_BODY { norm_mod_phase<true>(F, H, H, args.in[I_N2W] + DM, modx + (size_t)16 * 12288, modc + 12288, 3, ACT, MXR); \
        cvt_fp6_rows(F, args.in[I_PU] + (size_t)16384 * 2048, ws + WS_U, (float*)(ws + WS_SU), 16384); \
        cvt_fp6_rows(F, args.in[I_PV] + (size_t)16384 * 2048, ws + WS_V, (float*)(ws + WS_SV), 16384); }
#define P19_BODY { pg8::Gemm g{ACT, (const bf16_t*)(ws + WS_WPQ) + (size_t)2048 * 2048, MXR, DM, DM, DM, DM}; pg8::StaticOrder S; S.init(MXR, DM, F.G, F.wg); \
        pg8::EpiBf16 E{(bf16_t*)(ws + WS_PQ), DM}; pg8::gemm_phase(F.lds, g, S, E); }
#define P20_BODY { peer_topk_phase(F, args, 1, MXR); }
#define P21_BODY { peer_gather_phase<true>(F, args, 1, MXR); }
#define PHASE(k, BODY) if (IN(k)) { BODY REP2(k) BODY }
    PHASE(0, P0_BODY) SEAM(0);
    PHASE(1, P1_BODY) SEAM(1);
    PHASE(2, P2_BODY) SEAM(2);
    PHASE(3, P3_BODY) SEAM(3);
    PHASE(4, P4_BODY) SEAM(4);
    PHASE(5, P5_BODY) SEAM(5);
    PHASE(6, P6_BODY) SEAM(6);
    PHASE(7, P7_BODY) SEAM(7);
    PHASE(8, P8_BODY) SEAM(8);
    PHASE(9, P9_BODY) SEAM(9);
    PHASE(10, P10_BODY)
    PHASE(11, P11_BODY) SEAM(11);
    PHASE(12, P12_BODY) SEAM(12);
    PHASE(13, P13_BODY) SEAM(13);
    PHASE(14, P14_BODY)
    PHASE(15, P15_BODY) SEAM(15);
    PHASE(16, P16_BODY) SEAM(16);
    PHASE(17, P17_BODY) SEAM(17);
    PHASE(18, P18_BODY) SEAM(18);
    PHASE(19, P19_BODY) SEAM(19);
    PHASE(20, P20_BODY) SEAM(20);
    PHASE(21, P21_BODY)
#undef IN
#undef SEAM
}

extern "C" void kernel_launch(void* const* d_in, const int* in_sizes, int n_in, void* d_out, int out_size, void* d_ws, size_t ws_size, hipStream_t stream) {
    static int grid = 0;
    if (grid == 0) {
        if (n_in != N_IN || ws_size < WS_END) { fprintf(stderr, "kernel_launch: unexpected n_in %d or ws_size %zu (< %zu)\n", n_in, ws_size, (size_t)WS_END); grid = -1; return; }
        int dev = 0, cus = 0, per_cu = 0;
        if (hipGetDevice(&dev) != hipSuccess || hipDeviceGetAttribute(&cus, hipDeviceAttributeMultiprocessorCount, dev) != hipSuccess) { grid = -1; return; }
        if (hipFuncSetAttribute((const void*)fwd_kernel, hipFuncAttributeMaxDynamicSharedMemorySize, LDS_BYTES) != hipSuccess) { fprintf(stderr, "kernel_launch: hipFuncSetAttribute failed\n"); grid = -1; return; }
        if (hipOccupancyMaxActiveBlocksPerMultiprocessor(&per_cu, (const void*)fwd_kernel, 512, LDS_BYTES) != hipSuccess || per_cu < 1) { fprintf(stderr, "kernel_launch: occupancy query says %d\n", per_cu); }
        (void)hipGetLastError();
        if (cus < 256) { fprintf(stderr, "kernel_launch: this build is laid out for 256 CUs (MI355X); found %d\n", cus); grid = -1; return; }
        grid = 256;
    }
    if (grid < 0) return;
    (void)hipMemsetAsync((char*)d_ws + WS_CTL, 0, CTL_ZERO_BYTES, stream);
    Args a{};
    for (int i = 0; i < N_IN; ++i) a.in[i] = (const float*)d_in[i];
    a.out = (float*)d_out; a.ws = (unsigned char*)d_ws;
#if MK_N_LAUNCHES == 1
    a.ph_lo = 0; a.ph_hi = NPHASE;
    hipLaunchKernelGGL(fwd_kernel, dim3(grid), dim3(512), LDS_BYTES, stream, a);
#else
    for (int ph = 0; ph < NPHASE; ++ph) { a.ph_lo = ph; a.ph_hi = ph + 1; hipLaunchKernelGGL(fwd_kernel, dim3(grid), dim3(512), LDS_BYTES, stream, a); }
#endif
}
```

```cpp
#include <hip/hip_runtime.h>
#include <cstdio>
#include <cstdint>

#define DBG_SANITIZE 0
#ifndef DBG_REPMASK
#define DBG_REPMASK 0u
#endif
#ifndef MK_N_LAUNCHES
#define MK_N_LAUNCHES 1
#endif

#define DI __device__ __forceinline__
#define LAS __attribute__((address_space(3)))
typedef unsigned short bf16_t;
typedef short bf16x8 __attribute__((ext_vector_type(8)));
typedef short s16x4 __attribute__((ext_vector_type(4)));
typedef float f32x4 __attribute__((ext_vector_type(4)));
typedef float f32x16 __attribute__((ext_vector_type(16)));
typedef unsigned u32x4 __attribute__((ext_vector_type(4)));
typedef unsigned u32x2 __attribute__((ext_vector_type(2)));

constexpr int DM = 2048, NBATCH = 16, SEQ = 2048, CTXL = 256;
constexpr int MXR = NBATCH * SEQ;
constexpr int MCR = NBATCH * CTXL;
constexpr int MT = MXR + MCR;
constexpr int EV_IN = 6656, OD_IN = 4160, OD_INP = 4352;
constexpr float EPS = 1e-6f;
constexpr int NPHASE = 22;

constexpr size_t MiB = 1u << 20;
constexpr size_t WS_CTL = 0, CTL_ZERO_BYTES = 1 * MiB;
constexpr size_t WS_MODX = 1 * MiB;
constexpr size_t WS_MODC = WS_MODX + (size_t)2 * 16 * 12288 * 4;
constexpr size_t WS_WIN0 = 4 * MiB;
constexpr size_t WS_WOUT0 = 30 * MiB;
constexpr size_t WS_WIN1 = 38 * MiB;
constexpr size_t WS_WOUT1 = 55 * MiB;
constexpr size_t WS_WQUP = 63 * MiB;
constexpr size_t WS_WKVUP = 65 * MiB;
constexpr size_t WS_WPQ = 67 * MiB;
constexpr size_t WS_KEYS = 83 * MiB;
constexpr size_t WS_U = 84 * MiB, WS_V = 148 * MiB;
constexpr size_t WS_SU = 3 * MiB, WS_SV = 3 * MiB + 65536;
constexpr size_t WS_QUP = 84 * MiB;
constexpr size_t WS_ACT = 212 * MiB;
constexpr size_t WS_H = 356 * MiB;
constexpr size_t WS_OF = 356 * MiB, WS_OB = 428 * MiB;
constexpr size_t WS_A8 = 500 * MiB;
constexpr size_t WS_Q8 = 500 * MiB, WS_K8 = 540 * MiB;
constexpr size_t WS_K8N = 500 * MiB, WS_K8R = 540 * MiB;
constexpr size_t WS_K8NA = 572 * MiB;
constexpr size_t WS_V8G = 552 * MiB, WS_V8NA = 608 * MiB, WS_V8M = 950 * MiB;
constexpr float QK8_SC = 16.f;
constexpr size_t WS_Z = 644 * MiB;
constexpr size_t WS_PQ = 644 * MiB;
constexpr size_t WS_EIDX = 788 * MiB, WS_GATE = 806 * MiB;
constexpr size_t WS_HP = 824 * MiB;
constexpr size_t WS_KVUP = 950 * MiB;
constexpr size_t WS_END = 1112 * MiB;
constexpr int CW_BAR = 4096;
constexpr int CW_QUEUE2 = 8192 + 64;
constexpr int CW_QUEUE = 8192;

constexpr int LDS_BYTES = 147456;
constexpr int LDS_MISC = 131072 + 1024;

typedef __bf16 bf16v2 __attribute__((ext_vector_type(2)));
typedef float f32x2 __attribute__((ext_vector_type(2)));
DI unsigned pk2(float lo, float hi) { const f32x2 v = {lo, hi}; return __builtin_bit_cast(unsigned, __builtin_convertvector(v, bf16v2)); }
DI float bflo(unsigned u) { return __uint_as_float(u << 16); }
DI float bfhi(unsigned u) { return __uint_as_float(u & 0xffff0000u); }
DI int pk4_fp8(float a, float b, float c, float d) { int p = __builtin_amdgcn_cvt_pk_fp8_f32(fminf(fmaxf(a, -448.f), 448.f), fminf(fmaxf(b, -448.f), 448.f), 0, false);
    return __builtin_amdgcn_cvt_pk_fp8_f32(fminf(fmaxf(c, -448.f), 448.f), fminf(fmaxf(d, -448.f), 448.f), p, true); }
DI float wave_sum(float v) {
#pragma unroll
    for (int o = 1; o < 64; o <<= 1) v += __shfl_xor(v, o);
    return v;
}
DI float silu_f(float x) { return x * __builtin_amdgcn_rcpf(1.f + __expf(-x)); }
DI float gelu_tanh(float x) { const float u = 0.7978845608028654f * (x + 0.044715f * x * x * x); const float e = __expf(2.f * u); const float t = 1.f - 2.f * __builtin_amdgcn_rcpf(e + 1.f); return 0.5f * x * (1.f + t); }

#define XB_TMO      128
#define XB_XCNT(j)  (256  + 64 * (j))
#define XB_XSUB(j)  (1280 + 64 * (j))
#define XB_XGEN(j)  (2304 + 64 * (j))
#define XB_TOP      3328
#define XB_TOPGEN   3392
#define XCD_BAR_WORDS 3456
#define XB_SPIN_CAP (1u << 20)
DI unsigned xb_ld(unsigned* p)              { return __hip_atomic_load(p, __ATOMIC_RELAXED, __HIP_MEMORY_SCOPE_AGENT); }
DI unsigned xb_add(unsigned* p, unsigned v) { return __hip_atomic_fetch_add(p, v, __ATOMIC_RELAXED, __HIP_MEMORY_SCOPE_AGENT); }
DI unsigned xb_xcc_id() { return (unsigned)__builtin_amdgcn_s_getreg((3 << 11) | 20) & 0xFu; }
#define XB_SPIN(cond, bar) do { unsigned _sp = 0; while (cond) { __builtin_amdgcn_s_sleep(1); \
    if ((++_sp & 255u) == 0u) { if (xb_ld(&(bar)[XB_TMO])) break; if (_sp > XB_SPIN_CAP) { atomicAdd(&(bar)[XB_TMO], 1u); break; } } } } while (0)
struct XcdBarrier { unsigned* bar; unsigned x; volatile LAS unsigned* st; };
DI XcdBarrier xcd_barrier_post(unsigned* bar, volatile LAS unsigned* st) {
    XcdBarrier b; b.bar = bar; b.x = xb_xcc_id(); b.st = st;
    if (threadIdx.x == 0) (void)xb_add(&bar[XB_XCNT(b.x)], 1u);
    return b;
}
DI void xcd_barrier_complete(unsigned* bar, unsigned x, unsigned& nloc, unsigned& nx) {
    const unsigned G = gridDim.x * gridDim.y * gridDim.z;
    unsigned sum, cnt, mine, sp = 0u;
    for (;;) {
        sum = 0u; cnt = 0u; mine = 0u;
#pragma unroll
        for (unsigned j = 0; j < 16; ++j) { const unsigned c = xb_ld(&bar[XB_XCNT(j)]); sum += c; cnt += (c > 0u) ? 1u : 0u; mine = (j == x) ? c : mine; }
        if (sum == G) break;
        __builtin_amdgcn_s_sleep(1);
        if ((++sp & 255u) == 0u) { if (xb_ld(&bar[XB_TMO])) break; if (sp > XB_SPIN_CAP) { atomicAdd(&bar[XB_TMO], 1u); break; } }
    }
    nloc = mine > 0u ? mine : 1u; nx = cnt > 0u ? cnt : 1u;
}
DI void xcd_barrier(const XcdBarrier& b) {
    asm volatile("s_waitcnt vmcnt(0)" ::: "memory");
    __syncthreads();
    if (threadIdx.x == 0) {
        unsigned* bar = b.bar;
        __builtin_amdgcn_s_waitcnt(0);
        unsigned nloc = b.st[0], nx = b.st[1];
        if (nloc == 0u) { xcd_barrier_complete(bar, b.x, nloc, nx); b.st[0] = nloc; b.st[1] = nx; }
        const unsigned old = xb_add(&bar[XB_XSUB(b.x)], 1u);
        const unsigned gen = old / nloc;
        if (old + 1u == (gen + 1u) * nloc) {
            __builtin_amdgcn_fence(__ATOMIC_RELEASE, "agent");
            asm volatile("s_waitcnt vmcnt(0)" ::: "memory");
            const unsigned og = xb_add(&bar[XB_TOP], 1u);
            const unsigned tg = og / nx;
            if (og + 1u == (tg + 1u) * nx) xb_add(&bar[XB_TOPGEN], 1u);
            else XB_SPIN(xb_ld(&bar[XB_TOPGEN]) == tg, bar);
            __builtin_amdgcn_fence(__ATOMIC_ACQUIRE, "agent");
            xb_add(&bar[XB_XGEN(b.x)], 1u);
            asm volatile("s_waitcnt vmcnt(0)" ::: "memory");
        } else {
            XB_SPIN(xb_ld(&bar[XB_XGEN(b.x)]) == gen, bar);
            __builtin_amdgcn_fence(__ATOMIC_ACQUIRE, "agent");
            asm volatile("s_waitcnt vmcnt(0)" ::: "memory");
        }
    }
    __syncthreads();
}

namespace pg8 {
constexpr int BM = 256, BK = 64, HALF = 128, HTB = HALF * BK * 2, STAGE_BYTES = 8 * HTB, NXCD = 8, WGM = 8;
__host__ __device__ __forceinline__ int lds_byte(int r, int c) { const int st = (r >> 4) * 2 + (c >> 5), rr = r & 15, cc = c & 31, ob = rr * 64 + cc * 2; return st * 1024 + (ob ^ (((ob >> 9) & 1) << 5)); }
__host__ __device__ __forceinline__ void stage_rc(int b, int& R, int& C) { const int st = b / 1024, sb = b % 1024, swz = sb ^ (((sb >> 9) & 1) << 5); R = (st >> 1) * 16 + swz / 64; C = (st & 1) * 32 + (swz % 64) / 2; }
__host__ __device__ __forceinline__ int perm32(int rho) { const int n = rho >> 4, i = rho & 15; return 8 * (i >> 2) + 4 * n + (i & 3); }
struct Unit { int pm, pn; };
struct Gemm { const bf16_t* A; const bf16_t* Bt; int M, N, K, lda, ldb; };
struct StaticOrder {
    int nM, nN, nwg, G, c;
    __device__ void init(int M, int N, int G_, int c_) { nM = M / BM; nN = N / BM; nwg = nM * nN; G = G_; c = c_; }
    __device__ bool next(int i, Unit& u) const {
        const long L = (long)i * G + c; if (L >= nwg) return false;
        int wgid = (int)L; { const int q = nwg / NXCD, r = nwg % NXCD, xcd = wgid % NXCD, off = wgid / NXCD; wgid = (xcd < r ? xcd * (q + 1) : r * (q + 1) + (xcd - r) * q) + off; }
        const int nig = WGM * nN, gid = wgid / nig, fm = gid * WGM, gsz = (nM - fm) < WGM ? (nM - fm) : WGM;
        u.pm = fm + ((wgid % nig) % gsz); u.pn = (wgid % nig) / gsz; return true;
    }
};
struct EpiBf16 {
    static constexpr bool PERM = true;
    bf16_t* O; int ldc; float osc = 1.f;
    DI void operator()(const f32x4 (&acc)[2][2][4][2], const Unit& u, int wr, int wc, int fr, int fq) const {
        const int row0 = u.pm * BM + wr * 64 + fr, col0 = u.pn * BM + wc * 32 + 8 * fq;
#pragma unroll
        for (int ai = 0; ai < 2; ++ai)
#pragma unroll
            for (int m = 0; m < 4; ++m) { bf16_t* rowp = O + (size_t)(row0 + ai * HALF + m * 16) * ldc + col0;
#pragma unroll
                for (int bj = 0; bj < 2; ++bj) { const f32x4 v0 = acc[ai][bj][m][0] * osc, v1 = acc[ai][bj][m][1] * osc;
                    u32x4 w; w.x = pk2(v0[0], v0[1]); w.y = pk2(v0[2], v0[3]); w.z = pk2(v1[0], v1[1]); w.w = pk2(v1[2], v1[3]);
                    *(u32x4*)(rowp + bj * HALF) = w; } }
    }
};
struct EpiKV8 {
    static constexpr bool PERM = true;
    unsigned char* V8; float osc; unsigned char* K8; float ksc;
    DI void operator()(const f32x4 (&acc)[2][2][4][2], const Unit& u, int wr, int wc, int fr, int fq) const {
        const int row0 = u.pm * BM + wr * 64 + fr, cin = wc * 32 + 8 * fq;
#pragma unroll
        for (int ai = 0; ai < 2; ++ai)
#pragma unroll
            for (int m = 0; m < 4; ++m) { const size_t row = (size_t)(row0 + ai * HALF + m * 16);
                { const f32x4 v0 = acc[ai][0][m][0] * ksc, v1 = acc[ai][0][m][1] * ksc;
                  u32x2 w; w.x = (unsigned)pk4_fp8(v0[0], v0[1], v0[2], v0[3]); w.y = (unsigned)pk4_fp8(v1[0], v1[1], v1[2], v1[3]);
                  *(u32x2*)(K8 + row * 1024 + u.pn * 128 + cin) = w; }
                { const f32x4 v0 = acc[ai][1][m][0] * osc, v1 = acc[ai][1][m][1] * osc;
                  u32x2 w; w.x = (unsigned)pk4_fp8(v0[0], v0[1], v0[2], v0[3]); w.y = (unsigned)pk4_fp8(v1[0], v1[1], v1[2], v1[3]);
                  *(u32x2*)(V8 + row * 1024 + u.pn * 128 + cin) = w; } }
    }
};
struct EpiZ1 {
    static constexpr bool PERM = true;
    bf16_t* O; int ldc; float osc; unsigned char* K8; float ksc; unsigned char* V8;
    DI void operator()(const f32x4 (&acc)[2][2][4][2], const Unit& u, int wr, int wc, int fr, int fq) const {
        const int row0 = u.pm * BM + wr * 64 + fr, cin = wc * 32 + 8 * fq;
        if (u.pn >= 4 && u.pn < 12) {
            const bool isk = u.pn < 8; const float fs = isk ? ksc : osc; unsigned char* dst8 = isk ? (K8 + (u.pn - 4) * BM) : (V8 + (u.pn - 8) * BM);
#pragma unroll
            for (int ai = 0; ai < 2; ++ai)
#pragma unroll
                for (int m = 0; m < 4; ++m) { unsigned char* rowp = dst8 + (size_t)(row0 + ai * HALF + m * 16) * 1024 + cin;
#pragma unroll
                    for (int bj = 0; bj < 2; ++bj) { const f32x4 v0 = acc[ai][bj][m][0] * fs, v1 = acc[ai][bj][m][1] * fs;
                        u32x2 w; w.x = (unsigned)pk4_fp8(v0[0], v0[1], v0[2], v0[3]); w.y = (unsigned)pk4_fp8(v1[0], v1[1], v1[2], v1[3]);
                        *(u32x2*)(rowp + bj * HALF) = w; } }
        } else {
#pragma unroll
            for (int ai = 0; ai < 2; ++ai)
#pragma unroll
                for (int m = 0; m < 4; ++m) { bf16_t* rowp = O + (size_t)(row0 + ai * HALF + m * 16) * ldc + u.pn * BM + cin;
#pragma unroll
                    for (int bj = 0; bj < 2; ++bj) { const f32x4 v0 = acc[ai][bj][m][0] * osc, v1 = acc[ai][bj][m][1] * osc;
                        u32x4 w; w.x = pk2(v0[0], v0[1]); w.y = pk2(v0[2], v0[3]); w.z = pk2(v1[0], v1[1]); w.w = pk2(v1[2], v1[3]);
                        *(u32x4*)(rowp + bj * HALF) = w; } }
        }
    }
};
template <bool RBF16>
struct EpiResid {
    static constexpr bool PERM = true;
    bf16_t* H; const void* Rx; const void* Rc; const float* gx; const float* gc; int gstride; float osc = 1.f;
    DI void operator()(const f32x4 (&acc)[2][2][4][2], const Unit& u, int wr, int wc, int fr, int fq) const {
        const int rowt = u.pm * BM;
        const char* R; const float* g;
        constexpr int RB = RBF16 ? 2 : 4;
        if (rowt < MXR) { R = (const char*)Rx + (size_t)rowt * DM * RB; g = gx + (size_t)(rowt >> 11) * gstride; } else { R = (const char*)Rc + (size_t)(rowt - MXR) * DM * RB; g = gc; }
        bf16_t* Ho = H + (size_t)rowt * DM;
        const int rl0 = wr * 64 + fr, col0 = u.pn * BM + wc * 32 + 8 * fq;
        f32x4 gv[2][2];
#pragma unroll
        for (int bj = 0; bj < 2; ++bj)
#pragma unroll
            for (int n = 0; n < 2; ++n) gv[bj][n] = *(const f32x4*)(g + col0 + bj * HALF + 4 * n) * osc;
#pragma unroll
        for (int ai = 0; ai < 2; ++ai)
#pragma unroll
            for (int m = 0; m < 4; ++m) { const size_t ro = (size_t)(rl0 + ai * HALF + m * 16) * DM + col0;
#pragma unroll
                for (int bj = 0; bj < 2; ++bj) { f32x4 r0, r1;
                    if (RBF16) { const u32x4 rr = *(const u32x4*)(R + (ro + bj * HALF) * 2); r0 = (f32x4){bflo(rr.x), bfhi(rr.x), bflo(rr.y), bfhi(rr.y)}; r1 = (f32x4){bflo(rr.z), bfhi(rr.z), bflo(rr.w), bfhi(rr.w)}; }
                    else { r0 = *(const f32x4*)(R + (ro + bj * HALF) * 4); r1 = *(const f32x4*)(R + (ro + bj * HALF + 4) * 4); }
                    const f32x4 v0 = r0 + gv[bj][0] * acc[ai][bj][m][0], v1 = r1 + gv[bj][1] * acc[ai][bj][m][1];
                    u32x4 w; w.x = pk2(v0[0], v0[1]); w.y = pk2(v0[2], v0[3]); w.z = pk2(v1[0], v1[1]); w.w = pk2(v1[2], v1[3]);
                    *(u32x4*)(Ho + ro + bj * HALF) = w; } }
    }
};

template <class Epi, bool FP8 = false>
DI void gemm_phase(LAS unsigned char* lds, const Gemm g, const StaticOrder& S, const Epi& E) {
    const int tid = threadIdx.x, wid = __builtin_amdgcn_readfirstlane(tid >> 6), lane = tid & 63, wr = wid >> 2, wc = wid & 3, fr = lane & 15, fq = lane >> 4;
    const int K = g.K, nt = K / BK;
    unsigned voffA[2], voffB[2];
#pragma unroll
    for (int i = 0; i < 2; ++i) { int R, C; stage_rc(tid * 16 + i * 8192, R, C); const int Rb = Epi::PERM ? ((R & ~31) + perm32(R & 31)) : R;
        voffA[i] = (unsigned)(R * g.lda + C) * 2u; voffB[i] = (unsigned)(Rb * g.ldb + C) * 2u; }
    const size_t kstep = (size_t)(BK * 2);
    const size_t hA = (size_t)HALF * g.lda * 2, hB = (size_t)HALF * g.ldb * 2;
    const size_t tA = 2 * hA, tB = 2 * hB;
    const unsigned ldsw = (unsigned)wid * 1024u;
    const int aoff = lds_byte(wr * 64 + fr, fq * 8), boff = lds_byte(wc * 32 + fr, fq * 8);
#define PG8_SA(b, h) (((b) * 2 + (h)) * HTB)
#define PG8_SB(b, h) ((4 + (b) * 2 + (h)) * HTB)
#define PG8_STAGE(bufoff, gbase, voff) do { _Pragma("unroll") for (int _i = 0; _i < 2; ++_i) \
        __builtin_amdgcn_global_load_lds((const unsigned*)((const char*)(gbase) + (voff)[_i]), (LAS unsigned*)(lds + (bufoff) + ldsw + _i * 8192), 16, 0, 0); } while (0)
#define PG8_LD8(p) __builtin_shufflevector(*(const LAS u32x4*)(p), *(const LAS u32x4*)((p) + 1024), 0, 1, 2, 3, 4, 5, 6, 7)
#define PG8_LDA(dst, b, h) do { if constexpr (FP8) { _Pragma("unroll") for (int m = 0; m < 4; ++m) dst##8[m] = PG8_LD8(lds + PG8_SA(b, h) + aoff + m * 2048); } \
        else { _Pragma("unroll") for (int m = 0; m < 4; ++m) _Pragma("unroll") for (int k = 0; k < 2; ++k) dst[m][k] = *(const LAS bf16x8*)(lds + PG8_SA(b, h) + aoff + m * 2048 + k * 1024); } } while (0)
#define PG8_LDB(dst, b, h) do { if constexpr (FP8) { _Pragma("unroll") for (int n = 0; n < 2; ++n) dst##8[n] = PG8_LD8(lds + PG8_SB(b, h) + boff + n * 2048); } \
        else { _Pragma("unroll") for (int n = 0; n < 2; ++n) _Pragma("unroll") for (int k = 0; k < 2; ++k) dst[n][k] = *(const LAS bf16x8*)(lds + PG8_SB(b, h) + boff + n * 2048 + k * 1024); } } while (0)
#define PG8_MMA(ai, bj, At, Bt) do { __builtin_amdgcn_s_setprio(1); \
        if constexpr (FP8) { _Pragma("unroll") for (int m = 0; m < 4; ++m) _Pragma("unroll") for (int n = 0; n < 2; ++n) \
            asm volatile("v_mfma_scale_f32_16x16x128_f8f6f4 %0, %1, %2, %0, %3, %3 op_sel_hi:[0,0,0]" : "+v"(acc[ai][bj][m][n]) : "v"(Bt##8[n]), "v"(At##8[m]), "v"(one_scale)); } \
        else { _Pragma("unroll") for (int m = 0; m < 4; ++m) _Pragma("unroll") for (int n = 0; n < 2; ++n) _Pragma("unroll") for (int k = 0; k < 2; ++k) \
            acc[ai][bj][m][n] = __builtin_amdgcn_mfma_f32_16x16x32_bf16(Bt[n][k], At[m][k], acc[ai][bj][m][n], 0, 0, 0); } \
        __builtin_amdgcn_s_setprio(0); } while (0)
#define PG8_WAIT_V(n) asm volatile("s_waitcnt vmcnt(" #n ")" ::: "memory")
#define PG8_WAIT_L(n) asm volatile("s_waitcnt lgkmcnt(" #n ")" ::: "memory")
#define PG8_BAR __builtin_amdgcn_s_barrier()
#define PG8_SCHED __builtin_amdgcn_sched_barrier(0)
    Unit cur, nxt; int ui = 0;
    if (!S.next(0, cur)) return;
    f32x4 acc[2][2][4][2];
#pragma unroll
    for (int a = 0; a < 2; ++a)
#pragma unroll
        for (int b = 0; b < 2; ++b)
#pragma unroll
            for (int m = 0; m < 4; ++m)
#pragma unroll
                for (int n = 0; n < 2; ++n) acc[a][b][m][n] = (f32x4){0.f, 0.f, 0.f, 0.f};
    bf16x8 At[4][2], B0[2][2], B1[2][2];
    typedef unsigned u32x8 __attribute__((ext_vector_type(8))); typedef int i32x8 __attribute__((ext_vector_type(8)));
    u32x8 At8[4], B08[2], B18[2];
    const unsigned one_scale = 0x7f7f7f7fu;
    const char* cA = (const char*)g.A + (size_t)cur.pm * tA; const char* cB = (const char*)g.Bt + (size_t)cur.pn * tB;
    PG8_STAGE(PG8_SB(0, 0), cB, voffB); PG8_STAGE(PG8_SA(0, 0), cA, voffA); PG8_STAGE(PG8_SB(0, 1), cB + hB, voffB); PG8_STAGE(PG8_SA(0, 1), cA + hA, voffA);
    if (wr == 1) PG8_BAR;
    PG8_WAIT_V(4); PG8_BAR;
    PG8_STAGE(PG8_SB(1, 0), cB + kstep, voffB); PG8_STAGE(PG8_SA(1, 0), cA + kstep, voffA); PG8_STAGE(PG8_SB(1, 1), cB + hB + kstep, voffB);
    PG8_WAIT_V(6); PG8_BAR;
    for (;;) {
        const bool has_next = S.next(ui + 1, nxt);
        const char* nA = has_next ? (const char*)g.A + (size_t)nxt.pm * tA : cA; const char* nB = has_next ? (const char*)g.Bt + (size_t)nxt.pn * tB : cB;
        for (int t = 0; t < nt; t += 2) {
            const bool last = (t == nt - 2);
            const char* a1 = cA + (size_t)(t + 1) * kstep;
            const char* a2 = last ? nA : cA + (size_t)(t + 2) * kstep; const char* b2 = last ? nB : cB + (size_t)(t + 2) * kstep;
            const char* a3 = a2 + kstep; const char* b3 = b2 + kstep;
            PG8_LDB(B0, 0, 0); PG8_SCHED; PG8_LDA(At, 0, 0); PG8_STAGE(PG8_SA(1, 1), a1 + hA, voffA);
            PG8_WAIT_L(8); PG8_BAR; PG8_WAIT_L(0); PG8_MMA(0, 0, At, B0); PG8_BAR; PG8_SCHED;
            PG8_LDB(B1, 0, 1); PG8_STAGE(PG8_SB(0, 0), b2, voffB);
            PG8_BAR; PG8_WAIT_L(0); PG8_MMA(0, 1, At, B1); PG8_BAR;
            PG8_LDA(At, 0, 1); PG8_STAGE(PG8_SA(0, 0), a2, voffA);
            PG8_BAR; PG8_WAIT_L(0); PG8_MMA(1, 0, At, B0); PG8_BAR; PG8_SCHED;
            PG8_STAGE(PG8_SB(0, 1), b2 + hB, voffB);
            PG8_WAIT_V(6); PG8_BAR; PG8_MMA(1, 1, At, B1); PG8_BAR;
            PG8_LDB(B0, 1, 0); PG8_SCHED; PG8_LDA(At, 1, 0); PG8_STAGE(PG8_SA(0, 1), a2 + hA, voffA);
            PG8_WAIT_L(8); PG8_BAR; PG8_WAIT_L(0); PG8_MMA(0, 0, At, B0); PG8_BAR; PG8_SCHED;
            PG8_LDB(B1, 1, 1); PG8_STAGE(PG8_SB(1, 0), b3, voffB);
            PG8_BAR; PG8_WAIT_L(0); PG8_MMA(0, 1, At, B1); PG8_BAR;
            PG8_LDA(At, 1, 1); PG8_STAGE(PG8_SA(1, 0), a3, voffA);
            PG8_BAR; PG8_WAIT_L(0); PG8_MMA(1, 0, At, B0); PG8_BAR; PG8_SCHED;
            PG8_STAGE(PG8_SB(1, 1), b3 + hB, voffB);
            PG8_WAIT_V(6); PG8_BAR; PG8_MMA(1, 1, At, B1); PG8_BAR;
        }
        E(acc, cur, wr, wc, fr, fq);
        if (!has_next) break;
#pragma unroll
        for (int a = 0; a < 2; ++a)
#pragma unroll
            for (int b = 0; b < 2; ++b)
#pragma unroll
                for (int m = 0; m < 4; ++m)
#pragma unroll
                    for (int n = 0; n < 2; ++n) acc[a][b][m][n] = (f32x4){0.f, 0.f, 0.f, 0.f};
        cur = nxt; cA = nA; cB = nB; ++ui;
    }
    PG8_WAIT_V(0);
    if (wr == 0) PG8_BAR;
    PG8_BAR;
#undef PG8_SA
#undef PG8_SB
#undef PG8_STAGE
#undef PG8_LDA
#undef PG8_LDB
#undef PG8_MMA
#undef PG8_LD8
#undef PG8_WAIT_V
#undef PG8_WAIT_L
#undef PG8_BAR
#undef PG8_SCHED
}
}

enum { I_X = 0, I_C, I_CTX, I_CCTX, I_WMOD, I_BMOD, I_N1W, I_N2W, I_EVIN, I_EVOUT, I_GQN, I_GKN, I_HLB, I_HON, I_ODIN, I_ODOUT, I_RPB,
       I_MQN, I_MQUP, I_MKVN, I_MKVUP, I_PWQ, I_PKEYS, I_PU, I_PV, I_FNW, N_IN };
struct Args { const float* in[N_IN]; float* out; unsigned char* ws; int ph_lo, ph_hi; };
struct Frame {
    LAS unsigned char* lds;
    int tid, lane, wave, gw, ngw, G, wg;
};

constexpr float FP8_WSC = 2048.f, FP8_WSC2 = 1024.f, FP8_ASC = 16.f;
DI void transpose_item_fp8(const float* W, int K, int N, unsigned char* WT, LAS float* scr, int item, int lane, float wsc = FP8_WSC) {
    const int nblk = N / 32, kb = item / nblk, nb = item % nblk, k0 = 64 * kb, n0 = 32 * nb;
#pragma unroll 8
    for (int i = 0; i < 32; ++i) { const int kk = 2 * i + (lane >> 5); scr[kk * 33 + (lane & 31)] = W[(size_t)(k0 + kk) * N + n0 + (lane & 31)] * wsc; }
    asm volatile("s_waitcnt lgkmcnt(0)" ::: "memory");
    const int c = lane & 7;
#pragma unroll
    for (int j = 0; j < 4; ++j) { const int n = (lane >> 3) + 8 * j; const LAS float* sp = scr + (8 * c) * 33 + n;
        u32x2 o; o.x = (unsigned)pk4_fp8(sp[0 * 33], sp[1 * 33], sp[2 * 33], sp[3 * 33]); o.y = (unsigned)pk4_fp8(sp[4 * 33], sp[5 * 33], sp[6 * 33], sp[7 * 33]);
        *(u32x2*)(WT + (size_t)(n0 + n) * K + k0 + 8 * c) = o; }
    asm volatile("s_waitcnt lgkmcnt(0)" ::: "memory");
}
DI void transpose_item(const float* W, int K, int N, bf16_t* WT, LAS float* scr, int item, int lane) {
    const int nblk = N / 32, kb = item / nblk, nb = item % nblk, k0 = 64 * kb, n0 = 32 * nb;
#pragma unroll 8
    for (int i = 0; i < 32; ++i) { const int kk = 2 * i + (lane >> 5); scr[kk * 33 + (lane & 31)] = W[(size_t)(k0 + kk) * N + n0 + (lane & 31)]; }
    asm volatile("s_waitcnt lgkmcnt(0)" ::: "memory");
    const int c = lane & 7;
#pragma unroll
    for (int j = 0; j < 4; ++j) { const int n = (lane >> 3) + 8 * j; const LAS float* s = scr + (8 * c) * 33 + n;
        u32x4 o; o.x = pk2(s[0 * 33], s[1 * 33]); o.y = pk2(s[2 * 33], s[3 * 33]); o.z = pk2(s[4 * 33], s[5 * 33]); o.w = pk2(s[6 * 33], s[7 * 33]);
        *(u32x4*)(WT + (size_t)(n0 + n) * K + k0 + 8 * c) = o; }
    asm volatile("s_waitcnt lgkmcnt(0)" ::: "memory");
}
DI void cvt_bf16_stream(const Frame& F, const float* src, bf16_t* dst, size_t n) {
    const size_t nth = (size_t)F.G * 512, t0 = (size_t)F.wg * 512 + F.tid;
    for (size_t i = t0; i < n / 8; i += nth) {
        const f32x4 a = *(const f32x4*)(src + i * 8), b = *(const f32x4*)(src + i * 8 + 4);
        u32x4 o; o.x = pk2(a[0], a[1]); o.y = pk2(a[2], a[3]); o.z = pk2(b[0], b[1]); o.w = pk2(b[2], b[3]);
        *(u32x4*)(dst + i * 8) = o;
    }
}
typedef float f32x16v __attribute__((ext_vector_type(16)));
typedef float f32x32v __attribute__((ext_vector_type(32)));
typedef __bf16 bf16x32v __attribute__((ext_vector_type(32)));
typedef unsigned u32x6 __attribute__((ext_vector_type(6)));
constexpr int ROWB = 1536, SLB = 192;
DI void cvt_fp6_rows(const Frame& F, const float* src, unsigned char* dst, float* inv_scale, int nrows) {
    LAS float* stage = (LAS float*)(F.lds + F.wave * 8192);
    for (int row = F.gw; row < nrows; row += F.ngw) {
        const float* sp = src + (size_t)row * DM;
        f32x4 v[8]; float mx = 0.f;
#pragma unroll
        for (int j = 0; j < 8; ++j) { v[j] = *(const f32x4*)(sp + 4 * (F.lane + 64 * j));
            mx = fmaxf(mx, fmaxf(fmaxf(fabsf(v[j][0]), fabsf(v[j][1])), fmaxf(fabsf(v[j][2]), fabsf(v[j][3])))); }
#pragma unroll
        for (int o = 1; o < 64; o <<= 1) mx = fmaxf(mx, __shfl_xor(mx, o));
        mx = fmaxf(mx, 1e-30f);
        const float sc = exp2f(floorf(log2f(7.0f / mx)));
#pragma unroll
        for (int j = 0; j < 8; ++j) *(LAS f32x4*)(stage + 4 * (F.lane + 64 * j)) = v[j] * sc;
        asm volatile("s_waitcnt lgkmcnt(0)" ::: "memory");
        f32x16v a, b;
#pragma unroll
        for (int j = 0; j < 8; ++j) { const f32x4 t0 = *(const LAS f32x4*)(stage + 32 * F.lane + 4 * j);
            a[2 * j] = t0[0]; b[2 * j] = t0[1]; a[2 * j + 1] = t0[2]; b[2 * j + 1] = t0[3]; }
        const u32x6 p = __builtin_amdgcn_cvt_scalef32_2xpk16_fp6_f32(a, b, 1.0f);
        unsigned char* dp = dst + ((size_t)(F.lane >> 3) * 16384 + row) * SLB + 24 * (F.lane & 7);
        *(u32x2*)dp = (u32x2){p[0], p[1]}; *(u32x2*)(dp + 8) = (u32x2){p[2], p[3]}; *(u32x2*)(dp + 16) = (u32x2){p[4], p[5]};
        if (F.lane == 0) inv_scale[row] = 1.f / sc;
        asm volatile("s_waitcnt lgkmcnt(0)" ::: "memory");
    }
}
DI void mod_gemv(const Frame& F, const Args& a) {
    const float* c = a.in[I_C]; const float* cctx = a.in[I_CCTX]; const float* wmod = a.in[I_WMOD]; const float* bmod = a.in[I_BMOD];
    float* modx = (float*)(a.ws + WS_MODX); float* modc = (float*)(a.ws + WS_MODC);
    LAS float* red = (LAS float*)F.lds;
    const int r = F.lane & 31, hh = F.lane >> 5;
    for (int blk = F.wg; blk < 768; blk += F.G) {
        const int l = blk / 384, j0 = (blk % 384) * 32;
        const float* W = wmod + (size_t)l * DM * 12288 + j0;
        f32x16 acc; for (int i = 0; i < 16; ++i) acc[i] = 0.f;
        const int kbeg = F.wave * 256;
        for (int ks = 0; ks < 16; ++ks) {
            const int k0 = kbeg + ks * 16 + 8 * hh;
            float av[8];
            if (r < 17) { const float* src = (r < 16) ? c + (size_t)r * DM + k0 : cctx + k0;
                const f32x4 x0 = *(const f32x4*)src, x1 = *(const f32x4*)(src + 4);
                av[0] = silu_f(x0[0]); av[1] = silu_f(x0[1]); av[2] = silu_f(x0[2]); av[3] = silu_f(x0[3]);
                av[4] = silu_f(x1[0]); av[5] = silu_f(x1[1]); av[6] = silu_f(x1[2]); av[7] = silu_f(x1[3]);
            } else { for (int i = 0; i < 8; ++i) av[i] = 0.f; }
            u32x4 ap; ap.x = pk2(av[0], av[1]); ap.y = pk2(av[2], av[3]); ap.z = pk2(av[4], av[5]); ap.w = pk2(av[6], av[7]);
            float bv[8];
#pragma unroll
            for (int i = 0; i < 8; ++i) bv[i] = W[(size_t)(k0 + i) * 12288 + r];
            u32x4 bp; bp.x = pk2(bv[0], bv[1]); bp.y = pk2(bv[2], bv[3]); bp.z = pk2(bv[4], bv[5]); bp.w = pk2(bv[6], bv[7]);
            acc = __builtin_amdgcn_mfma_f32_32x32x16_bf16(__builtin_bit_cast(bf16x8, ap), __builtin_bit_cast(bf16x8, bp), acc, 0, 0, 0);
        }
        __syncthreads();
#pragma unroll
        for (int i = 0; i < 16; ++i) { const int row = (i & 3) + 8 * (i >> 2) + 4 * hh; red[(F.wave * 32 + row) * 32 + r] = acc[i]; }
        __syncthreads();
        for (int o = F.tid; o < 17 * 32; o += 512) { const int row = o >> 5, col = o & 31; float s = 0.f;
#pragma unroll
            for (int w = 0; w < 8; ++w) s += red[(w * 32 + row) * 32 + col];
            s += bmod[(size_t)l * 12288 + j0 + col];
            if (row < 16) modx[((size_t)l * 16 + row) * 12288 + j0 + col] = s; else modc[(size_t)l * 12288 + j0 + col] = s; }
    }
    __syncthreads();
}
DI void prologue(const Frame& F, const Args& a) {
    LAS float* scr = (LAS float*)(F.lds + 32768 + F.wave * 8704);
    unsigned char* ws = a.ws;
    constexpr int I0 = 32 * 208, I1 = 32 * 64, I2 = 32 * 130, I3 = 32 * 64, I4 = 8 * 48, I5 = 8 * 64, I6 = 32 * 64, I7 = 32 * 64;
    constexpr int NIT = I0 + I1 + I2 + I3 + I4 + I5 + I6 + I7;
    for (int it = F.gw; it < NIT; it += F.ngw) {
        int r = it;
        if (r < I0) { transpose_item_fp8(a.in[I_EVIN], 2048, 6656, ws + WS_WIN0, scr, r, F.lane); continue; } r -= I0;
        if (r < I1) { transpose_item_fp8(a.in[I_EVOUT], 2048, 2048, ws + WS_WOUT0, scr, r, F.lane); continue; } r -= I1;
        if (r < I2) { transpose_item_fp8(a.in[I_ODIN], 2048, 4160, ws + WS_WIN1, scr, r, F.lane); continue; } r -= I2;
        if (r < I3) { transpose_item_fp8(a.in[I_ODOUT], 2048, 2048, ws + WS_WOUT1, scr, r, F.lane); continue; } r -= I3;
        if (r < I4) { transpose_item_fp8(a.in[I_MQUP], 512, 1536, ws + WS_WQUP, scr, r, F.lane, FP8_WSC2); continue; } r -= I4;
        if (r < I5) { transpose_item_fp8(a.in[I_MKVUP], 512, 2048, ws + WS_WKVUP, scr, r, F.lane, FP8_WSC2); continue; } r -= I5;
        if (r < I6) { transpose_item(a.in[I_PWQ], 2048, 2048, (bf16_t*)(ws + WS_WPQ), scr, r, F.lane); continue; } r -= I6;
        transpose_item(a.in[I_PWQ] + (size_t)2048 * 2048, 2048, 2048, (bf16_t*)(ws + WS_WPQ) + (size_t)2048 * 2048, scr, r, F.lane);
    }
    { u32x4* z = (u32x4*)(ws + WS_WIN1 + (size_t)4160 * 2048); const size_t n16 = (size_t)192 * 2048 / 16;
      for (size_t i = (size_t)F.wg * 512 + F.tid; i < n16; i += (size_t)F.G * 512) z[i] = (u32x4){0u, 0u, 0u, 0u}; }
    cvt_bf16_stream(F, a.in[I_PKEYS], (bf16_t*)(ws + WS_KEYS), (size_t)2 * 8 * 2 * 128 * 128);
    __syncthreads();
    cvt_fp6_rows(F, a.in[I_PU], ws + WS_U, (float*)(ws + WS_SU), 16384);
    cvt_fp6_rows(F, a.in[I_PV], ws + WS_V, (float*)(ws + WS_SV), 16384);
    mod_gemv(F, a);
}

template <bool SRC_BF16, bool DST_FP8>
DI void norm_mod_row(const Frame& F, const char* src, const f32x4 (&w)[8], const f32x4 (&sh)[8], const f32x4 (&sc)[8], bf16_t* dst, size_t row) {
    f32x4 v[8]; float ss = 0.f;
#pragma unroll
    for (int j = 0; j < 4; ++j) { const int c = 8 * (F.lane + 64 * j);
        if (SRC_BF16) { const u32x4 rr = *(const u32x4*)(src + (size_t)c * 2); v[2 * j] = (f32x4){bflo(rr.x), bfhi(rr.x), bflo(rr.y), bfhi(rr.y)}; v[2 * j + 1] = (f32x4){bflo(rr.z), bfhi(rr.z), bflo(rr.w), bfhi(rr.w)}; }
        else { v[2 * j] = *(const f32x4*)(src + (size_t)c * 4); v[2 * j + 1] = *(const f32x4*)(src + (size_t)c * 4 + 16); }
#pragma unroll
        for (int q = 0; q < 2; ++q) ss += v[2 * j + q][0] * v[2 * j + q][0] + v[2 * j + q][1] * v[2 * j + q][1] + v[2 * j + q][2] * v[2 * j + q][2] + v[2 * j + q][3] * v[2 * j + q][3]; }
    const float rstd = __frsqrt_rn(wave_sum(ss) * (1.f / DM) + EPS);
    bf16_t* o = dst + row * DM;
#pragma unroll
    for (int j = 0; j < 4; ++j) { const int c = 8 * (F.lane + 64 * j); unsigned pk[4];
#pragma unroll
        for (int q = 0; q < 2; ++q) { f32x4 y;
#pragma unroll
            for (int e = 0; e < 4; ++e) y[e] = (v[2 * j + q][e] * rstd * w[2 * j + q][e]) * (1.f + sc[2 * j + q][e]) + sh[2 * j + q][e];
            if (DST_FP8) pk[q] = (unsigned)pk4_fp8(y[0] * FP8_ASC, y[1] * FP8_ASC, y[2] * FP8_ASC, y[3] * FP8_ASC);
            else { pk[2 * q] = pk2(y[0], y[1]); pk[2 * q + 1] = pk2(y[2], y[3]); } }
        if (DST_FP8) *(u32x2*)((unsigned char*)dst + row * DM + c) = (u32x2){pk[0], pk[1]};
        else *(u32x4*)(o + c) = (u32x4){pk[0], pk[1], pk[2], pk[3]}; }
}
template <bool SRC_BF16, bool DST_FP8 = false>
DI void norm_mod_phase(const Frame& F, const void* srcX, const void* srcC, const float* nw, const float* modx_l, const float* modc_l, int sidx, bf16_t* dst, int nrows) {
    constexpr int SB = SRC_BF16 ? 2 : 4;
    f32x4 w[8], sh[8], sc[8];
#pragma unroll
    for (int j = 0; j < 4; ++j) { const int c = 8 * (F.lane + 64 * j); w[2 * j] = *(const f32x4*)(nw + c); w[2 * j + 1] = *(const f32x4*)(nw + c + 4); }
    for (int blk = F.gw; blk < MXR / 16; blk += F.ngw) {
        const int row0 = 16 * blk; const float* shift = modx_l + (size_t)(row0 >> 11) * 12288 + sidx * DM; const float* scale = shift + DM;
#pragma unroll
        for (int j = 0; j < 4; ++j) { const int c = 8 * (F.lane + 64 * j); sh[2 * j] = *(const f32x4*)(shift + c); sh[2 * j + 1] = *(const f32x4*)(shift + c + 4); sc[2 * j] = *(const f32x4*)(scale + c); sc[2 * j + 1] = *(const f32x4*)(scale + c + 4); }
#pragma unroll 1
        for (int i = 0; i < 16; ++i) norm_mod_row<SRC_BF16, DST_FP8>(F, (const char*)srcX + (size_t)(row0 + i) * DM * SB, w, sh, sc, dst, (size_t)(row0 + i));
    }
    if (nrows > MXR) {
        const float* shift = modc_l + sidx * DM; const float* scale = shift + DM;
#pragma unroll
        for (int j = 0; j < 4; ++j) { const int c = 8 * (F.lane + 64 * j); sh[2 * j] = *(const f32x4*)(shift + c); sh[2 * j + 1] = *(const f32x4*)(shift + c + 4); sc[2 * j] = *(const f32x4*)(scale + c); sc[2 * j + 1] = *(const f32x4*)(scale + c + 4); }
        for (int row = MXR + F.gw; row < nrows; row += F.ngw) norm_mod_row<SRC_BF16, DST_FP8>(F, (const char*)srcC + (size_t)(row - MXR) * DM * SB, w, sh, sc, dst, (size_t)row);
    }
}

DI void rope_pair(float& a, float& bsub, int lane, int posA, int posB, float inv) {
    const float pa = __shfl_xor(a, 32), pb = __shfl_xor(bsub, 32);
    const float angA = (float)posA * inv, angB = (float)posB * inv;
    const float sA = __sinf(angA), cA = __cosf(angA), sB = __sinf(angB), cB = __cosf(angB);
    const float sg = (lane < 32) ? -1.f : 1.f;
    a = a * cA + sg * pa * sA; bsub = bsub * cB + sg * pb * sB;
}
DI void gqa_prep_phase(const Frame& F, const Args& a) {
    const bf16_t* Z = (const bf16_t*)(a.ws + WS_Z);
    const float* qn = a.in[I_GQN]; const float* kn = a.in[I_GKN];
    const float inv = exp2f(-(float)(F.lane & 31) * (13.287712379549449f / 32.f));
    const float wq0 = qn[F.lane], wq1 = qn[64 + F.lane], wk0 = kn[F.lane], wk1 = kn[64 + F.lane];
    LAS unsigned char* Lin = F.lds + F.wave * 4608; LAS unsigned char* Lout = Lin + 3072;
    u32x4 nx[3];
    if (F.gw < MT) { const unsigned char* zr = (const unsigned char*)(Z + (size_t)F.gw * EV_IN);
#pragma unroll
        for (int i = 0; i < 3; ++i) nx[i] = *(const u32x4*)(zr + 1024 * i + 16 * F.lane); }
    for (int row = F.gw; row < MT; row += F.ngw) {
        const bool isx = row < MXR; const int t = row & 2047;
#pragma unroll
        for (int i = 0; i < 3; ++i) *(LAS u32x4*)(Lin + 1024 * i + 16 * F.lane) = nx[i];
        { const int nrow = (row + F.ngw < MT) ? row + F.ngw : row; const unsigned char* zn = (const unsigned char*)(Z + (size_t)nrow * EV_IN);
#pragma unroll
          for (int i = 0; i < 3; ++i) nx[i] = *(const u32x4*)(zn + 1024 * i + 16 * F.lane); }
        const LAS unsigned short* Li = (const LAS unsigned short*)Lin;
#pragma unroll
        for (int hv = 0; hv < 10; ++hv) {
            float v0 = __uint_as_float((unsigned)Li[hv * 128 + F.lane] << 16), v1 = __uint_as_float((unsigned)Li[hv * 128 + 64 + F.lane] << 16);
            const float ms = wave_sum(v0 * v0 + v1 * v1) * (1.f / 128.f);
            const float rs = __frsqrt_rn(ms + EPS);
            v0 = v0 * rs * (hv < 8 ? wq0 : wk0); v1 = v1 * rs * (hv < 8 ? wq1 : wk1);
            if (isx) rope_pair(v0, v1, F.lane, t >> 6, t & 63, inv);
            const float q8s = (hv < 8) ? QK8_SC * 1.020139447f : QK8_SC;
            Lout[hv * 128 + F.lane] = (unsigned char)(pk4_fp8(v0 * q8s, 0.f, 0.f, 0.f) & 0xff); Lout[hv * 128 + 64 + F.lane] = (unsigned char)(pk4_fp8(v1 * q8s, 0.f, 0.f, 0.f) & 0xff);
        }
#pragma unroll
        for (int q = 0; q < 4; ++q) Lout[1280 + 64 * q + F.lane] = (unsigned char)(pk4_fp8(__uint_as_float((unsigned)Li[1280 + 64 * q + F.lane] << 16), 0.f, 0.f, 0.f) & 0xff);
        *(u32x4*)(a.ws + WS_Q8 + (size_t)row * 1024 + 16 * F.lane) = *(const LAS u32x4*)(Lout + 16 * F.lane);
        if (F.lane < 32) { const u32x4 w1 = *(const LAS u32x4*)(Lout + 1024 + 16 * F.lane);
            unsigned char* dp = (F.lane < 16) ? (a.ws + WS_K8 + (size_t)row * 256 + 16 * F.lane) : (a.ws + WS_V8G + (size_t)row * 256 + 16 * (F.lane - 16));
            *(u32x4*)dp = w1; }
    }
}

struct AttnP {
    const bf16_t* Q; int ldq;
    const bf16_t* K1; int ldk1;
    const bf16_t* K2; int ldk2;
    const bf16_t* V; int ldv;
    unsigned char* O; int ldo;
    int qrow0;
    int orow0;
    int b;
    int nctx_tiles;
    int xtile0, nx_tiles;
    float sc_log2e;
    const float* rpb; int qgrow0;
};
template <int DK, bool NA, bool FAST>
DI void attn_unit(const Frame& F, const AttnP& p) {
    constexpr int KST = DK * 2 + 16;
    constexpr int VST = 320;
    constexpr int KBYTES = 64 * KST, VBYTES = 64 * VST;
    constexpr int NKS = DK / 16;
    constexpr int KCH = DK / 8;
    constexpr int KLD = (64 * KCH) / 512;
    LAS unsigned char* Ks = F.lds; LAS unsigned char* Vs = F.lds + KBYTES; LAS float* rp = (LAS float*)(F.lds + KBYTES + VBYTES);
    const int lane = F.lane, w = F.wave, r = lane & 31, hh = lane >> 5;
    const int ntiles = p.nctx_tiles + p.nx_tiles;
    if (NA) { for (int i = F.tid; i < 15 * 31; i += 512) rp[i] = p.rpb[i]; }
    bf16x8 qf[NKS];
    { const bf16_t* qp = p.Q + (size_t)(p.qrow0 + 32 * w + r) * p.ldq + 8 * hh;
#pragma unroll
      for (int ks = 0; ks < NKS; ++ks) qf[ks] = *(const bf16x8*)(qp + 16 * ks); }
    f32x16 oacc[4];
#pragma unroll
    for (int d = 0; d < 4; ++d) for (int i = 0; i < 16; ++i) oacc[d][i] = 0.f;
    float m_run = -1e30f, l_run = 0.f;
    u32x4 kreg[KLD], vreg[2];
#define ATT_TILE_ROW(j) (((j) < p.nctx_tiles) ? (MXR + p.b * CTXL + 64 * (j)) : (p.b * SEQ + 64 * (p.xtile0 + (j) - p.nctx_tiles)))
#define ATT_ISSUE(j) do { const int row0_ = ATT_TILE_ROW(j); \
        _Pragma("unroll") for (int i_ = 0; i_ < KLD; ++i_) { const int c_ = F.tid + 512 * i_, kr_ = c_ / KCH, kc_ = c_ % KCH; \
            if (DK == 128 || kc_ < 16) kreg[i_] = *(const u32x4*)(p.K1 + (size_t)(row0_ + kr_) * p.ldk1 + 8 * kc_); \
            else kreg[i_] = *(const u32x4*)(p.K2 + (size_t)(row0_ + kr_) * p.ldk2 + 8 * (kc_ - 16)); } \
        _Pragma("unroll") for (int i_ = 0; i_ < 2; ++i_) { const int c_ = F.tid + 512 * i_, vr_ = c_ >> 4, vc_ = c_ & 15; \
            vreg[i_] = *(const u32x4*)(p.V + (size_t)(row0_ + vr_) * p.ldv + 8 * vc_); } } while (0)
#define ATT_WRITE() do { \
        _Pragma("unroll") for (int i_ = 0; i_ < KLD; ++i_) { const int c_ = F.tid + 512 * i_, kr_ = c_ / KCH, kc_ = c_ % KCH; *(LAS u32x4*)(Ks + kr_ * KST + 16 * kc_) = kreg[i_]; } \
        _Pragma("unroll") for (int i_ = 0; i_ < 2; ++i_) { const int c_ = F.tid + 512 * i_, vr_ = c_ >> 4, vc_ = c_ & 15; *(LAS u32x4*)(Vs + vr_ * VST + 16 * vc_) = vreg[i_]; } } while (0)
    const int qgr = NA ? (p.qgrow0 + (w >> 1)) : 0;
    const int qc = 32 * (w & 1) + r;
    const int r0w = NA ? min(max(qgr - 4, 0), 24) : 0;
    const int csq = min(max(qc - 8, 0), 48);
    const int tq = (lane & 15) >> 2, tp = lane & 3, dsub = (lane >> 4) & 1;
    const unsigned vtr_base = (unsigned)(size_t)(Vs) + (unsigned)((4 * hh + tq) * VST + (16 * dsub + 4 * tp) * 2);
    const unsigned kfr_base = (unsigned)(size_t)(Ks) + (unsigned)(r * KST + 16 * hh);
    ATT_ISSUE(0);
    for (int j = 0; j < ntiles; ++j) {
        __syncthreads();
        ATT_WRITE();
        if (j + 1 < ntiles) ATT_ISSUE(j + 1);
        __syncthreads();
        bool active = true; int dr = 0;
        if (NA && j >= p.nctx_tiles) { const int kr = p.xtile0 + (j - p.nctx_tiles); active = (kr >= r0w) && (kr < r0w + 8); dr = kr - qgr + 7; }
        if (!active) continue;
        f32x16 st[2];
#pragma unroll
        for (int kb = 0; kb < 2; ++kb) for (int i = 0; i < 16; ++i) st[kb][i] = 0.f;
        {
            constexpr int NT = 2 * NKS;
            bf16x8 kr[4];
#define K_READ(R, T) asm volatile("ds_read_b128 %0, %1 offset:%2" : "=v"(R) : "v"(kfr_base), "n"(32 * ((T) / NKS) * KST + 32 * ((T) % NKS)) : "memory")
#define K_WAIT(R, N) asm volatile("s_waitcnt lgkmcnt(%1)" : "+v"(R) : "n"(N) : "memory")
            K_READ(kr[0], 0); K_READ(kr[1], 1); K_READ(kr[2], 2); K_READ(kr[3], 3);
#pragma unroll
            for (int t = 0; t < NT; ++t) {
                K_WAIT(kr[t & 3], (NT - 1 - t) < 3 ? (NT - 1 - t) : 3);
                st[t / NKS] = __builtin_amdgcn_mfma_f32_32x32x16_bf16(kr[t & 3], qf[t % NKS], st[t / NKS], 0, 0, 0);
                if (t + 4 < NT) K_READ(kr[t & 3], t + 4);
            }
#undef K_READ
#undef K_WAIT
        }
        s16x4 vlo[4], vhi[4];
#define V_READ(I, T) asm volatile("ds_read_b64_tr_b16 %0, %2 offset:%3\n\tds_read_b64_tr_b16 %1, %2 offset:%4" : "=&v"(vlo[I]), "=&v"(vhi[I]) : "v"(vtr_base), "n"(16 * ((T) >> 2) * VST + 64 * ((T) & 3)), "n"(16 * ((T) >> 2) * VST + 64 * ((T) & 3) + 8 * VST) : "memory")
#define V_WAIT(I, N) asm volatile("s_waitcnt lgkmcnt(%2)" : "+v"(vlo[I]), "+v"(vhi[I]) : "n"(N) : "memory")
        V_READ(0, 0); V_READ(1, 1); V_READ(2, 2); V_READ(3, 3);
        if constexpr (FAST) {
        float tmax = -1e30f;
        if (NA && j >= p.nctx_tiles) {
#pragma unroll
            for (int kb = 0; kb < 2; ++kb)
#pragma unroll
                for (int i = 0; i < 16; ++i) {
                    const int kc = 32 * kb + (i & 3) + 8 * (i >> 2) + 4 * hh; const bool inw = (kc >= csq) && (kc < csq + 16);
                    const int dc = min(max(kc - qc + 15, 0), 30); const float bias = rp[dr * 31 + dc];
                    const float sv = inw ? __builtin_fmaf(st[kb][i], p.sc_log2e, bias * 1.4426950408889634f) : -1e30f;
                    st[kb][i] = sv; tmax = fmaxf(tmax, sv); }
        } else {
#pragma unroll
            for (int kb = 0; kb < 2; ++kb)
#pragma unroll
                for (int i = 0; i < 16; ++i) tmax = fmaxf(tmax, st[kb][i]);
            tmax *= p.sc_log2e;
        }
        tmax = fmaxf(tmax, __shfl_xor(tmax, 32));
        if (__any(tmax > m_run + 11.5f)) {
            const float m_new = fmaxf(m_run, tmax);
            const float alpha = __builtin_amdgcn_exp2f(m_run - m_new);
            m_run = m_new; l_run *= alpha;
#pragma unroll
            for (int d = 0; d < 4; ++d)
#pragma unroll
                for (int i = 0; i < 16; ++i) oacc[d][i] *= alpha;
        }
        float psum = 0.f;
        if (NA && j >= p.nctx_tiles) {
#pragma unroll
            for (int kb = 0; kb < 2; ++kb)
#pragma unroll
                for (int i = 0; i < 16; ++i) { const float e = __builtin_amdgcn_exp2f(st[kb][i] - m_run); st[kb][i] = e; psum += e; }
        } else {
#pragma unroll
            for (int kb = 0; kb < 2; ++kb)
#pragma unroll
                for (int i = 0; i < 16; ++i) { const float e = __builtin_amdgcn_exp2f(__builtin_fmaf(st[kb][i], p.sc_log2e, -m_run)); st[kb][i] = e; psum += e; }
        }
        l_run += psum;
        } else {
        float tmax = -1e30f;
#pragma unroll
        for (int kb = 0; kb < 2; ++kb)
#pragma unroll
            for (int i = 0; i < 16; ++i) {
                float s = st[kb][i] * p.sc_log2e;
                if (NA && j >= p.nctx_tiles) { const int kc = 32 * kb + (i & 3) + 8 * (i >> 2) + 4 * hh; const bool inw = (kc >= csq) && (kc < csq + 16);
                    const int dc = min(max(kc - qc + 15, 0), 30); const float bias = rp[dr * 31 + dc];
                    s = inw ? (s + bias * 1.4426950408889634f) : -1e30f; }
                st[kb][i] = s; tmax = fmaxf(tmax, s); }
        tmax = fmaxf(tmax, __shfl_xor(tmax, 32));
        const float m_new = fmaxf(m_run, tmax);
        const float alpha = exp2f(m_run - m_new);
        m_run = m_new;
        float psum = 0.f;
#pragma unroll
        for (int kb = 0; kb < 2; ++kb)
#pragma unroll
            for (int i = 0; i < 16; ++i) { const float e = exp2f(st[kb][i] - m_new); st[kb][i] = e; psum += e; }
        l_run = l_run * alpha + psum;
#pragma unroll
        for (int d = 0; d < 4; ++d)
#pragma unroll
            for (int i = 0; i < 16; ++i) oacc[d][i] *= alpha;
        }
#pragma unroll
        for (int t = 0; t < 16; ++t) {
            const int T = t >> 2, KB = T >> 1, S = T & 1, d = t & 3;
            u32x4 pp; pp.x = pk2(st[KB][8 * S + 0], st[KB][8 * S + 1]); pp.y = pk2(st[KB][8 * S + 2], st[KB][8 * S + 3]);
            pp.z = pk2(st[KB][8 * S + 4], st[KB][8 * S + 5]); pp.w = pk2(st[KB][8 * S + 6], st[KB][8 * S + 7]);
            const bf16x8 pf = __builtin_bit_cast(bf16x8, pp);
            if (t < 13) V_WAIT(t & 3, 6); else if (t == 13) V_WAIT(t & 3, 4); else if (t == 14) V_WAIT(t & 3, 2); else V_WAIT(t & 3, 0);
            oacc[d] = __builtin_amdgcn_mfma_f32_32x32x16_bf16(__builtin_shufflevector(vlo[t & 3], vhi[t & 3], 0, 1, 2, 3, 4, 5, 6, 7), pf, oacc[d], 0, 0, 0);
            if (t + 4 < 16) {
                if ((t & 3) == 0) V_READ(0, t + 4); else if ((t & 3) == 1) V_READ(1, t + 4); else if ((t & 3) == 2) V_READ(2, t + 4); else V_READ(3, t + 4);
            }
        }
#undef V_READ
#undef V_WAIT
    }
    const float lt = l_run + __shfl_xor(l_run, 32);
    const float il = 1.f / lt;
    unsigned char* op = p.O + (size_t)(p.orow0 + 32 * w + r) * p.ldo;
    const float ils = il * FP8_ASC;
#pragma unroll
    for (int d = 0; d < 4; ++d)
#pragma unroll
        for (int g = 0; g < 4; ++g) *(int*)(op + 32 * d + 8 * g + 4 * hh) = pk4_fp8(oacc[d][4 * g + 0] * ils, oacc[d][4 * g + 1] * ils, oacc[d][4 * g + 2] * ils, oacc[d][4 * g + 3] * ils);
    __syncthreads();
#undef ATT_TILE_ROW
#undef ATT_ISSUE
#undef ATT_WRITE
}

typedef int i32x8 __attribute__((ext_vector_type(8)));
struct AttnQK8 { const unsigned char* Q8; int ldq8; const unsigned char* K8a; int ldk8a; const unsigned char* K8b; int ldk8b; const unsigned char* V8; int ldv8; };
template <int DK, bool QBF16, bool NA = false, bool QROPE = false>
DI void attn_unit_f8(const Frame& F, const AttnP& p, const AttnQK8& e) {
    constexpr int KST = DK + 16, VS8 = 144, KBYTES = 64 * KST, VBYTES = 64 * VS8;
    constexpr float QC = (DK == 192) ? 1.665880740f : 1.020139447f; constexpr int KSCALE = ((DK == 192) ? 115 : 116) * 0x01010101;
    constexpr float PTHR = 4.f;
    constexpr int NC = DK / 64, KCH = DK / 16, NCHUNK = 64 * KCH, KLD = (NCHUNK + 511) / 512, NT = 2 * NC;
    LAS unsigned char* Ks = F.lds; LAS unsigned char* Vs = F.lds + KBYTES; LAS float* rp = (LAS float*)(F.lds + KBYTES + VBYTES);
    const int lane = F.lane, w = F.wave, r = lane & 31, hh = lane >> 5;
    const int ntiles = p.nctx_tiles + p.nx_tiles;
    if (NA) { for (int i = F.tid; i < 15 * 31; i += 512) rp[i] = p.rpb[i]; }
    i32x8 qf[NC];
    if constexpr (QBF16) {
        const bf16_t* qp = p.Q + (size_t)(p.qrow0 + 32 * w + r) * p.ldq + 32 * hh;
#pragma unroll
        for (int c = 0; c < NC; ++c) {
#pragma unroll
            for (int g = 0; g < 4; ++g) { const u32x4 q4 = *(const u32x4*)(qp + 64 * c + 8 * g);
                qf[c][2 * g] = pk4_fp8(bflo(q4.x) * (QK8_SC * QC), bfhi(q4.x) * (QK8_SC * QC), bflo(q4.y) * (QK8_SC * QC), bfhi(q4.y) * (QK8_SC * QC));
                qf[c][2 * g + 1] = pk4_fp8(bflo(q4.z) * (QK8_SC * QC), bfhi(q4.z) * (QK8_SC * QC), bflo(q4.w) * (QK8_SC * QC), bfhi(q4.w) * (QK8_SC * QC)); } }
        if constexpr (QROPE) {
            float v[32];
#pragma unroll
            for (int g = 0; g < 4; ++g) { const u32x4 q4 = *(const u32x4*)(qp + 64 * (NC - 1) + 8 * g);
                v[8 * g + 0] = bflo(q4.x); v[8 * g + 1] = bfhi(q4.x); v[8 * g + 2] = bflo(q4.y); v[8 * g + 3] = bfhi(q4.y);
                v[8 * g + 4] = bflo(q4.z); v[8 * g + 5] = bfhi(q4.z); v[8 * g + 6] = bflo(q4.w); v[8 * g + 7] = bfhi(q4.w); }
            const int tpos = (p.qrow0 + 32 * w + r) & 2047; const float pos = (float)(hh ? (tpos & 63) : (tpos >> 6));
#pragma unroll
            for (int i = 0; i < 16; ++i) { const float ang = pos * exp2f(-(float)i * (13.287712379549449f / 16.f)); const float sn = __sinf(ang), cs = __cosf(ang);
                const float x0 = v[i], x1 = v[i + 16]; v[i] = x0 * cs - x1 * sn; v[i + 16] = x1 * cs + x0 * sn; }
#pragma unroll
            for (int g = 0; g < 8; ++g) qf[NC - 1][g] = pk4_fp8(v[4 * g] * (QK8_SC * QC), v[4 * g + 1] * (QK8_SC * QC), v[4 * g + 2] * (QK8_SC * QC), v[4 * g + 3] * (QK8_SC * QC));
        }
    } else {
      const unsigned char* qp = e.Q8 + (size_t)(p.qrow0 + 32 * w + r) * e.ldq8 + 32 * hh;
#pragma unroll
      for (int c = 0; c < NC; ++c) { const u32x4 qa = *(const u32x4*)(qp + 64 * c), qb = *(const u32x4*)(qp + 64 * c + 16); qf[c] = __builtin_bit_cast(i32x8, __builtin_shufflevector(qa, qb, 0, 1, 2, 3, 4, 5, 6, 7)); } }
    f32x16 oacc[4];
#pragma unroll
    for (int d = 0; d < 4; ++d) for (int i = 0; i < 16; ++i) oacc[d][i] = 0.f;
    constexpr bool LSUM = (DK == 128 && !NA);
    float l_run = 0.f;
    f32x16 lacc;
#pragma unroll
    for (int i = 0; i < 16; ++i) lacc[i] = 0.f;
    f32x16 cinit;
#pragma unroll
    for (int i = 0; i < 16; ++i) cinit[i] = 0.f;
    u32x4 kreg[KLD], vreg;
#define A8_TILE_ROW(j) (((j) < p.nctx_tiles) ? (MXR + p.b * CTXL + 64 * (j)) : (p.b * SEQ + 64 * (p.xtile0 + (j) - p.nctx_tiles)))
#define A8_ISSUE(j) do { const int row0_ = A8_TILE_ROW(j); \
        _Pragma("unroll") for (int i_ = 0; i_ < KLD; ++i_) { const int c_ = F.tid + 512 * i_, kr_ = c_ / KCH, kc_ = c_ % KCH; \
            if (c_ < NCHUNK) { if (DK == 128 || kc_ < 8) kreg[i_] = *(const u32x4*)(e.K8a + (size_t)(row0_ + kr_) * e.ldk8a + 16 * kc_); \
                               else kreg[i_] = *(const u32x4*)(e.K8b + (size_t)(row0_ + kr_) * e.ldk8b + 16 * (kc_ - 8)); } } \
        vreg = *(const u32x4*)(e.V8 + (size_t)(row0_ + (F.tid >> 3)) * e.ldv8 + 16 * (F.tid & 7)); } while (0)
#define A8_WRITE() do { \
        _Pragma("unroll") for (int i_ = 0; i_ < KLD; ++i_) { const int c_ = F.tid + 512 * i_, kr_ = c_ / KCH, kc_ = c_ % KCH; if (c_ < NCHUNK) *(LAS u32x4*)(Ks + kr_ * KST + 16 * kc_) = kreg[i_]; } \
        *(LAS u32x4*)(Vs + (F.tid >> 3) * VS8 + 16 * (F.tid & 7)) = vreg; } while (0)
    const int qgr = NA ? (p.qgrow0 + (w >> 1)) : 0;
    const int qc = 32 * (w & 1) + r;
    const int r0w = NA ? min(max(qgr - 4, 0), 24) : 0;
    const int csq = min(max(qc - 8, 0), 48);
    const unsigned vt_base = (unsigned)(size_t)(Vs) + (unsigned)((8 * (((lane & 15) >> 1) >> 2) + 4 * hh + (((lane & 15) >> 1) & 3)) * VS8 + 16 * ((lane >> 4) & 1) + 8 * (lane & 1));
    const unsigned kfr_base = (unsigned)(size_t)(Ks) + (unsigned)(r * KST + 32 * hh);
    A8_ISSUE(0);
    for (int j = 0; j < ntiles; ++j) {
        __syncthreads();
        A8_WRITE();
        if (j + 1 < ntiles) A8_ISSUE(j + 1);
        __syncthreads();
        bool active = true; int dr = 0;
        if (NA && j >= p.nctx_tiles) { const int krow = p.xtile0 + (j - p.nctx_tiles); active = (krow >= r0w) && (krow < r0w + 8); dr = krow - qgr + 7; }
        if (!active) continue;
        f32x16 st[2];
        {
            u32x4 klo[4], khi[4];
#define K8_READ(I, T) asm volatile("ds_read_b128 %0, %2 offset:%3\n\tds_read_b128 %1, %2 offset:%4" : "=&v"(klo[I]), "=&v"(khi[I]) : "v"(kfr_base), "n"(32 * ((T) / NC) * KST + 64 * ((T) % NC)), "n"(32 * ((T) / NC) * KST + 64 * ((T) % NC) + 16) : "memory")
#define K8_WAIT(I, N) asm volatile("s_waitcnt lgkmcnt(%2)" : "+v"(klo[I]), "+v"(khi[I]) : "n"(N) : "memory")
            K8_READ(0, 0); K8_READ(1, 1); K8_READ(2, 2); K8_READ(3, 3);
#pragma unroll
            for (int t = 0; t < NT; ++t) {
                const int last = (t + 3 < NT - 1) ? t + 3 : NT - 1;
                if ((t & 3) == 0) K8_WAIT(0, 2 * (last - t)); else if ((t & 3) == 1) K8_WAIT(1, 2 * (last - t)); else if ((t & 3) == 2) K8_WAIT(2, 2 * (last - t)); else K8_WAIT(3, 2 * (last - t));
                const i32x8 kf = __builtin_bit_cast(i32x8, __builtin_shufflevector(klo[t & 3], khi[t & 3], 0, 1, 2, 3, 4, 5, 6, 7));
                st[t / NC] = __builtin_amdgcn_mfma_scale_f32_32x32x64_f8f6f4(kf, qf[t % NC], (t % NC == 0) ? cinit : st[t / NC], 0, 0, 0, KSCALE, 0, 0x7f7f7f7f);
                if (t + 4 < NT) { if ((t & 3) == 0) K8_READ(0, t + 4); else if ((t & 3) == 1) K8_READ(1, t + 4); else if ((t & 3) == 2) K8_READ(2, t + 4); else K8_READ(3, t + 4); }
            }
#undef K8_READ
#undef K8_WAIT
        }
        u32x2 va[2][4];
#define V_READ(I, D) asm volatile("ds_read_b64_tr_b8 %0, %4 offset:%5\n\tds_read_b64_tr_b8 %1, %4 offset:%6\n\tds_read_b64_tr_b8 %2, %4 offset:%7\n\tds_read_b64_tr_b8 %3, %4 offset:%8" \
            : "=&v"(va[I][0]), "=&v"(va[I][1]), "=&v"(va[I][2]), "=&v"(va[I][3]) : "v"(vt_base), "n"(32 * (D)), "n"(16 * VS8 + 32 * (D)), "n"(32 * VS8 + 32 * (D)), "n"(48 * VS8 + 32 * (D)) : "memory")
#define V_WAIT(I, N) asm volatile("s_waitcnt lgkmcnt(%4)" : "+v"(va[I][0]), "+v"(va[I][1]), "+v"(va[I][2]), "+v"(va[I][3]) : "n"(N) : "memory")
        V_READ(0, 0); V_READ(1, 1);
        float tmax = -1e30f;
        const bool masked = NA && j >= p.nctx_tiles;
        if (masked) {
            const LAS float* rpb = rp + dr * 31 + (4 * hh - qc + 15); const int m0 = 4 * hh - csq;
#pragma unroll
            for (int kb = 0; kb < 2; ++kb)
#pragma unroll
                for (int i = 0; i < 16; ++i) {
                    const int dl = 32 * kb + (i & 3) + 8 * (i >> 2); const bool inw = (unsigned)(dl + m0) < 16u;
                    const float bias = rpb[dl];
                    const float sv = inw ? __builtin_fmaf(bias, 1.4426950408889634f, st[kb][i]) : -1e30f;
                    st[kb][i] = sv; tmax = fmaxf(tmax, sv); }
        } else {
#pragma unroll
            for (int kb = 0; kb < 2; ++kb)
#pragma unroll
                for (int i = 0; i < 16; ++i) tmax = fmaxf(tmax, st[kb][i]);
        }
        tmax = fmaxf(tmax, __shfl_xor(tmax, 32));
        if (j == 0 || __any(tmax > 4.f + PTHR)) {
            const float dm = (j == 0) ? (tmax - 4.f) : fmaxf(tmax - 4.f, 0.f);
            const float alpha = __builtin_amdgcn_exp2f(-dm);
            l_run *= alpha;
            if constexpr (LSUM) {
#pragma unroll
                for (int i = 0; i < 16; ++i) lacc[i] *= alpha; }
#pragma unroll
            for (int d = 0; d < 4; ++d)
#pragma unroll
                for (int i = 0; i < 16; ++i) oacc[d][i] *= alpha;
#pragma unroll
            for (int kb = 0; kb < 2; ++kb)
#pragma unroll
                for (int i = 0; i < 16; ++i) st[kb][i] -= dm;
            const float cn = cinit[0] - dm;
#pragma unroll
            for (int i = 0; i < 16; ++i) cinit[i] = cn;
        }
        float psum = 0.f;
#pragma unroll
        for (int kb = 0; kb < 2; ++kb)
#pragma unroll
            for (int i = 0; i < 16; ++i) { const float ex = __builtin_amdgcn_exp2f(st[kb][i]); st[kb][i] = ex; if constexpr (!LSUM) psum += ex; }
        l_run += psum;
        i32x8 pf;
#pragma unroll
        for (int v = 0; v < 8; ++v) { const int kb = v >> 2, m = v & 3;
            int t = __builtin_amdgcn_cvt_pk_fp8_f32(st[kb][4 * m], st[kb][4 * m + 1], 0, false); pf[v] = __builtin_amdgcn_cvt_pk_fp8_f32(st[kb][4 * m + 2], st[kb][4 * m + 3], t, true); }
        if constexpr (LSUM) { i32x8 ones; for (int v = 0; v < 8; ++v) ones[v] = 0x38383838;
            lacc = __builtin_amdgcn_mfma_scale_f32_32x32x64_f8f6f4(ones, pf, lacc, 0, 0, 0, 0x7f7f7f7f, 0, 0x7f7f7f7f); }
#pragma unroll
        for (int d = 0; d < 4; ++d) {
            if (d == 0) V_WAIT(0, 4); else if (d == 1) V_WAIT(1, 4); else if (d == 2) V_WAIT(0, 4); else V_WAIT(1, 0);
            const i32x8 vf = __builtin_bit_cast(i32x8, __builtin_shufflevector(__builtin_shufflevector(va[d & 1][0], va[d & 1][1], 0, 1, 2, 3), __builtin_shufflevector(va[d & 1][2], va[d & 1][3], 0, 1, 2, 3), 0, 1, 2, 3, 4, 5, 6, 7));
            oacc[d] = __builtin_amdgcn_mfma_scale_f32_32x32x64_f8f6f4(vf, pf, oacc[d], 0, 0, 0, 0x7f7f7f7f, 0, 0x7f7f7f7f);
            if (d == 0) V_READ(0, 2); else if (d == 1) V_READ(1, 3);
        }
#undef V_READ
#undef V_WAIT
    }
    const float lt = LSUM ? lacc[0] : (l_run + __shfl_xor(l_run, 32));
    const float il = 1.f / lt;
    unsigned char* op = p.O + (size_t)(p.orow0 + 32 * w + r) * p.ldo;
    const float ils = il * FP8_ASC;
#pragma unroll
    for (int d = 0; d < 4; ++d) {
        unsigned wq[4];
#pragma unroll
        for (int g = 0; g < 4; ++g) wq[g] = (unsigned)pk4_fp8(oacc[d][4 * g + 0] * ils, oacc[d][4 * g + 1] * ils, oacc[d][4 * g + 2] * ils, oacc[d][4 * g + 3] * ils);
        const auto s02 = __builtin_amdgcn_permlane32_swap(wq[0], wq[2], false, false), s13 = __builtin_amdgcn_permlane32_swap(wq[1], wq[3], false, false);
        *(u32x4*)(op + 32 * d + 16 * hh) = (u32x4){s02[0], s02[1], s13[0], s13[1]};
    }
    __syncthreads();
#undef A8_TILE_ROW
#undef A8_ISSUE
#undef A8_WRITE
}

DI int hg_tok_row(int b, int dir, int c, int t) {
    if (c < 8) { const int pos = 32 * c + t; return MXR + b * CTXL + (dir ? (CTXL - 1 - pos) : pos); }
    const int pos = 32 * (c - 8) + t; return b * SEQ + (dir ? (SEQ - 1 - pos) : pos);
}
DI void hgrn_pair(const Frame& F, const Args& a, int pair) {
    const int b = pair >> 3, h = pair & 7, dir = F.tid >> 8;
    const bf16_t* Z = (const bf16_t*)(a.ws + WS_Z);
    bf16_t* OUT = (bf16_t*)(a.ws + (dir ? WS_OB : WS_OF));
    LAS unsigned char* base = F.lds + dir * 65536;
    LAS float* G = (LAS float*)base;
    LAS unsigned char* QE1 = base + 16384;
    LAS unsigned char* KE = base + 25088;
    LAS unsigned char* QE2 = base + 33792;
    LAS unsigned char* KDr = base + 42496;
    LAS unsigned char* VVr = base + 51712;
    LAS float* DL = (LAS float*)(base + 60928);
    const int t256 = F.tid & 255, lane = F.lane, wl = F.wave & 3;
    const int tau = t256 >> 3, dq = (t256 & 7) * 16;
    LAS float* LB = (LAS float*)(base + 61440);
    if (t256 < 128) { const float* hl = a.in[I_HLB] + (size_t)dir * 3 * 1024 + h * 128 + t256; const float v0 = hl[0], v1 = hl[1024], v2 = hl[2048]; const float mx = fmaxf(v0, fmaxf(v1, v2));
        const float e0 = __expf(v0 - mx), e1 = __expf(v1 - mx), e2 = __expf(v2 - mx); LB[t256] = e0 / (e0 + e1 + e2); }
    __syncthreads();
    const int qcol = 1536 + h * 128 + dq, fcol = (dir ? 3584 : 2560) + h * 128 + dq, vcol = 4608 + h * 128 + dq;
    u32x4 rq[2], rf[2], rv[2];
#pragma unroll
    for (int g = 0; g < 2; ++g) {
        { const bf16_t* zr = Z + (size_t)hg_tok_row(b, dir, 0, tau) * EV_IN + 8 * g; rq[g] = *(const u32x4*)(zr + qcol); rf[g] = *(const u32x4*)(zr + fcol); rv[g] = *(const u32x4*)(zr + vcol); }
    }
    f32x4 S[2][8];
#pragma unroll
    for (int nb = 0; nb < 2; ++nb)
#pragma unroll
        for (int i = 0; i < 8; ++i) S[nb][i] = (f32x4){0.f, 0.f, 0.f, 0.f};
    const int fr = lane & 15, fg = lane >> 4;
    for (int c = 0; c < 72; ++c) {
        float kv[2][8], gv[2][8];
#pragma unroll
        for (int g = 0; g < 2; ++g) {
            const unsigned uf[4] = {rf[g].x, rf[g].y, rf[g].z, rf[g].w};
            const f32x4 lb0 = *(const LAS f32x4*)(LB + dq + 8 * g), lb1 = *(const LAS f32x4*)(LB + dq + 8 * g + 4); const float lbv[8] = {lb0[0], lb0[1], lb0[2], lb0[3], lb1[0], lb1[1], lb1[2], lb1[3]};
#pragma unroll
            for (int i = 0; i < 4; ++i) {
                const float f0 = bflo(uf[i]), f1 = bfhi(uf[i]);
                const float s0 = __builtin_amdgcn_rcpf(1.f + __expf(-f0)), s1 = __builtin_amdgcn_rcpf(1.f + __expf(-f1));
                const float l0 = lbv[2 * i], l1 = lbv[2 * i + 1];
                kv[g][2 * i] = (1.f - l0) * (1.f - s0); kv[g][2 * i + 1] = (1.f - l1) * (1.f - s1);
                gv[g][2 * i] = __logf(l0 + (1.f - l0) * s0); gv[g][2 * i + 1] = __logf(l1 + (1.f - l1) * s1); }
            *(LAS f32x4*)(G + tau * 128 + dq + 8 * g) = (f32x4){gv[g][0], gv[g][1], gv[g][2], gv[g][3]};
            *(LAS f32x4*)(G + tau * 128 + dq + 8 * g + 4) = (f32x4){gv[g][4], gv[g][5], gv[g][6], gv[g][7]}; }
        __syncthreads();
        if (t256 < 128) { float run = 0.f;
#pragma unroll
            for (int t = 0; t < 32; ++t) { run += G[t * 128 + t256]; G[t * 128 + t256] = run; } }
        __syncthreads();
#pragma unroll
        for (int g = 0; g < 2; ++g) { const int d0 = dq + 8 * g;
          const f32x4 c0 = *(const LAS f32x4*)(G + tau * 128 + d0), c1 = *(const LAS f32x4*)(G + tau * 128 + d0 + 4);
          const f32x4 m0 = *(const LAS f32x4*)(G + 15 * 128 + d0), m1 = *(const LAS f32x4*)(G + 15 * 128 + d0 + 4);
          const f32x4 e0 = *(const LAS f32x4*)(G + 31 * 128 + d0), e1 = *(const LAS f32x4*)(G + 31 * 128 + d0 + 4);
          float cu[8] = {c0[0], c0[1], c0[2], c0[3], c1[0], c1[1], c1[2], c1[3]};
          float mm[8] = {m0[0], m0[1], m0[2], m0[3], m1[0], m1[1], m1[2], m1[3]};
          float la[8] = {e0[0], e0[1], e0[2], e0[3], e1[0], e1[1], e1[2], e1[3]};
          const unsigned uq[4] = {rq[g].x, rq[g].y, rq[g].z, rq[g].w};
          float qv[8], q1[8], k1[8], q2[8], kd[8];
#pragma unroll
          for (int i = 0; i < 4; ++i) { qv[2 * i] = bflo(uq[i]); qv[2 * i + 1] = bfhi(uq[i]); }
#pragma unroll
          for (int i = 0; i < 8; ++i) { q1[i] = qv[i] * __expf(cu[i] - mm[i]); k1[i] = kv[g][i] * __expf(mm[i] - cu[i]); q2[i] = qv[i] * __expf(cu[i]); kd[i] = kv[g][i] * __expf(la[i] - cu[i]); }
          u32x4 o;
          o.x = pk2(q1[0], q1[1]); o.y = pk2(q1[2], q1[3]); o.z = pk2(q1[4], q1[5]); o.w = pk2(q1[6], q1[7]); *(LAS u32x4*)(QE1 + tau * 272 + d0 * 2) = o;
          o.x = pk2(k1[0], k1[1]); o.y = pk2(k1[2], k1[3]); o.z = pk2(k1[4], k1[5]); o.w = pk2(k1[6], k1[7]); *(LAS u32x4*)(KE + tau * 272 + d0 * 2) = o;
          o.x = pk2(q2[0], q2[1]); o.y = pk2(q2[2], q2[3]); o.z = pk2(q2[4], q2[5]); o.w = pk2(q2[6], q2[7]); *(LAS u32x4*)(QE2 + tau * 272 + d0 * 2) = o;
          o.x = pk2(kd[0], kd[1]); o.y = pk2(kd[2], kd[3]); o.z = pk2(kd[4], kd[5]); o.w = pk2(kd[6], kd[7]); *(LAS u32x4*)(KDr + tau * 288 + d0 * 2) = o;
          *(LAS u32x4*)(VVr + tau * 288 + d0 * 2) = rv[g];
          if (tau == 31) {
#pragma unroll
              for (int i = 0; i < 8; ++i) DL[d0 + i] = __expf(la[i]); } }
#pragma unroll
        for (int g = 0; g < 2; ++g) { const int cn = (c + 1 < 72) ? c + 1 : 71; const bf16_t* zr = Z + (size_t)hg_tok_row(b, dir, cn, tau) * EV_IN + 8 * g; rq[g] = *(const u32x4*)(zr + qcol); rf[g] = *(const u32x4*)(zr + fcol); rv[g] = *(const u32x4*)(zr + vcol); }
        __syncthreads();
        f32x4 X00 = {0.f, 0.f, 0.f, 0.f}, X01 = X00, X11 = X00;
#pragma unroll
        for (int ks = 0; ks < 4; ++ks) {
            const bf16x8 ke0 = *(const LAS bf16x8*)(KE + fr * 272 + (32 * ks + 8 * fg) * 2), ke1 = *(const LAS bf16x8*)(KE + (16 + fr) * 272 + (32 * ks + 8 * fg) * 2);
            const bf16x8 qe0 = *(const LAS bf16x8*)(QE1 + fr * 272 + (32 * ks + 8 * fg) * 2), qe1 = *(const LAS bf16x8*)(QE1 + (16 + fr) * 272 + (32 * ks + 8 * fg) * 2);
            X00 = __builtin_amdgcn_mfma_f32_16x16x32_bf16(ke0, qe0, X00, 0, 0, 0);
            X01 = __builtin_amdgcn_mfma_f32_16x16x32_bf16(ke0, qe1, X01, 0, 0, 0);
            X11 = __builtin_amdgcn_mfma_f32_16x16x32_bf16(ke1, qe1, X11, 0, 0, 0);
        }
#pragma unroll
        for (int i = 0; i < 4; ++i) { const bool keep = (4 * fg + i) <= fr; X00[i] = keep ? X00[i] : 0.f; X11[i] = keep ? X11[i] : 0.f; }
        u32x4 p0; p0.x = pk2(X00[0], X00[1]); p0.y = pk2(X00[2], X00[3]); p0.z = 0u; p0.w = 0u;
        u32x4 p1; p1.x = pk2(X01[0], X01[1]); p1.y = pk2(X01[2], X01[3]); p1.z = pk2(X11[0], X11[1]); p1.w = pk2(X11[2], X11[3]);
#pragma unroll
        for (int nb = 0; nb < 2; ++nb) {
            const int dvc = 32 * wl + 16 * nb;
            bf16x8 vf;
            { s16x4 v0, v1; const unsigned va = (unsigned)(size_t)VVr + (unsigned)((4 * fg + ((lane & 15) >> 2)) * 288 + (dvc + 4 * (lane & 3)) * 2);
              asm volatile("ds_read_b64_tr_b16 %0, %2\n\tds_read_b64_tr_b16 %1, %2 offset:4608\n\ts_waitcnt lgkmcnt(0)" : "=&v"(v0), "=&v"(v1) : "v"(va) : "memory");
              vf = __builtin_shufflevector(v0, v1, 0, 1, 2, 3, 4, 5, 6, 7); }
            f32x4 o0 = {0.f, 0.f, 0.f, 0.f}, o1 = o0;
            o0 = __builtin_amdgcn_mfma_f32_16x16x32_bf16(__builtin_bit_cast(bf16x8, p0), vf, o0, 0, 0, 0);
            o1 = __builtin_amdgcn_mfma_f32_16x16x32_bf16(__builtin_bit_cast(bf16x8, p1), vf, o1, 0, 0, 0);
#pragma unroll
            for (int ks = 0; ks < 4; ++ks) {
                u32x4 sp; sp.x = pk2(S[nb][2 * ks][0], S[nb][2 * ks][1]); sp.y = pk2(S[nb][2 * ks][2], S[nb][2 * ks][3]); sp.z = pk2(S[nb][2 * ks + 1][0], S[nb][2 * ks + 1][1]); sp.w = pk2(S[nb][2 * ks + 1][2], S[nb][2 * ks + 1][3]);
                const bf16x8 sf = __builtin_bit_cast(bf16x8, sp);
                const s16x4 a00 = *(const LAS s16x4*)(QE2 + fr * 272 + (32 * ks + 4 * fg) * 2), a01 = *(const LAS s16x4*)(QE2 + fr * 272 + (32 * ks + 16 + 4 * fg) * 2);
                const s16x4 a10 = *(const LAS s16x4*)(QE2 + (16 + fr) * 272 + (32 * ks + 4 * fg) * 2), a11 = *(const LAS s16x4*)(QE2 + (16 + fr) * 272 + (32 * ks + 16 + 4 * fg) * 2);
                o0 = __builtin_amdgcn_mfma_f32_16x16x32_bf16(__builtin_shufflevector(a00, a01, 0, 1, 2, 3, 4, 5, 6, 7), sf, o0, 0, 0, 0);
                o1 = __builtin_amdgcn_mfma_f32_16x16x32_bf16(__builtin_shufflevector(a10, a11, 0, 1, 2, 3, 4, 5, 6, 7), sf, o1, 0, 0, 0);
            }
#pragma unroll
            for (int db = 0; db < 8; ++db) {
                const f32x4 dl = *(const LAS f32x4*)(DL + 16 * db + 4 * fg);
                s16x4 k0, k1; { const unsigned ka = (unsigned)(size_t)KDr + (unsigned)((4 * fg + ((lane & 15) >> 2)) * 288 + (16 * db + 4 * (lane & 3)) * 2);
                  asm volatile("ds_read_b64_tr_b16 %0, %2\n\tds_read_b64_tr_b16 %1, %2 offset:4608\n\ts_waitcnt lgkmcnt(0)" : "=&v"(k0), "=&v"(k1) : "v"(ka) : "memory"); }
                f32x4 sc = S[nb][db] * dl;
                S[nb][db] = __builtin_amdgcn_mfma_f32_16x16x32_bf16(__builtin_shufflevector(k0, k1, 0, 1, 2, 3, 4, 5, 6, 7), vf, sc, 0, 0, 0);
            }
#pragma unroll
            for (int i = 0; i < 4; ++i) {
                OUT[(size_t)hg_tok_row(b, dir, c, 4 * fg + i) * 1024 + h * 128 + dvc + fr] = (bf16_t)(pk2(o0[i], 0.f) & 0xffffu);
                OUT[(size_t)hg_tok_row(b, dir, c, 16 + 4 * fg + i) * 1024 + h * 128 + dvc + fr] = (bf16_t)(pk2(o1[i], 0.f) & 0xffffu);
            }
        }
    }
    __syncthreads();
}

DI void hgrn_readout_phase(const Frame& F, const Args& a) {
    const bf16_t* OFp = (const bf16_t*)(a.ws + WS_OF); const bf16_t* OBp = (const bf16_t*)(a.ws + WS_OB);
    const bf16_t* Z = (const bf16_t*)(a.ws + WS_Z); unsigned char* Y = a.ws + WS_ACT;
    const float* wn = a.in[I_HON] + 16 * F.lane;
    float wv[16];
#pragma unroll
    for (int i = 0; i < 16; ++i) wv[i] = wn[i];
    for (int row = F.gw; row < MT; row += F.ngw) {
        const u32x4 f0 = *(const u32x4*)(OFp + (size_t)row * 1024 + 16 * F.lane), f1 = *(const u32x4*)(OFp + (size_t)row * 1024 + 16 * F.lane + 8);
        const u32x4 b0 = *(const u32x4*)(OBp + (size_t)row * 1024 + 16 * F.lane), b1 = *(const u32x4*)(OBp + (size_t)row * 1024 + 16 * F.lane + 8);
        const u32x4 g0 = *(const u32x4*)(Z + (size_t)row * EV_IN + 5632 + 16 * F.lane), g1 = *(const u32x4*)(Z + (size_t)row * EV_IN + 5632 + 16 * F.lane + 8);
        const unsigned uf[8] = {f0.x, f0.y, f0.z, f0.w, f1.x, f1.y, f1.z, f1.w}, ub[8] = {b0.x, b0.y, b0.z, b0.w, b1.x, b1.y, b1.z, b1.w}, ug[8] = {g0.x, g0.y, g0.z, g0.w, g1.x, g1.y, g1.z, g1.w};
        float o[16], gt[16]; float ss = 0.f;
#pragma unroll
        for (int i = 0; i < 8; ++i) { o[2 * i] = bflo(uf[i]) + bflo(ub[i]); o[2 * i + 1] = bfhi(uf[i]) + bfhi(ub[i]); gt[2 * i] = bflo(ug[i]); gt[2 * i + 1] = bfhi(ug[i]);
            ss += o[2 * i] * o[2 * i] + o[2 * i + 1] * o[2 * i + 1]; }
        ss += __shfl_xor(ss, 1); ss += __shfl_xor(ss, 2); ss += __shfl_xor(ss, 4);
        const float rs = __frsqrt_rn(ss * (1.f / 128.f) + EPS);
        unsigned pk[4];
#pragma unroll
        for (int i = 0; i < 4; ++i) { float y4[4];
#pragma unroll
            for (int e = 0; e < 4; ++e) y4[e] = o[4 * i + e] * rs * wv[4 * i + e] * silu_f(gt[4 * i + e]) * FP8_ASC;
            pk[i] = (unsigned)pk4_fp8(y4[0], y4[1], y4[2], y4[3]); }
        *(u32x4*)(Y + (size_t)row * DM + 1024 + 16 * F.lane) = (u32x4){pk[0], pk[1], pk[2], pk[3]};
    }
}

DI void mixer0_phase(const Frame& F, const Args& a) {
    for (int pair = F.wg; pair < 128; pair += F.G) hgrn_pair(F, a, pair);
    const bf16_t* Z = (const bf16_t*)(a.ws + WS_Z); unsigned char* Y = a.ws + WS_ACT;
    unsigned* qctr = (unsigned*)(a.ws + WS_CTL) + CW_QUEUE;
    volatile LAS unsigned* qslot = (volatile LAS unsigned*)(F.lds + LDS_MISC + 64);
    if (F.tid == 0) *qslot = __hip_atomic_fetch_add(qctr, 1u, __ATOMIC_RELAXED, __HIP_MEMORY_SCOPE_AGENT);
    __syncthreads();
    int u = (int)*qslot;
    while (u < 1024 + 128) {
        unsigned nxt = 0u;
        if (F.tid == 0) nxt = __hip_atomic_fetch_add(qctr, 1u, __ATOMIC_RELAXED, __HIP_MEMORY_SCOPE_AGENT);
        AttnP p{};
        p.ldq = EV_IN; p.ldk1 = EV_IN; p.K2 = nullptr; p.ldk2 = 0; p.ldv = EV_IN; p.ldo = DM; p.nctx_tiles = 4; p.xtile0 = 0;
        p.sc_log2e = 0.08838834764831845f * 1.4426950408889634f; p.rpb = nullptr; p.qgrow0 = 0;
        int b, head;
        if (u < 1024) { const int qb = u & 7; head = (u >> 3) & 7; b = u >> 6; p.qrow0 = b * SEQ + 256 * qb; p.nx_tiles = 32; }
        else { const int v = u - 1024; head = v & 7; b = v >> 3; p.qrow0 = MXR + b * CTXL; p.nx_tiles = 0; }
        const int kvh = head >> 2;
        p.b = b; p.orow0 = p.qrow0;
        p.Q = Z + head * 128; p.K1 = Z + 1024 + kvh * 128; p.V = Z + 1280 + kvh * 128; p.O = Y + head * 128;
        const AttnQK8 e{a.ws + WS_Q8 + head * 128, 1024, a.ws + WS_K8 + kvh * 128, 256, nullptr, 0, a.ws + WS_V8G + kvh * 128, 256};
        attn_unit_f8<128, false>(F, p, e);
        if (F.tid == 0) *qslot = nxt;
        __syncthreads();
        u = (int)*qslot;
    }
}

DI void rope64(float& v, int lane, int t, float inv16) {
    const float pv = __shfl_xor(v, 16);
    const int pos = (lane < 32) ? (t >> 6) : (t & 63);
    const float ang = (float)pos * inv16;
    const float sn = __sinf(ang), cs = __cosf(ang);
    const float sg = ((lane & 16) == 0) ? -1.f : 1.f;
    v = v * cs + sg * pv * sn;
}
DI void mla_prep_phase(const Frame& F, const Args& a) {
    bf16_t* Z = (bf16_t*)(a.ws + WS_Z);
    const float inv16 = exp2f(-(float)(F.lane & 15) * (13.287712379549449f / 16.f));
    f32x4 wq0 = *(const f32x4*)(a.in[I_MQN] + 8 * F.lane), wq1 = *(const f32x4*)(a.in[I_MQN] + 8 * F.lane + 4);
    f32x4 wk0 = *(const f32x4*)(a.in[I_MKVN] + 8 * F.lane), wk1 = *(const f32x4*)(a.in[I_MKVN] + 8 * F.lane + 4);
    for (int row = F.gw; row < MT; row += F.ngw) {
        bf16_t* zr = Z + (size_t)row * OD_INP;
#pragma unroll
        for (int part = 0; part < 2; ++part) {
            bf16_t* p = zr + 3072 + part * 512 + 8 * F.lane;
            const u32x4 u = *(const u32x4*)p; const unsigned uu[4] = {u.x, u.y, u.z, u.w};
            float v[8]; float ss = 0.f;
#pragma unroll
            for (int i = 0; i < 4; ++i) { v[2 * i] = bflo(uu[i]); v[2 * i + 1] = bfhi(uu[i]); ss += v[2 * i] * v[2 * i] + v[2 * i + 1] * v[2 * i + 1]; }
            const float rs = __frsqrt_rn(wave_sum(ss) * (1.f / 512.f) + EPS);
            const f32x4 w0 = part ? wk0 : wq0, w1 = part ? wk1 : wq1;
            u32x2 o; o.x = (unsigned)pk4_fp8(v[0] * rs * w0[0] * FP8_ASC, v[1] * rs * w0[1] * FP8_ASC, v[2] * rs * w0[2] * FP8_ASC, v[3] * rs * w0[3] * FP8_ASC);
            o.y = (unsigned)pk4_fp8(v[4] * rs * w1[0] * FP8_ASC, v[5] * rs * w1[1] * FP8_ASC, v[6] * rs * w1[2] * FP8_ASC, v[7] * rs * w1[3] * FP8_ASC);
            *(u32x2*)(a.ws + WS_ACT + (size_t)part * MT * 512 + (size_t)row * 512 + 8 * F.lane) = o;
        }
        { float v = __uint_as_float((unsigned)zr[4096 + F.lane] << 16); if (row < MXR) rope64(v, F.lane, row & 2047, inv16);
          (a.ws + WS_K8R)[(size_t)row * 64 + F.lane] = (unsigned char)(pk4_fp8(v * QK8_SC, 0.f, 0.f, 0.f) & 0xff); }
    }
}
DI void mla_qrope_phase(const Frame& F, const Args& a) {
    bf16_t* Q = (bf16_t*)(a.ws + WS_QUP);
    const float inv16 = exp2f(-(float)(F.lane & 15) * (13.287712379549449f / 16.f));
    unsigned short nx[8];
    if (F.gw < MXR) {
#pragma unroll
        for (int h = 0; h < 8; ++h) nx[h] = Q[(size_t)F.gw * 1536 + h * 192 + 128 + F.lane]; }
    for (int row = F.gw; row < MXR; row += F.ngw) {
        bf16_t* qr = Q + (size_t)row * 1536;
        unsigned short cu[8];
#pragma unroll
        for (int h = 0; h < 8; ++h) cu[h] = nx[h];
        { const int nrow = (row + F.ngw < MXR) ? row + F.ngw : row;
#pragma unroll
          for (int h = 0; h < 8; ++h) nx[h] = Q[(size_t)nrow * 1536 + h * 192 + 128 + F.lane]; }
#pragma unroll
        for (int h = 0; h < 8; ++h) { float v = __uint_as_float((unsigned)cu[h] << 16); rope64(v, F.lane, row & 2047, inv16); qr[h * 192 + 128 + F.lane] = (bf16_t)(pk2(v, 0.f) & 0xffffu); }
    }
}

DI void mixer1_phase(const Frame& F, const Args& a) {
    const bf16_t* Z = (const bf16_t*)(a.ws + WS_Z); unsigned char* Y = a.ws + WS_ACT;
    const bf16_t* QUP = (const bf16_t*)(a.ws + WS_QUP); const bf16_t* KVUP = (const bf16_t*)(a.ws + WS_KVUP);
    unsigned* qctr = (unsigned*)(a.ws + WS_CTL) + CW_QUEUE2;
    volatile LAS unsigned* qslot = (volatile LAS unsigned*)(F.lds + LDS_MISC + 64);
    if (F.tid == 0) *qslot = __hip_atomic_fetch_add(qctr, 1u, __ATOMIC_RELAXED, __HIP_MEMORY_SCOPE_AGENT);
    __syncthreads();
    int u = (int)*qslot;
    while (u < 1024) {
        unsigned nxt = 0u;
        if (F.tid == 0) nxt = __hip_atomic_fetch_add(qctr, 1u, __ATOMIC_RELAXED, __HIP_MEMORY_SCOPE_AGENT);
        AttnP p{};
        const int qb = u & 7, head = (u >> 3) & 7, b = u >> 6;
        p.b = b; p.qrow0 = b * SEQ + 256 * qb; p.orow0 = p.qrow0; p.ldo = DM; p.nctx_tiles = 4;
        p.Q = QUP + head * 192; p.ldq = 1536; p.K1 = KVUP + head * 256; p.ldk1 = 2048; p.K2 = Z + 4096; p.ldk2 = OD_INP; p.V = KVUP + head * 256 + 128; p.ldv = 2048;
        p.O = Y + 1024 + head * 128; p.xtile0 = 0; p.nx_tiles = 32; p.sc_log2e = 0.07216878364870323f * 1.4426950408889634f; p.rpb = nullptr; p.qgrow0 = 0;
        const AttnQK8 e{nullptr, 0, a.ws + WS_K8N + head * 128, 1024, a.ws + WS_K8R, 64, a.ws + WS_V8M + head * 128, 1024};
        attn_unit_f8<192, true, false, true>(F, p, e);
        if (F.tid == 0) *qslot = nxt;
        __syncthreads();
        u = (int)*qslot;
    }
    while (u < 2048) {
        unsigned nxt = 0u;
        if (F.tid == 0) nxt = __hip_atomic_fetch_add(qctr, 1u, __ATOMIC_RELAXED, __HIP_MEMORY_SCOPE_AGENT);
        AttnP p{};
        const int v = u - 1024, qb = v & 7, head = (v >> 3) & 7, b = v >> 6;
        p.b = b; p.qrow0 = b * SEQ + 256 * qb; p.orow0 = p.qrow0; p.ldo = DM; p.nctx_tiles = 4;
        p.Q = Z + head * 128; p.ldq = OD_INP; p.K1 = Z + 1024 + head * 128; p.ldk1 = OD_INP; p.K2 = nullptr; p.ldk2 = 0; p.V = Z + 2048 + head * 128; p.ldv = OD_INP;
        p.O = Y + head * 128; p.sc_log2e = 0.08838834764831845f * 1.4426950408889634f; p.rpb = a.in[I_RPB] + head * 15 * 31; p.qgrow0 = 4 * qb;
        const int rlo = min(max(4 * qb - 4, 0), 24), rhi = min(max(4 * qb + 3 - 4, 0), 24) + 8;
        p.xtile0 = rlo; p.nx_tiles = rhi - rlo;
        const AttnQK8 e{nullptr, 0, a.ws + WS_K8NA + head * 128, 1024, nullptr, 0, a.ws + WS_V8NA + head * 128, 1024};
        attn_unit_f8<128, true, true>(F, p, e);
        if (F.tid == 0) *qslot = nxt;
        __syncthreads();
        u = (int)*qslot;
    }
}

#define CEX(a, b) do { const float _hi = fmaxf(a, b), _lo = fminf(a, b); a = _hi; b = _lo; } while (0)
DI void bitonic_merge16(float (&c)[16]) {
#pragma unroll
    for (int st = 8; st >= 1; st >>= 1)
#pragma unroll
        for (int i = 0; i < 16; ++i) if ((i & st) == 0) CEX(c[i], c[i + st]);
}
DI void sort16_desc(float (&a)[16]) {
#pragma unroll
    for (int k = 2; k <= 16; k <<= 1)
#pragma unroll
        for (int j = k >> 1; j >= 1; j >>= 1)
#pragma unroll
            for (int i = 0; i < 16; ++i) { const int l = i ^ j; if (l > i) { const bool desc = (i & k) == 0;
                const float hi = fmaxf(a[i], a[l]), lo = fminf(a[i], a[l]); a[i] = desc ? hi : lo; a[l] = desc ? lo : hi; } }
}
DI void insert16(float (&a)[16], float x) {
#pragma unroll
    for (int i = 0; i < 16; ++i) { const float hi = fmaxf(a[i], x); x = fminf(a[i], x); a[i] = hi; }
}
struct CandTab { int ci[50], cj[50];
    constexpr CandTab() : ci{}, cj{} { int n = 0; for (int i = 0; i < 16; ++i) for (int j = 0; j < 16; ++j) if ((i + 1) * (j + 1) <= 16) { ci[n] = i; cj[n] = j; ++n; } } };
DI void peer_topk_wave(const Frame& F, const bf16_t* PQ, const LAS unsigned char* keysL  , int tok0, int head, int* eidx, float* gate, LAS unsigned char* scr  ) {
    const int lane = F.lane, r = lane & 31, hh = lane >> 5;
    float top[2][16];
#pragma unroll
    for (int p = 0; p < 2; ++p) {
        f32x16 st[4];
#pragma unroll
        for (int kb = 0; kb < 4; ++kb) for (int i = 0; i < 16; ++i) st[kb][i] = 0.f;
        const bf16_t* qp = PQ + (size_t)(tok0 + r) * DM + head * 256 + p * 128 + 8 * hh;
        const LAS unsigned char* kp = keysL + p * (128 * 272) + r * 272 + 16 * hh;
#pragma unroll 2
        for (int ks = 0; ks < 8; ++ks) {
            const bf16x8 qf = *(const bf16x8*)(qp + 16 * ks);
#pragma unroll
            for (int kb = 0; kb < 4; ++kb) { const bf16x8 kf = *(const LAS bf16x8*)(kp + kb * (32 * 272) + 32 * ks);
                st[kb] = __builtin_amdgcn_mfma_f32_32x32x16_bf16(kf, qf, st[kb], 0, 0, 0); }
        }
        float blk[4][16];
#pragma unroll
        for (int kb = 0; kb < 4; ++kb) {
#pragma unroll
            for (int i = 0; i < 16; ++i) { const unsigned key = 32 * kb + (i & 3) + 8 * (i >> 2) + 4 * hh; blk[kb][i] = __uint_as_float((__float_as_uint(st[kb][i]) & 0xffffff80u) | key); }
            sort16_desc(blk[kb]);
        }
        float m01[16], m23[16], aa[16];
#pragma unroll
        for (int i = 0; i < 16; ++i) { m01[i] = fmaxf(blk[0][i], blk[1][15 - i]); m23[i] = fmaxf(blk[2][i], blk[3][15 - i]); }
        bitonic_merge16(m01); bitonic_merge16(m23);
#pragma unroll
        for (int i = 0; i < 16; ++i) aa[i] = fmaxf(m01[i], m23[15 - i]);
        bitonic_merge16(aa);
        float cc[16];
#pragma unroll
        for (int i = 0; i < 16; ++i) cc[i] = fmaxf(aa[i], __shfl_xor(aa[15 - i], 32));
        bitonic_merge16(cc);
#pragma unroll
        for (int i = 0; i < 16; ++i) top[p][i] = cc[i];
    }
    LAS unsigned char* my = scr + r * 32;
#pragma unroll
    for (int p = 0; p < 2; ++p)
#pragma unroll
        for (int q4 = 0; q4 < 4; ++q4) { unsigned wv = 0;
#pragma unroll
            for (int e = 0; e < 4; ++e) wv |= (__float_as_uint(top[p][4 * q4 + e]) & 0x7fu) << (8 * e);
            *(LAS unsigned*)(my + p * 16 + 4 * q4) = wv; }
    float va[16], vb[16];
#pragma unroll
    for (int i = 0; i < 16; ++i) { va[i] = __uint_as_float(__float_as_uint(top[0][i]) & 0xffffff80u); vb[i] = __uint_as_float(__float_as_uint(top[1][i]) & 0xffffff80u); }
    float ca[16], cb[16], cd[16];
#pragma unroll
    for (int i = 0; i < 16; ++i) cb[i] = -3.0e38f;
#pragma unroll
    for (int k = 0; k < 25; ++k) {
        constexpr CandTab T{};
        const int i0 = T.ci[2 * k], j0 = T.cj[2 * k], i1 = T.ci[2 * k + 1], j1 = T.cj[2 * k + 1];
        const float s0 = va[i0] + vb[j0], s1 = va[i1] + vb[j1];
        const float x0 = __uint_as_float((__float_as_uint(s0) & 0xffffff00u) | (unsigned)(i0 * 16 + j0));
        const float x1 = __uint_as_float((__float_as_uint(s1) & 0xffffff00u) | (unsigned)(i1 * 16 + j1));
        if (k < 16) ca[k] = hh ? x1 : x0; else cb[k - 16] = hh ? x1 : x0;
    }
    sort16_desc(ca); sort16_desc(cb);
#pragma unroll
    for (int i = 0; i < 16; ++i) cd[i] = fmaxf(ca[i], cb[15 - i]);
    bitonic_merge16(cd);
    float cc[16];
#pragma unroll
    for (int i = 0; i < 16; ++i) cc[i] = fmaxf(cd[i], __shfl_xor(cd[15 - i], 32));
    bitonic_merge16(cc);
    float sv[16]; float den = 0.f;
    const float mx = __uint_as_float(__float_as_uint(cc[0]) & 0xffffff00u);
#pragma unroll
    for (int i = 0; i < 16; ++i) { sv[i] = __expf(__uint_as_float(__float_as_uint(cc[i]) & 0xffffff00u) - mx); den += sv[i]; }
    const float iden = 1.f / den;
    asm volatile("s_waitcnt lgkmcnt(0)" ::: "memory");
    if (hh == 0) {
        int* ep = eidx + (size_t)(tok0 + r) * 128 + head * 16; float* gp = gate + (size_t)(tok0 + r) * 128 + head * 16;
#pragma unroll
        for (int q4 = 0; q4 < 4; ++q4) { int ev[4]; float gv[4];
#pragma unroll
            for (int e = 0; e < 4; ++e) { const unsigned code = __float_as_uint(cc[4 * q4 + e]) & 0xffu; const unsigned ia = my[code >> 4], ib = my[16 + (code & 15u)];
                ev[e] = (int)(ia * 128u + ib); gv[e] = sv[4 * q4 + e] * iden; }
            *(int4*)(ep + 4 * q4) = make_int4(ev[0], ev[1], ev[2], ev[3]); *(f32x4*)(gp + 4 * q4) = (f32x4){gv[0], gv[1], gv[2], gv[3]}; }
    }
}
DI void peer_topk_phase(const Frame& F, const Args& a, int layer, int ntok) {
    const bf16_t* PQ = (const bf16_t*)(a.ws + WS_PQ); const int head = F.wg & 7;
    const bf16_t* keys = (const bf16_t*)(a.ws + WS_KEYS) + ((size_t)layer * 8 + head) * 2 * 128 * 128;
    int* eidx = (int*)(a.ws + WS_EIDX); float* gate = (float*)(a.ws + WS_GATE);
    LAS unsigned char* keysL = F.lds; LAS unsigned char* scr = F.lds + 2 * 128 * 272 + F.wave * 2048;
    for (int c = F.tid; c < 2 * 128 * 16; c += 512) { const int row = c >> 4, ch = c & 15; *(LAS u32x4*)(keysL + row * 272 + 16 * ch) = *(const u32x4*)(keys + (size_t)row * 128 + 8 * ch); }
    __syncthreads();
    const int nblk = ntok / 256;
    for (int blk = F.wg >> 3; blk < nblk; blk += F.G >> 3) peer_topk_wave(F, PQ, keysL, 256 * blk + 32 * F.wave, head, eidx, gate, scr);
    __syncthreads();
}

typedef __bf16 bf16p __attribute__((ext_vector_type(2)));
DI float fp6_dot32(const u32x6 r, const unsigned (&xw)[16]) {
    const bf16x32v d = __builtin_amdgcn_cvt_scalef32_pk32_bf16_fp6(r, 1.0f);
    float d0 = 0.f, d1 = 0.f;
#pragma unroll
    for (int i = 0; i < 8; ++i) {
        const bf16p lo = {d[4 * i], d[4 * i + 1]}, hi = {d[4 * i + 2], d[4 * i + 3]};
        d0 = __builtin_amdgcn_fdot2_f32_bf16(lo, __builtin_bit_cast(bf16p, xw[2 * i]), d0, false);
        d1 = __builtin_amdgcn_fdot2_f32_bf16(hi, __builtin_bit_cast(bf16p, xw[2 * i + 1]), d1, false);
    }
    return d0 + d1;
}
DI void fp6_axpy32(const u32x6 r, float w, f32x2 (&acc)[16]) {
    const f32x32v d = __builtin_amdgcn_cvt_scalef32_pk32_f32_fp6(r, 1.0f);
    const f32x2 w2 = {w, w};
#pragma unroll
    for (int i = 0; i < 16; ++i) { const f32x2 v2 = {d[2 * i], d[2 * i + 1]}; acc[i] = __builtin_elementwise_fma(w2, v2, acc[i]); }
}
typedef _Float16 h16x2 __attribute__((ext_vector_type(2)));
typedef _Float16 h16x32 __attribute__((ext_vector_type(32)));
constexpr float VW_SC = 64.f;
DI void fp6_axpy32_h(const u32x6 r, unsigned wbits  , h16x2 (&acc)[16]) {
    const h16x32 d = __builtin_amdgcn_cvt_scalef32_pk32_f16_fp6(r, 1.0f);
    const h16x2 w2 = __builtin_bit_cast(h16x2, wbits);
#pragma unroll
    for (int i = 0; i < 16; ++i) { const h16x2 v2 = {d[2 * i], d[2 * i + 1]}; acc[i] = __builtin_elementwise_fma(w2, v2, acc[i]); }
}
DI unsigned h2add(unsigned a, unsigned b) { const h16x2 r = __builtin_bit_cast(h16x2, a) + __builtin_bit_cast(h16x2, b); return __builtin_bit_cast(unsigned, r); }
DI u32x6 ld_row24(const unsigned char* p) { const u32x4 a = *(const u32x4*)p; const u32x2 b = *(const u32x2*)(p + 16); return (u32x6){a.x, a.y, a.z, a.w, b.x, b.y}; }
template <bool FINAL>
DI void peer_gather_phase(const Frame& F, const Args& a, int layer, int ntok) {
    const bf16_t* Fa = (const bf16_t*)(a.ws + WS_ACT); const unsigned char* U = a.ws + WS_U; const unsigned char* V = a.ws + WS_V;
    const float* SU = (const float*)(a.ws + WS_SU); const float* SV = (const float*)(a.ws + WS_SV);
    const int* eidx = (const int*)(a.ws + WS_EIDX); const float* gate = (const float*)(a.ws + WS_GATE);
    bf16_t* H = (bf16_t*)(a.ws + WS_H); float* HP = (float*)(a.ws + WS_HP);
    const float* modx = (const float*)(a.ws + WS_MODX) + (size_t)layer * 16 * 12288; const float* modc = (const float*)(a.ws + WS_MODC) + (size_t)layer * 12288;
    const int lane = F.lane, g8 = lane >> 3, p8 = lane & 7;
    LAS float* hpL = (LAS float*)(F.lds + F.wave * 13824); LAS unsigned short* eiL = (LAS unsigned short*)(F.lds + F.wave * 13824 + 18 * 512);
#pragma unroll 1
    for (int s = 0; s < 8; ++s) {
        const unsigned char* Us = U + (size_t)s * 16384 * SLB; const unsigned lo8 = 24u * (unsigned)p8;
#pragma unroll 1
        for (int tok = F.gw, kt = 0; tok < ntok; tok += F.ngw, ++kt) {
            unsigned xw[16];
            { const bf16_t* xp = Fa + (size_t)tok * DM + 256 * s + 32 * p8;
              const u32x4 x0 = *(const u32x4*)xp, x1 = *(const u32x4*)(xp + 8), x2 = *(const u32x4*)(xp + 16), x3 = *(const u32x4*)(xp + 24);
              xw[0] = x0.x; xw[1] = x0.y; xw[2] = x0.z; xw[3] = x0.w; xw[4] = x1.x; xw[5] = x1.y; xw[6] = x1.z; xw[7] = x1.w;
              xw[8] = x2.x; xw[9] = x2.y; xw[10] = x2.z; xw[11] = x2.w; xw[12] = x3.x; xw[13] = x3.y; xw[14] = x3.z; xw[15] = x3.w; }
            if (s == 0) { const int tp = 8 * (lane & 7) + (lane >> 3);
                eiL[kt * 128 + tp] = (unsigned short)eidx[(size_t)tok * 128 + lane]; eiL[kt * 128 + 64 + tp] = (unsigned short)eidx[(size_t)tok * 128 + 64 + lane]; }
            float hs[2] = {0.f, 0.f};
#pragma unroll
            for (int half = 0; half < 2; ++half) {
                u32x6 ra[8];
                const u32x4 ew = *(const LAS u32x4*)(eiL + kt * 128 + 64 * half + 8 * g8);
#pragma unroll
                for (int i = 0; i < 8; ++i) { const unsigned e = (i & 1) ? (ew[i >> 1] >> 16) : (ew[i >> 1] & 0xffffu); ra[i] = ld_row24(Us + (e * (unsigned)SLB + lo8)); }
                float d8[8];
#pragma unroll
                for (int i = 0; i < 8; ++i) d8[i] = fp6_dot32(ra[i], xw);
                float b4[4], c2[2];
                { const bool bit = (lane & 4) != 0;
#pragma unroll
                  for (int k = 0; k < 4; ++k) { const float kp = bit ? d8[4 + k] : d8[k], snd = bit ? d8[k] : d8[4 + k]; b4[k] = kp + __shfl_xor(snd, 4); } }
                { const bool bit = (lane & 2) != 0;
#pragma unroll
                  for (int k = 0; k < 2; ++k) { const float kp = bit ? b4[2 + k] : b4[k], snd = bit ? b4[k] : b4[2 + k]; c2[k] = kp + __shfl_xor(snd, 2); } }
                { const bool bit = (lane & 1) != 0; const float kp = bit ? c2[1] : c2[0], snd = bit ? c2[0] : c2[1]; hs[half] = kp + __shfl_xor(snd, 1); }
            }
            LAS float* hp = hpL + kt * 128 + lane;
            if (s > 0) { hs[0] += hp[0]; hs[1] += hp[64]; }
            hp[0] = hs[0]; hp[64] = hs[1];
        }
    }
#pragma unroll 1
    for (int s = 0; s < 8; ++s) {
        const unsigned char* Vs = V + (size_t)s * 16384 * SLB; const unsigned lo8 = 24u * (unsigned)p8;
#pragma unroll 1
        for (int tok = F.gw, kt = 0; tok < ntok; tok += F.ngw, ++kt) {
            LAS float* hp = hpL + kt * 128;
            if (s == 0) { const int e0 = eiL[kt * 128 + lane], e1 = eiL[kt * 128 + 64 + lane]; const int pp = 8 * (lane & 7) + (lane >> 3);
                const _Float16 w0h = (_Float16)(gate[(size_t)tok * 128 + pp] * gelu_tanh(hp[lane] * SU[e0]) * (SV[e0] * VW_SC)), w1h = (_Float16)(gate[(size_t)tok * 128 + 64 + pp] * gelu_tanh(hp[64 + lane] * SU[e1]) * (SV[e1] * VW_SC));
                ((LAS unsigned*)hp)[lane] = __builtin_bit_cast(unsigned, (h16x2){w0h, w0h}); ((LAS unsigned*)hp)[64 + lane] = __builtin_bit_cast(unsigned, (h16x2){w1h, w1h}); }
            h16x2 acc[16];
#pragma unroll
            for (int i = 0; i < 16; ++i) acc[i] = (h16x2){(_Float16)0.f, (_Float16)0.f};
#pragma unroll
            for (int half = 0; half < 2; ++half) {
                u32x6 ra[8]; unsigned wj[8];
                const u32x4 ew = *(const LAS u32x4*)(eiL + kt * 128 + 64 * half + 8 * g8);
                const u32x4 wa = *(const LAS u32x4*)(hp + 64 * half + 8 * g8), wb = *(const LAS u32x4*)(hp + 64 * half + 8 * g8 + 4);
#pragma unroll
                for (int i = 0; i < 8; ++i) { const unsigned e = (i & 1) ? (ew[i >> 1] >> 16) : (ew[i >> 1] & 0xffffu); wj[i] = (i < 4) ? wa[i & 3] : wb[i & 3]; ra[i] = ld_row24(Vs + (e * (unsigned)SLB + lo8)); }
#pragma unroll
                for (int i = 0; i < 8; ++i) fp6_axpy32_h(ra[i], wj[i], acc);
            }
            unsigned P[16], Q[8], R[4], T[2]; f32x4 r4;
#pragma unroll
            for (int k = 0; k < 16; ++k) P[k] = __builtin_bit_cast(unsigned, acc[k]);
#pragma unroll
            for (int k = 0; k < 8; ++k) { const auto r = __builtin_amdgcn_permlane32_swap(P[k], P[8 + k], false, false); Q[k] = h2add(r[0], r[1]); }
#pragma unroll
            for (int k = 0; k < 4; ++k) { const auto r = __builtin_amdgcn_permlane16_swap(Q[k], Q[4 + k], false, false); R[k] = h2add(r[0], r[1]); }
            { const bool bit = (lane & 8) != 0;
#pragma unroll
              for (int k = 0; k < 2; ++k) { const unsigned snd = bit ? R[k] : R[2 + k], kp = bit ? R[2 + k] : R[k]; T[k] = h2add(kp, __builtin_amdgcn_update_dpp(0u, snd, 0x128, 0xf, 0xf, false)); } }
            { const h16x2 t0 = __builtin_bit_cast(h16x2, T[0]), t1 = __builtin_bit_cast(h16x2, T[1]);
              r4 = (f32x4){(float)t0[0], (float)t0[1], (float)t1[0], (float)t1[1]} * (1.f / VW_SC); }
            const float* g5 = ((tok < MXR) ? (modx + (size_t)(tok >> 11) * 12288) : modc) + 5 * DM;
            const int col = 256 * s + 32 * p8 + 4 * g8;
            bf16_t* hrow = H + (size_t)tok * DM;
            const u32x2 hb = *(const u32x2*)(hrow + col); const f32x4 h4 = {bflo(hb.x), bfhi(hb.x), bflo(hb.y), bfhi(hb.y)}, gg = *(const f32x4*)(g5 + col);
            { const f32x4 y4 = h4 + gg * r4; u32x2 ob; ob.x = pk2(y4[0], y4[1]); ob.y = pk2(y4[2], y4[3]); *(u32x2*)(hrow + col) = ob; }
            if (!FINAL && s == 7) {
                asm volatile("s_waitcnt vmcnt(0)" ::: "memory");
                f32x4 v[8]; float ss = 0.f;
#pragma unroll
                for (int j = 0; j < 8; ++j) { const u32x2 hb2 = *(const u32x2*)(hrow + 4 * (lane + 64 * j)); v[j] = (f32x4){bflo(hb2.x), bfhi(hb2.x), bflo(hb2.y), bfhi(hb2.y)}; ss += v[j][0] * v[j][0] + v[j][1] * v[j][1] + v[j][2] * v[j][2] + v[j][3] * v[j][3]; }
                const float rs = __frsqrt_rn(wave_sum(ss) * (1.f / DM) + EPS);
                const float* nw = a.in[I_N1W] + (size_t)(layer + 1) * DM;
                const float* mod1 = (tok < MXR) ? ((const float*)(a.ws + WS_MODX) + ((size_t)(layer + 1) * 16 + (tok >> 11)) * 12288) : ((const float*)(a.ws + WS_MODC) + (size_t)(layer + 1) * 12288);
                bf16_t* ao = (bf16_t*)(a.ws + WS_ACT) + (size_t)tok * DM;
#pragma unroll
                for (int j = 0; j < 8; ++j) { const int cc = 4 * (lane + 64 * j); const f32x4 w4 = *(const f32x4*)(nw + cc), sh = *(const f32x4*)(mod1 + cc), sc4 = *(const f32x4*)(mod1 + DM + cc);
                    f32x4 y;
#pragma unroll
                    for (int e = 0; e < 4; ++e) y[e] = (v[j][e] * rs * w4[e]) * (1.f + sc4[e]) + sh[e];
                    *(int*)((unsigned char*)(a.ws + WS_A8) + (size_t)tok * DM + cc) = pk4_fp8(y[0] * FP8_ASC, y[1] * FP8_ASC, y[2] * FP8_ASC, y[3] * FP8_ASC); }
            }
            if (FINAL && s == 7) {
                asm volatile("s_waitcnt vmcnt(0)" ::: "memory");
                f32x4 v[8]; float ss = 0.f;
#pragma unroll
                for (int j = 0; j < 8; ++j) { const u32x2 hb2 = *(const u32x2*)(hrow + 4 * (lane + 64 * j)); v[j] = (f32x4){bflo(hb2.x), bfhi(hb2.x), bflo(hb2.y), bfhi(hb2.y)}; ss += v[j][0] * v[j][0] + v[j][1] * v[j][1] + v[j][2] * v[j][2] + v[j][3] * v[j][3]; }
                const float rs = __frsqrt_rn(wave_sum(ss) * (1.f / DM) + EPS);
                const float* fw = a.in[I_FNW]; float* op = a.out + (size_t)tok * DM;
#pragma unroll
                for (int j = 0; j < 8; ++j) { const int cc = 4 * (lane + 64 * j); const f32x4 w4 = *(const f32x4*)(fw + cc);
                    f32x4 ov = v[j] * rs * w4;
#if DBG_SANITIZE
                    for (int e = 0; e < 4; ++e) if (!(fabsf(ov[e]) < 1e30f)) ov[e] = 1.0e4f;
#endif
                    *(f32x4*)(op + cc) = ov; }
            }
        }
    }
}

__global__ void __launch_bounds__(512, 2) fwd_kernel(Args args) {
    extern __shared__ __attribute__((aligned(16))) unsigned char lds_raw[];
    Frame F;
    F.lds = (LAS unsigned char*)lds_raw;
    F.tid = threadIdx.x; F.lane = F.tid & 63; F.wave = __builtin_amdgcn_readfirstlane(F.tid >> 6);
    F.G = gridDim.x; F.wg = blockIdx.x; F.gw = F.wg * 8 + F.wave; F.ngw = F.G * 8;
    volatile LAS unsigned* MISC = (volatile LAS unsigned*)(F.lds + LDS_MISC);
    if (F.tid < 4) MISC[F.tid] = 0u;
    __syncthreads();
    unsigned char* ws = args.ws;
    const int lo = args.ph_lo, hi = args.ph_hi;
    XcdBarrier bar; bar.bar = (unsigned*)(ws + WS_CTL) + CW_BAR; bar.x = 0; bar.st = nullptr;
    if (hi - lo > 1) bar = xcd_barrier_post((unsigned*)(ws + WS_CTL) + CW_BAR, MISC);
#ifndef PH_MASK
#define PH_MASK 0xffffffffu
#endif
#define IN(k) ((((PH_MASK) >> (k)) & 1u) && lo <= (k) && (k) < hi)
#define SEAM(k) do { if (IN(k) && IN((k) + 1)) xcd_barrier(bar); } while (0)
    const float* modx = (const float*)(ws + WS_MODX); const float* modc = (const float*)(ws + WS_MODC);
    bf16_t* ACT = (bf16_t*)(ws + WS_ACT); bf16_t* H = (bf16_t*)(ws + WS_H); bf16_t* Z = (bf16_t*)(ws + WS_Z);

#define REP2(k) if (((DBG_REPMASK) >> (k)) & 1u)
#define P0_BODY  { prologue(F, args); }
#define P1_BODY  { norm_mod_phase<false, true>(F, args.in[I_X], args.in[I_CTX], args.in[I_N1W], modx, modc, 0, ACT, MT); }
#define P2_BODY  { pg8::Gemm g{ACT, (const bf16_t*)(ws + WS_WIN0), MT, EV_IN, DM / 2, DM / 2, DM / 2}; pg8::StaticOrder S; S.init(MT, EV_IN, F.G, F.wg); \
        pg8::EpiBf16 E{Z, EV_IN, 1.f / (FP8_WSC * FP8_ASC)}; pg8::gemm_phase<pg8::EpiBf16, true>(F.lds, g, S, E); }
#define P3_BODY  { gqa_prep_phase(F, args); }
#define P4_BODY  { mixer0_phase(F, args); }
#define P5_BODY  { hgrn_readout_phase(F, args); }
#define P6_BODY  { pg8::Gemm g{ACT, (const bf16_t*)(ws + WS_WOUT0), MT, DM, DM / 2, DM / 2, DM / 2}; pg8::StaticOrder S; S.init(MT, DM, F.G, F.wg); \
        pg8::EpiResid<false> E{H, args.in[I_X], args.in[I_CTX], modx + 2 * DM, modc + 2 * DM, 12288, 1.f / (FP8_WSC * FP8_ASC)}; pg8::gemm_phase<pg8::EpiResid<false>, true>(F.lds, g, S, E); }
#define P7_BODY  { norm_mod_phase<true>(F, H, H + (size_t)MXR * DM, args.in[I_N2W], modx, modc, 3, ACT, MT); }
#define P8_BODY  { pg8::Gemm g{ACT, (const bf16_t*)(ws + WS_WPQ), MT, DM, DM, DM, DM}; pg8::StaticOrder S; S.init(MT, DM, F.G, F.wg); \
        pg8::EpiBf16 E{(bf16_t*)(ws + WS_PQ), DM}; pg8::gemm_phase(F.lds, g, S, E); }
#define P9_BODY  { peer_topk_phase(F, args, 0, MT); }
#define P10_BODY { peer_gather_phase<false>(F, args, 0, MT); }
#define P11_BODY { }
#define P12_BODY { pg8::Gemm g{(const bf16_t*)(ws + WS_A8), (const bf16_t*)(ws + WS_WIN1), MT, OD_INP, DM / 2, DM / 2, DM / 2}; pg8::StaticOrder S; S.init(MT, OD_INP, F.G, F.wg); \
        pg8::EpiZ1 E{Z, OD_INP, 1.f / (FP8_WSC * FP8_ASC), ws + WS_K8NA, QK8_SC / (FP8_WSC * FP8_ASC), ws + WS_V8NA}; pg8::gemm_phase<pg8::EpiZ1, true>(F.lds, g, S, E); }
#define P13_BODY { mla_prep_phase(F, args); }
#define P14_BODY { \
        { pg8::Gemm g{ACT, (const bf16_t*)(ws + WS_WQUP), MXR, 1536, 256, 256, 256}; pg8::StaticOrder S; S.init(MXR, 1536, F.G, F.wg); \
          pg8::EpiBf16 E{(bf16_t*)(ws + WS_QUP), 1536, 1.f / (FP8_WSC2 * FP8_ASC)}; pg8::gemm_phase<pg8::EpiBf16, true>(F.lds, g, S, E); } \
        { pg8::Gemm g{(const bf16_t*)(ws + WS_ACT + (size_t)MT * 512), (const bf16_t*)(ws + WS_WKVUP), MT, 2048, 256, 256, 256}; pg8::StaticOrder S; S.init(MT, 2048, F.G, F.wg); \
          pg8::EpiKV8 E{ws + WS_V8M, 1.f / (FP8_WSC2 * FP8_ASC), ws + WS_K8N, QK8_SC / (FP8_WSC2 * FP8_ASC)}; pg8::gemm_phase<pg8::EpiKV8, true>(F.lds, g, S, E); } }
#define P15_BODY { }
#define P16_BODY { mixer1_phase(F, args); }
#define P17_BODY { pg8::Gemm g{ACT, (const bf16_t*)(ws + WS_WOUT1), MXR, DM, DM / 2, DM / 2, DM / 2}; pg8::StaticOrder S; S.init(MXR, DM, F.G, F.wg); \
        pg8::EpiResid<true> E{H, H, H, modx + (size_t)16 * 12288 + 2 * DM, modc + 12288 + 2 * DM, 12288, 1.f / (FP8_WSC * FP8_ASC)}; pg8::gemm_phase<pg8::EpiResid<true>, true>(F.lds, g, S, E); }
#define P18_BODY { norm_mod_phase<true>(F, H, H, args.in[I_N2W] + DM, modx + (size_t)16 * 12288, modc + 12288, 3, ACT, MXR); \
        cvt_fp6_rows(F, args.in[I_PU] + (size_t)16384 * 2048, ws + WS_U, (float*)(ws + WS_SU), 16384); \
        cvt_fp6_rows(F, args.in[I_PV] + (size_t)16384 * 2048, ws + WS_V, (float*)(ws + WS_SV), 16384); }
#define P19_BODY { pg8::Gemm g{ACT, (const bf16_t*)(ws + WS_WPQ) + (size_t)2048 * 2048, MXR, DM, DM, DM, DM}; pg8::StaticOrder S; S.init(MXR, DM, F.G, F.wg); \
        pg8::EpiBf16 E{(bf16_t*)(ws + WS_PQ), DM}; pg8::gemm_phase(F.lds, g, S, E); }
#define P20_BODY { peer_topk_phase(F, args, 1, MXR); }
#define P21_BODY { peer_gather_phase<true>(F, args, 1, MXR); }
#define PHASE(k, BODY) if (IN(k)) { BODY REP2(k) BODY }
    PHASE(0, P0_BODY) SEAM(0);
    PHASE(1, P1_BODY) SEAM(1);
    PHASE(2, P2_BODY) SEAM(2);
    PHASE(3, P3_BODY) SEAM(3);
    PHASE(4, P4_BODY) SEAM(4);
    PHASE(5, P5_BODY) SEAM(5);
    PHASE(6, P6_BODY) SEAM(6);
    PHASE(7, P7_BODY) SEAM(7);
    PHASE(8, P8_BODY) SEAM(8);
    PHASE(9, P9_BODY) SEAM(9);
    PHASE(10, P10_BODY)
    PHASE(11, P11_BODY) SEAM(11);
    PHASE(12, P12_BODY) SEAM(12);
    PHASE(13, P13_BODY) SEAM(13);
    PHASE(14, P14_BODY)
    PHASE(15, P15_BODY) SEAM(15);
    PHASE(16, P16_BODY) SEAM(16);
    PHASE(17, P17_BODY) SEAM(17);
    PHASE(18, P18_BODY) SEAM(18);
    PHASE(19, P19_BODY) SEAM(19);
    PHASE(20, P20_BODY) SEAM(20);
    PHASE(21, P21_BODY)
#undef IN
#undef SEAM
}

extern "C" void kernel_launch(void* const* d_in, const int* in_sizes, int n_in, void* d_out, int out_size, void* d_ws, size_t ws_size, hipStream_t stream) {
    static int grid = 0;
    if (grid == 0) {
        if (n_in != N_IN || ws_size < WS_END) { fprintf(stderr, "kernel_launch: unexpected n_in %d or ws_size %zu (< %zu)\n", n_in, ws_size, (size_t)WS_END); grid = -1; return; }
        int dev = 0, cus = 0, per_cu = 0;
        if (hipGetDevice(&dev) != hipSuccess || hipDeviceGetAttribute(&cus, hipDeviceAttributeMultiprocessorCount, dev) != hipSuccess) { grid = -1; return; }
        if (hipFuncSetAttribute((const void*)fwd_kernel, hipFuncAttributeMaxDynamicSharedMemorySize, LDS_BYTES) != hipSuccess) { fprintf(stderr, "kernel_launch: hipFuncSetAttribute failed\n"); grid = -1; return; }
        if (hipOccupancyMaxActiveBlocksPerMultiprocessor(&per_cu, (const void*)fwd_kernel, 512, LDS_BYTES) != hipSuccess || per_cu < 1) { fprintf(stderr, "kernel_launch: occupancy query says %d\n", per_cu); }
        (void)hipGetLastError();
        if (cus < 256) { fprintf(stderr, "kernel_launch: this build is laid out for 256 CUs (MI355X); found %d\n", cus); grid = -1; return; }
        grid = 256;
    }
    if (grid < 0) return;
    (void)hipMemsetAsync((char*)d_ws + WS_CTL, 0, CTL_ZERO_BYTES, stream);
    Args a{};
    for (int i = 0; i < N_IN; ++i) a.in[i] = (const float*)d_in[i];
    a.out = (float*)d_out; a.ws = (unsigned char*)d_ws;
#if MK_N_LAUNCHES == 1
    a.ph_lo = 0; a.ph_hi = NPHASE;
    hipLaunchKernelGGL(fwd_kernel, dim3(grid), dim3(512), LDS_BYTES, stream, a);
#else
    for (int ph = 0; ph < NPHASE; ++ph) { a.ph_lo = ph; a.ph_hi = ph + 1; hipLaunchKernelGGL(fwd_kernel, dim3(grid), dim3(512), LDS_BYTES, stream, a); }
#endif
}
```
